# Optimizing an MI355X kernel written in HIP

```python
import math
import jax, jax.numpy as jnp
from jax import lax
import numpy as np

D_MODEL = 1024
BATCH = 2
SEQ = 16384
DEPTH = 4

ATTN_HEADS = 8
NOPE_DIM = 64
ROPE_DIM = 32
QK_DIM = NOPE_DIM + ROPE_DIM
V_DIM = 64
Q_RANK = 384
KV_RANK = 256
ATTN_WIDTH = ATTN_HEADS * V_DIM
Q_BLOCK = 128
ROPE_THETA = 10000.0
SG_GROUPS = 4
SG_CH = 64
SG_WIDTH = SG_GROUPS * SG_CH
SG_CHUNK = 128
SSM_GROUPS = 16
SSM_CH = 16
SSM_WIDTH = SSM_GROUPS * SSM_CH
SSM_STATE = 64
MIX_WIDTH = ATTN_WIDTH + SG_WIDTH + SSM_WIDTH
IN_COLS = Q_RANK + KV_RANK + ROPE_DIM + 2 * SG_WIDTH + SSM_WIDTH
OFF_KV = Q_RANK
OFF_KR = OFF_KV + KV_RANK
OFF_SG = OFF_KR + ROPE_DIM
OFF_SSM = OFF_SG + 2 * SG_WIDTH
MOE_GROUPS = 4
EXPERTS_PER_GROUP = 8
N_EXPERTS = MOE_GROUPS * EXPERTS_PER_GROUP
TOP_K = 2
D_EXPERT = 256
MOE_BLOCK = 128
PLE_DIM = 256
EPS = 1e-6

kernel_name = 'hybrid_mla_gmlp_s5_hmoe_trunk'


def rms_norm(x, g):
    xf = x.astype(jnp.float32)
    y = xf * lax.rsqrt(jnp.mean(xf * xf, axis=-1, keepdims=True) + EPS)
    return (y * g.astype(jnp.float32)).astype(x.dtype)


def layer_norm(x, g, b):
    xf = x.astype(jnp.float32)
    mu = jnp.mean(xf, axis=-1, keepdims=True)
    xc = xf - mu
    y = xc * lax.rsqrt(jnp.mean(xc * xc, axis=-1, keepdims=True) + EPS)
    return (y * g.astype(jnp.float32) + b.astype(jnp.float32)).astype(x.dtype)


def rope_tables(seq):
    inv = 1.0 / (ROPE_THETA ** (jnp.arange(0, ROPE_DIM, 2, dtype=jnp.float32) / ROPE_DIM))
    ang = jnp.arange(seq, dtype=jnp.float32)[:, None] * inv[None, :]
    return jnp.cos(ang), jnp.sin(ang)


def apply_rope(x, cos, sin):
    x1, x2 = jnp.split(x.astype(jnp.float32), 2, axis=-1)
    c = cos[None, :, None, :]
    s = sin[None, :, None, :]
    return jnp.concatenate([x1 * c - x2 * s, x1 * s + x2 * c], axis=-1).astype(x.dtype)


def mla_attention(z_q, z_kv, k_rope, g_cq, g_ckv, w_uq, w_ukv, g_qh, g_kh, cos, sin):
    B, S, _ = z_q.shape
    q = (rms_norm(z_q, g_cq) @ w_uq).reshape(B, S, ATTN_HEADS, QK_DIM)
    kv = (rms_norm(z_kv, g_ckv) @ w_ukv).reshape(B, S, ATTN_HEADS, NOPE_DIM + V_DIM)
    k_nope, v = kv[..., :NOPE_DIM], kv[..., NOPE_DIM:]
    k_r = jnp.broadcast_to(k_rope[:, :, None, :], (B, S, ATTN_HEADS, ROPE_DIM))
    k = jnp.concatenate([k_nope, k_r], axis=-1)
    q = rms_norm(q, g_qh)
    k = rms_norm(k, g_kh)
    q = jnp.concatenate([q[..., :NOPE_DIM], apply_rope(q[..., NOPE_DIM:], cos, sin)], axis=-1)
    k = jnp.concatenate([k[..., :NOPE_DIM], apply_rope(k[..., NOPE_DIM:], cos, sin)], axis=-1)
    scale = QK_DIM ** -0.5
    n_blk = S // Q_BLOCK
    qb = q.reshape(B, n_blk, Q_BLOCK, ATTN_HEADS, QK_DIM).transpose(1, 0, 2, 3, 4)
    kpos = jnp.arange(S)

    def block(args):
        qi, bi = args
        qpos = bi * Q_BLOCK + jnp.arange(Q_BLOCK)
        s = jnp.einsum('bqhd,bkhd->bhqk', qi, k, preferred_element_type=jnp.float32) * scale
        s = jnp.where(kpos[None, :] <= qpos[:, None], s, -jnp.inf)
        pr = jax.nn.softmax(s, axis=-1)
        return jnp.einsum('bhqk,bkhd->bqhd', pr.astype(v.dtype), v)

    o = lax.map(block, (qb, jnp.arange(n_blk)))
    return o.transpose(1, 0, 2, 3, 4).reshape(B, S, ATTN_WIDTH)


def spatial_gating(z, ln_g, ln_b, w_s, b_s):
    B, S, _ = z.shape
    z = jax.nn.gelu(z)
    u, v = z[..., :SG_WIDTH], z[..., SG_WIDTH:]
    v = layer_norm(v.reshape(B, S, SG_GROUPS, SG_CH),
                   ln_g.reshape(SG_GROUPS, SG_CH), ln_b.reshape(SG_GROUPS, SG_CH))
    vc = v.reshape(B, S // SG_CHUNK, SG_CHUNK, SG_GROUPS, SG_CH)
    causal = jnp.tril(jnp.ones((SG_CHUNK, SG_CHUNK), dtype=w_s.dtype))
    w = w_s * causal[None]
    mixed = jnp.einsum('gts,bcsgd->bctgd', w, vc) + b_s.T[None, None, :, :, None]
    return u * mixed.reshape(B, S, SG_WIDTH)


def _ssm_combine(e1, e2):
    a1r, a1i, b1r, b1i = e1
    a2r, a2i, b2r, b2i = e2
    return (a2r * a1r - a2i * a1i,
            a2r * a1i + a2i * a1r,
            a2r * b1r - a2i * b1i + b2r,
            a2r * b1i + a2i * b1r + b2i)


def s5_mixer(u, lam_re, lam_im, log_dt, b_re, b_im, c_re, c_im, d_skip, w_glu, b_glu):
    B, S, _ = u.shape
    f32 = jnp.float32
    x = u.reshape(B, S, SSM_GROUPS, SSM_CH).astype(f32)
    lr = jnp.minimum(lam_re.astype(f32), -1e-4)
    li = lam_im.astype(f32)
    dt = jnp.exp(log_dt.astype(f32))
    mag = jnp.exp(lr * dt)
    ab_re, ab_im = mag * jnp.cos(li * dt), mag * jnp.sin(li * dt)
    den = lr * lr + li * li
    nr, ni = ab_re - 1.0, ab_im
    fr = (nr * lr + ni * li) / den
    fi = (ni * lr - nr * li) / den
    br, bi = b_re.astype(f32), b_im.astype(f32)
    bb_re = fr[..., None] * br - fi[..., None] * bi
    bb_im = fr[..., None] * bi + fi[..., None] * br
    bu_re = jnp.einsum('gnc,bsgc->bsgn', bb_re, x)
    bu_im = jnp.einsum('gnc,bsgc->bsgn', bb_im, x)
    a_re = jnp.broadcast_to(ab_re, bu_re.shape)
    a_im = jnp.broadcast_to(ab_im, bu_im.shape)
    _, _, h_re, h_im = lax.associative_scan(_ssm_combine, (a_re, a_im, bu_re, bu_im), axis=1)
    y = (jnp.einsum('gcn,bsgn->bsgc', c_re.astype(f32), h_re)
         - jnp.einsum('gcn,bsgn->bsgc', c_im.astype(f32), h_im)
         + d_skip.astype(f32) * x)
    g = jax.nn.gelu(y.reshape(B, S, SSM_WIDTH)).astype(u.dtype)
    return g * jax.nn.sigmoid(g @ w_glu + b_glu)


def hierarchical_moe(h, w_rg, b_rg, w_rexp, b_rexp, w1, w3, w2):
    B, S, D = h.shape
    T = B * S
    xf = h.reshape(T, D)
    g_logits = (xf @ w_rg + b_rg).astype(jnp.float32)
    g_sel = jnp.argmax(g_logits, axis=-1)
    g_w = jnp.take_along_axis(jax.nn.softmax(g_logits, axis=-1), g_sel[:, None], axis=-1)[:, 0]
    e_logits = (xf @ w_rexp + b_rexp).astype(jnp.float32).reshape(T, MOE_GROUPS, EXPERTS_PER_GROUP)
    e_in = jnp.take_along_axis(e_logits, g_sel[:, None, None], axis=1)[:, 0]
    top_v, top_i = lax.top_k(e_in, TOP_K)
    e_w = jax.nn.softmax(top_v, axis=-1) * g_w[:, None]
    e_idx = g_sel[:, None].astype(jnp.int32) * EXPERTS_PER_GROUP + top_i.astype(jnp.int32)

    TK = T * TOP_K
    flat_e = e_idx.reshape(TK)
    flat_w = e_w.reshape(TK)
    flat_tok = jnp.repeat(jnp.arange(T, dtype=jnp.int32), TOP_K)
    order = jnp.argsort(flat_e)
    se = flat_e[order]
    counts = jnp.bincount(flat_e, length=N_EXPERTS)
    start = jnp.cumsum(counts) - counts
    pcounts = (counts + MOE_BLOCK - 1) // MOE_BLOCK * MOE_BLOCK
    pend = jnp.cumsum(pcounts)
    pstart = pend - pcounts
    dest = pstart[se] + (jnp.arange(TK, dtype=jnp.int32) - start[se])
    n_blocks = -(-(TK + N_EXPERTS * (MOE_BLOCK - 1)) // MOE_BLOCK)
    NP = n_blocks * MOE_BLOCK
    row_tok = jnp.full((NP,), T, dtype=jnp.int32).at[dest].set(flat_tok[order])
    row_w = jnp.zeros((NP,), jnp.float32).at[dest].set(flat_w[order])
    blk_e = jnp.minimum(jnp.searchsorted(pend, jnp.arange(n_blocks) * MOE_BLOCK, side='right'),
                        N_EXPERTS - 1)
    xpad = jnp.concatenate([xf, jnp.zeros((1, D), xf.dtype)], axis=0)

    def expert_block(args):
        tok, e = args
        xb = xpad[tok]
        hb = jax.nn.silu(xb @ w1[e]) * (xb @ w3[e])
        return hb @ w2[e]

    yb = lax.map(expert_block, (row_tok.reshape(n_blocks, MOE_BLOCK), blk_e))
    y = jnp.zeros((T + 1, D), jnp.float32).at[row_tok].add(
        yb.reshape(NP, D).astype(jnp.float32) * row_w[:, None])
    return y[:T].reshape(B, S, D).astype(h.dtype)


def setup_inputs(seed: int = 0) -> dict:
    key = jax.random.key(seed)
    ks = iter(jax.random.split(key, 48))
    f32 = jnp.float32

    def nrm(shape, scale):
        return jax.random.normal(next(ks), shape, f32) * scale

    def gain(shape):
        return 1.0 + nrm(shape, 0.02)

    L = DEPTH
    inp = {}
    inp['x'] = nrm((BATCH, SEQ, D_MODEL), 1.0)
    inp['p'] = nrm((DEPTH, BATCH, SEQ, PLE_DIM), 1.0)
    inp['ln1'] = gain((L, D_MODEL))
    inp['w_in'] = nrm((L, D_MODEL, IN_COLS), D_MODEL ** -0.5)
    inp['g_cq'] = gain((L, Q_RANK))
    inp['g_ckv'] = gain((L, KV_RANK))
    inp['w_uq'] = nrm((L, Q_RANK, ATTN_HEADS * QK_DIM), Q_RANK ** -0.5)
    inp['w_ukv'] = nrm((L, KV_RANK, ATTN_HEADS * (NOPE_DIM + V_DIM)), KV_RANK ** -0.5)
    inp['g_qh'] = gain((L, QK_DIM))
    inp['g_kh'] = gain((L, QK_DIM))
    inp['sg_ln_g'] = gain((L, SG_WIDTH))
    inp['sg_ln_b'] = nrm((L, SG_WIDTH), 0.02)
    inp['sg_w'] = nrm((L, SG_GROUPS, SG_CHUNK, SG_CHUNK), 0.5 * SG_CHUNK ** -0.5)
    inp['sg_b'] = 1.0 + nrm((L, SG_GROUPS, SG_CHUNK), 0.1)
    inp['lam_re'] = -0.5 + nrm((L, SSM_GROUPS, SSM_STATE), 0.01)
    inp['lam_im'] = (math.pi * jnp.arange(SSM_STATE, dtype=f32))[None, None, :] + nrm((L, SSM_GROUPS, SSM_STATE), 0.01)
    inp['log_dt'] = jax.random.uniform(next(ks), (L, SSM_GROUPS, SSM_STATE), f32, math.log(1e-3), math.log(1e-1))
    inp['ssm_b_re'] = nrm((L, SSM_GROUPS, SSM_STATE, SSM_CH), (2.0 * SSM_CH) ** -0.5)
    inp['ssm_b_im'] = nrm((L, SSM_GROUPS, SSM_STATE, SSM_CH), (2.0 * SSM_CH) ** -0.5)
    inp['ssm_c_re'] = nrm((L, SSM_GROUPS, SSM_CH, SSM_STATE), (2.0 * SSM_STATE) ** -0.5)
    inp['ssm_c_im'] = nrm((L, SSM_GROUPS, SSM_CH, SSM_STATE), (2.0 * SSM_STATE) ** -0.5)
    inp['ssm_d'] = nrm((L, SSM_GROUPS, SSM_CH), 1.0)
    inp['w_glu'] = nrm((L, SSM_WIDTH, SSM_WIDTH), SSM_WIDTH ** -0.5)
    inp['b_glu'] = nrm((L, SSM_WIDTH), 0.02)
    inp['g_mix'] = gain((L, MIX_WIDTH))
    inp['w_out'] = nrm((L, MIX_WIDTH, D_MODEL), MIX_WIDTH ** -0.5)
    inp['ln2'] = gain((L, D_MODEL))
    inp['w_rg'] = nrm((L, D_MODEL, MOE_GROUPS), D_MODEL ** -0.5)
    inp['b_rg'] = nrm((L, MOE_GROUPS), 0.01)
    inp['w_rexp'] = nrm((L, D_MODEL, N_EXPERTS), D_MODEL ** -0.5)
    inp['b_rexp'] = nrm((L, N_EXPERTS), 0.01)
    inp['w1'] = nrm((L, N_EXPERTS, D_MODEL, D_EXPERT), D_MODEL ** -0.5)
    inp['w3'] = nrm((L, N_EXPERTS, D_MODEL, D_EXPERT), D_MODEL ** -0.5)
    inp['w2'] = nrm((L, N_EXPERTS, D_EXPERT, D_MODEL), D_EXPERT ** -0.5)
    inp['w_pg'] = nrm((L, D_MODEL, D_MODEL), D_MODEL ** -0.5)
    inp['b_pg'] = nrm((L, D_MODEL), 0.02)
    inp['w_ple'] = nrm((L, PLE_DIM, D_MODEL), PLE_DIM ** -0.5)
    return inp


def reference(x, p, ln1, w_in, g_cq, g_ckv, w_uq, w_ukv, g_qh, g_kh, sg_ln_g, sg_ln_b, sg_w, sg_b,
              lam_re, lam_im, log_dt, ssm_b_re, ssm_b_im, ssm_c_re, ssm_c_im, ssm_d, w_glu, b_glu,
              g_mix, w_out, ln2, w_rg, b_rg, w_rexp, b_rexp, w1, w3, w2, w_pg, b_pg, w_ple):
    cos, sin = rope_tables(x.shape[1])
    h = x
    for i in range(DEPTH):
        z = rms_norm(h, ln1[i]) @ w_in[i]
        a = mla_attention(z[..., :OFF_KV], z[..., OFF_KV:OFF_KR], z[..., OFF_KR:OFF_SG],
                          g_cq[i], g_ckv[i], w_uq[i], w_ukv[i], g_qh[i], g_kh[i], cos, sin)
        g = spatial_gating(z[..., OFF_SG:OFF_SSM], sg_ln_g[i], sg_ln_b[i], sg_w[i], sg_b[i])
        s = s5_mixer(z[..., OFF_SSM:], lam_re[i], lam_im[i], log_dt[i], ssm_b_re[i], ssm_b_im[i],
                     ssm_c_re[i], ssm_c_im[i], ssm_d[i], w_glu[i], b_glu[i])
        gm = g_mix[i]
        mix = jnp.concatenate([
            rms_norm(a, gm[:ATTN_WIDTH]),
            rms_norm(g, gm[ATTN_WIDTH:ATTN_WIDTH + SG_WIDTH]),
            rms_norm(s, gm[ATTN_WIDTH + SG_WIDTH:]),
        ], axis=-1)
        h = h + mix @ w_out[i]
        h = h + hierarchical_moe(rms_norm(h, ln2[i]), w_rg[i], b_rg[i], w_rexp[i], b_rexp[i],
                                 w1[i], w3[i], w2[i])
        h = h + jax.nn.sigmoid(h @ w_pg[i] + b_pg[i]) * (p[i] @ w_ple[i])
    return h
```

```cpp
#include <hip/hip_runtime.h>
#include <cstdio>
#include <cstdint>
namespace nv {
constexpr int D_MODEL = 1024, SEQ = 16384, BATCH = 2, DEPTH = 4;
constexpr int ATTN_HEADS = 8, NOPE = 64, ROPE = 32, QK = 96, VD = 64, Q_RANK = 384, KV_RANK = 256, ATTN_W = 512;
constexpr int SG_G = 4, SG_CH = 64, SG_W = 256, SG_CHUNK = 128;
constexpr int SSM_G = 16, SSM_C = 16, SSM_W = 256, SSM_N = 64;
constexpr int IN_COLS = 1440, OFF_KV = 384, OFF_KR = 640, OFF_SG = 672, OFF_SSM = 1184;
constexpr int MOE_G = 4, EPG = 8, NEXP = 32, D_EXP = 256, PLE = 256;
constexpr float EPS = 1e-6f;

__device__ __forceinline__ float wsum(float v) {
#pragma unroll
    for (int o = 32; o >= 1; o >>= 1) v += __shfl_xor(v, o);
    return v;
}
__device__ __forceinline__ float gelu_tanh(float x) {
    const float c = 0.7978845608028654f;
    float u = c * (x + 0.044715f * x * x * x);
    return 0.5f * x * (1.0f + tanhf(u));
}
__device__ __forceinline__ float sigmoidf_(float x) { return 1.0f / (1.0f + __expf(-x)); }

__global__ void k_rmsnorm(const float* __restrict__ in, int ldi, const float* __restrict__ g, float* __restrict__ out, int ldo, int D, int rows) {
    int row = blockIdx.x * (blockDim.x >> 6) + (threadIdx.x >> 6), lane = threadIdx.x & 63;
    if (row >= rows) return;
    const float* x = in + (size_t)row * ldi;
    float s = 0.f;
    for (int c = lane; c < D; c += 64) { float v = x[c]; s += v * v; }
    s = wsum(s);
    float r = rsqrtf(s / (float)D + EPS);
    float* o = out + (size_t)row * ldo;
    for (int c = lane; c < D; c += 64) o[c] = x[c] * r * g[c];
}

template <int ACC>
__global__ void __launch_bounds__(256) k_gemm(const float* __restrict__ A, int lda, const float* __restrict__ B, int ldb, float* __restrict__ C, int ldc, int M, int N, int K) {
    __shared__ float As[16][68];
    __shared__ float Bs[16][68];
    const int tid = threadIdx.x, tx = tid & 15, ty = tid >> 4;
    const int m0 = blockIdx.y * 64, n0 = blockIdx.x * 64;
    float acc[4][4];
#pragma unroll
    for (int i = 0; i < 4; ++i)
#pragma unroll
        for (int j = 0; j < 4; ++j) acc[i][j] = 0.f;
    for (int k0 = 0; k0 < K; k0 += 16) {
        {
            int r = tid >> 2, kc = (tid & 3) * 4;
            float4 v = make_float4(0.f, 0.f, 0.f, 0.f);
            if (m0 + r < M) v = *(const float4*)(A + (size_t)(m0 + r) * lda + k0 + kc);
            As[kc + 0][r] = v.x; As[kc + 1][r] = v.y; As[kc + 2][r] = v.z; As[kc + 3][r] = v.w;
        }
        {
            int kr = tid >> 4, nc = (tid & 15) * 4;
            float4 v = make_float4(0.f, 0.f, 0.f, 0.f);
            if (n0 + nc < N) v = *(const float4*)(B + (size_t)(k0 + kr) * ldb + n0 + nc);
            *(float4*)&Bs[kr][nc] = v;
        }
        __syncthreads();
#pragma unroll
        for (int k = 0; k < 16; ++k) {
            float4 a = *(const float4*)&As[k][ty * 4];
            float4 b = *(const float4*)&Bs[k][tx * 4];
            float av[4] = {a.x, a.y, a.z, a.w}, bv[4] = {b.x, b.y, b.z, b.w};
#pragma unroll
            for (int i = 0; i < 4; ++i)
#pragma unroll
                for (int j = 0; j < 4; ++j) acc[i][j] += av[i] * bv[j];
        }
        __syncthreads();
    }
#pragma unroll
    for (int i = 0; i < 4; ++i) {
        int r = m0 + ty * 4 + i;
        if (r >= M) continue;
        int c = n0 + tx * 4;
        if (c >= N) continue;
        float4* p = (float4*)(C + (size_t)r * ldc + c);
        float4 o = make_float4(acc[i][0], acc[i][1], acc[i][2], acc[i][3]);
        if (ACC) { float4 old = *p; o.x += old.x; o.y += old.y; o.z += old.z; o.w += old.w; }
        *p = o;
    }
}

__global__ void k_qk_prep(float* __restrict__ Q, const float* __restrict__ KV, const float* __restrict__ Z, float* __restrict__ Kout,
                          const float* __restrict__ g_qh, const float* __restrict__ g_kh, int rows, int ns) {
    int gw = blockIdx.x * (blockDim.x >> 6) + (threadIdx.x >> 6), lane = threadIdx.x & 63;
    if (gw >= rows * ATTN_HEADS) return;
    int row = gw / ATTN_HEADS, h = gw % ATTN_HEADS;
    int s = row % ns;
    float q0 = Q[(size_t)row * 768 + h * 96 + lane];
    float q1 = (lane < 32) ? Q[(size_t)row * 768 + h * 96 + 64 + lane] : 0.f;
    float k0 = KV[(size_t)row * 1024 + h * 128 + lane];
    float k1 = (lane < 32) ? Z[(size_t)row * IN_COLS + OFF_KR + lane] : 0.f;
    float sq = wsum(q0 * q0 + q1 * q1), sk = wsum(k0 * k0 + k1 * k1);
    float rq = rsqrtf(sq / 96.f + EPS), rk = rsqrtf(sk / 96.f + EPS);
    q0 = q0 * rq * g_qh[lane]; k0 = k0 * rk * g_kh[lane];
    if (lane < 32) { q1 = q1 * rq * g_qh[64 + lane]; k1 = k1 * rk * g_kh[64 + lane]; }
    float q1o = __shfl_xor(q1, 16), k1o = __shfl_xor(k1, 16);
    if (lane < 32) {
        int j = lane & 15;
        float inv = 1.0f / powf(10000.0f, (float)(2 * j) / 32.0f);
        float ang = (float)s * inv;
        float c = cosf(ang), sn = sinf(ang);
        float qr, kr;
        if (lane < 16) { qr = q1 * c - q1o * sn; kr = k1 * c - k1o * sn; }
        else           { qr = q1o * sn + q1 * c; kr = k1o * sn + k1 * c; }
        Q[(size_t)row * 768 + h * 96 + 64 + lane] = qr;
        Kout[(size_t)row * 768 + h * 96 + 64 + lane] = kr;
    }
    Q[(size_t)row * 768 + h * 96 + lane] = q0;
    Kout[(size_t)row * 768 + h * 96 + lane] = k0;
}

__global__ void __launch_bounds__(64) k_attn(const float* __restrict__ Q, const float* __restrict__ K, const float* __restrict__ KV, float* __restrict__ A, int nb, int ns) {
    const int lane = threadIdx.x;
    const int qblocks = ns / 64;
    int bid = blockIdx.x;
    const int qb = qblocks - 1 - (bid % qblocks); bid /= qblocks;
    const int h = bid % ATTN_HEADS, b = bid / ATTN_HEADS;
    const int qpos = qb * 64 + lane;
    const size_t row = (size_t)b * ns + qpos;
    float q[96], o[64];
    const float sc = 0.10206207261596577f * 1.4426950408889634f;
#pragma unroll
    for (int d = 0; d < 96; ++d) q[d] = Q[row * 768 + h * 96 + d] * sc;
#pragma unroll
    for (int d = 0; d < 64; ++d) o[d] = 0.f;
    float m = -1e30f, l = 0.f;
    const int kend = qb * 64 + 64;
    const float* Kb = K + (size_t)b * ns * 768 + h * 96;
    const float* Vb = KV + (size_t)b * ns * 1024 + h * 128 + 64;
    for (int k0 = 0; k0 < kend; k0 += 4) {
        float s[4];
#pragma unroll
        for (int j = 0; j < 4; ++j) {
            const float* kr = Kb + (size_t)(k0 + j) * 768;
            float a = 0.f;
#pragma unroll
            for (int d = 0; d < 96; ++d) a += q[d] * kr[d];
            s[j] = (k0 + j <= qpos) ? a : -1e30f;
        }
        float mb = fmaxf(fmaxf(s[0], s[1]), fmaxf(s[2], s[3]));
        float mn = fmaxf(m, mb);
        float alpha = exp2f(m - mn);
        m = mn; l *= alpha;
#pragma unroll
        for (int d = 0; d < 64; ++d) o[d] *= alpha;
#pragma unroll
        for (int j = 0; j < 4; ++j) {
            float p = (k0 + j <= qpos) ? exp2f(s[j] - mn) : 0.f;
            l += p;
            const float* vr = Vb + (size_t)(k0 + j) * 1024;
#pragma unroll
            for (int d = 0; d < 64; ++d) o[d] += p * vr[d];
        }
    }
    float il = 1.0f / l;
#pragma unroll
    for (int d = 0; d < 64; ++d) A[row * 512 + h * 64 + d] = o[d] * il;
}

__global__ void k_sg_prep(const float* __restrict__ Z, const float* __restrict__ ln_g, const float* __restrict__ ln_b, float* __restrict__ U, float* __restrict__ VS, int rows) {
    int gw = blockIdx.x * (blockDim.x >> 6) + (threadIdx.x >> 6), lane = threadIdx.x & 63;
    if (gw >= rows * SG_G) return;
    int row = gw / SG_G, g = gw % SG_G;
    float u = gelu_tanh(Z[(size_t)row * IN_COLS + OFF_SG + g * 64 + lane]);
    float v = gelu_tanh(Z[(size_t)row * IN_COLS + OFF_SG + SG_W + g * 64 + lane]);
    float mu = wsum(v) / 64.f;
    float xc = v - mu;
    float var = wsum(xc * xc) / 64.f;
    float y = xc * rsqrtf(var + EPS) * ln_g[g * 64 + lane] + ln_b[g * 64 + lane];
    U[(size_t)row * 256 + g * 64 + lane] = u;
    VS[(size_t)row * 256 + g * 64 + lane] = y;
}
__global__ void k_sg_mix(const float* __restrict__ U, const float* __restrict__ VS, const float* __restrict__ w, const float* __restrict__ bsg, float* __restrict__ G, int rows) {
    size_t idx = (size_t)blockIdx.x * blockDim.x + threadIdx.x;
    if (idx >= (size_t)rows * 256) return;
    int row = (int)(idx >> 8), c = (int)(idx & 255), g = c >> 6;
    int t = row & 127, r0 = row - t;
    const float* wr = w + ((size_t)g * 128 + t) * 128;
    float acc = 0.f;
    for (int s = 0; s <= t; ++s) acc += wr[s] * VS[(size_t)(r0 + s) * 256 + c];
    G[idx] = U[idx] * (acc + bsg[g * 128 + t]);
}

__global__ void __launch_bounds__(64) k_s5(const float* __restrict__ Z, const float* __restrict__ lam_re, const float* __restrict__ lam_im, const float* __restrict__ log_dt,
                     const float* __restrict__ b_re, const float* __restrict__ b_im, const float* __restrict__ c_re, const float* __restrict__ c_im,
                     const float* __restrict__ dsk, float* __restrict__ GG, int nb, int ns) {
    const int lane = threadIdx.x, g = blockIdx.x % SSM_G, b = blockIdx.x / SSM_G;
    const int n = lane;
    float lr = fminf(lam_re[g * 64 + n], -1e-4f), li = lam_im[g * 64 + n], dt = expf(log_dt[g * 64 + n]);
    float mag = expf(lr * dt);
    float are = mag * cosf(li * dt), aim = mag * sinf(li * dt);
    float den = lr * lr + li * li;
    float nr = are - 1.0f, ni = aim;
    float fr = (nr * lr + ni * li) / den, fi = (ni * lr - nr * li) / den;
    float bbr[16], bbi[16], cr[16], ci[16];
#pragma unroll
    for (int c = 0; c < 16; ++c) {
        float br = b_re[((size_t)g * 64 + n) * 16 + c], bi = b_im[((size_t)g * 64 + n) * 16 + c];
        bbr[c] = fr * br - fi * bi; bbi[c] = fr * bi + fi * br;
        cr[c] = c_re[((size_t)g * 16 + c) * 64 + n]; ci[c] = c_im[((size_t)g * 16 + c) * 64 + n];
    }
    float dval = (lane < 16) ? dsk[g * 16 + lane] : 0.f;
    float hr = 0.f, hi = 0.f;
    for (int s = 0; s < ns; ++s) {
        const size_t row = (size_t)b * ns + s;
        const float* xr = Z + row * IN_COLS + OFF_SSM + g * 16;
        float xv = (lane < 16) ? xr[lane] : 0.f;
        float ur = 0.f, ui = 0.f;
#pragma unroll
        for (int c = 0; c < 16; ++c) { float xc = __shfl(xv, c); ur += bbr[c] * xc; ui += bbi[c] * xc; }
        float nhr = are * hr - aim * hi + ur;
        float nhi = are * hi + aim * hr + ui;
        hr = nhr; hi = nhi;
        float yo = 0.f;
#pragma unroll
        for (int c = 0; c < 16; ++c) {
            float v = wsum(cr[c] * hr - ci[c] * hi);
            if (lane == c) yo = v;
        }
        if (lane < 16) { float y = yo + dval * xv; GG[row * 256 + g * 16 + lane] = gelu_tanh(y); }
    }
}
__global__ void k_glu(const float* __restrict__ GG, const float* __restrict__ T1, const float* __restrict__ bg, float* __restrict__ S, size_t n) {
    size_t idx = (size_t)blockIdx.x * blockDim.x + threadIdx.x;
    if (idx >= n) return;
    S[idx] = GG[idx] * sigmoidf_(T1[idx] + bg[idx & 255]);
}
__global__ void k_router(const float* __restrict__ XN, const float* __restrict__ w_rg, const float* __restrict__ b_rg, const float* __restrict__ w_re, const float* __restrict__ b_re,
                         int* __restrict__ sel, float* __restrict__ wgt, int rows) {
    int row = blockIdx.x * (blockDim.x >> 6) + (threadIdx.x >> 6), lane = threadIdx.x & 63;
    if (row >= rows) return;
    const float* x = XN + (size_t)row * 1024;
    float gl[4] = {0.f, 0.f, 0.f, 0.f};
    for (int k = lane; k < 1024; k += 64) { float xv = x[k];
#pragma unroll
        for (int j = 0; j < 4; ++j) gl[j] += xv * w_rg[k * 4 + j]; }
#pragma unroll
    for (int j = 0; j < 4; ++j) gl[j] = wsum(gl[j]) + b_rg[j];
    int gs = 0; float gm = gl[0];
#pragma unroll
    for (int j = 1; j < 4; ++j) if (gl[j] > gm) { gm = gl[j]; gs = j; }
    float se = 0.f;
#pragma unroll
    for (int j = 0; j < 4; ++j) se += expf(gl[j] - gm);
    float gw = 1.0f / se;
    float el[8];
#pragma unroll
    for (int j = 0; j < 8; ++j) el[j] = 0.f;
    for (int k = lane; k < 1024; k += 64) { float xv = x[k];
#pragma unroll
        for (int j = 0; j < 8; ++j) el[j] += xv * w_re[k * 32 + gs * 8 + j]; }
#pragma unroll
    for (int j = 0; j < 8; ++j) el[j] = wsum(el[j]) + b_re[gs * 8 + j];
    int i0 = 0; float v0 = el[0];
#pragma unroll
    for (int j = 1; j < 8; ++j) if (el[j] > v0) { v0 = el[j]; i0 = j; }
    int i1 = -1; float v1 = -3.4e38f;
#pragma unroll
    for (int j = 0; j < 8; ++j) if (j != i0 && el[j] > v1) { v1 = el[j]; i1 = j; }
    float e1 = expf(v1 - v0);
    float w0 = 1.0f / (1.0f + e1), w1 = e1 / (1.0f + e1);
    if (lane == 0) { sel[row * 2] = gs * 8 + i0; sel[row * 2 + 1] = gs * 8 + i1; wgt[row * 2] = w0 * gw; wgt[row * 2 + 1] = w1 * gw; }
}
__global__ void __launch_bounds__(256) k_moe(const float* __restrict__ XN, const int* __restrict__ sel, const float* __restrict__ wgt,
                                             const float* __restrict__ w1, const float* __restrict__ w3, const float* __restrict__ w2, float* __restrict__ H, int rows) {
    __shared__ float xs[1024];
    __shared__ float hb[256];
    const int row = blockIdx.x, tid = threadIdx.x;
    for (int k = tid; k < 1024; k += 256) xs[k] = XN[(size_t)row * 1024 + k];
    float out[4] = {0.f, 0.f, 0.f, 0.f};
    for (int kk = 0; kk < 2; ++kk) {
        const int e = sel[row * 2 + kk]; const float w = wgt[row * 2 + kk];
        __syncthreads();
        const float* a1 = w1 + (size_t)e * 1024 * 256 + tid; const float* a3 = w3 + (size_t)e * 1024 * 256 + tid;
        float s1 = 0.f, s3 = 0.f;
        for (int k = 0; k < 1024; ++k) { float xv = xs[k]; s1 += xv * a1[(size_t)k * 256]; s3 += xv * a3[(size_t)k * 256]; }
        hb[tid] = (s1 * sigmoidf_(s1)) * s3;
        __syncthreads();
        const float* a2 = w2 + (size_t)e * 256 * 1024;
        float y[4] = {0.f, 0.f, 0.f, 0.f};
        for (int j = 0; j < 256; ++j) { float hv = hb[j];
#pragma unroll
            for (int c = 0; c < 4; ++c) y[c] += hv * a2[(size_t)j * 1024 + tid + c * 256]; }
#pragma unroll
        for (int c = 0; c < 4; ++c) out[c] += w * y[c];
    }
#pragma unroll
    for (int c = 0; c < 4; ++c) H[(size_t)row * 1024 + tid + c * 256] += out[c];
}
__global__ void k_ple(float* __restrict__ H, const float* __restrict__ T1, const float* __restrict__ bpg, const float* __restrict__ T2, int ld2, size_t n) {
    size_t idx = (size_t)blockIdx.x * blockDim.x + threadIdx.x;
    if (idx >= n) return;
    size_t r = idx >> 10; int c = (int)(idx & 1023);
    H[idx] += sigmoidf_(T1[idx] + bpg[c]) * T2[r * ld2 + c];
}
__global__ void k_copy(const float* __restrict__ a, float* __restrict__ b, size_t n) {
    size_t idx = (size_t)blockIdx.x * blockDim.x + threadIdx.x;
    if (idx < n) b[idx] = a[idx];
}

struct Bufs { float *H, *XN, *Z, *Q, *KV, *K, *A, *ZQ, *ZKV, *U, *VS, *G, *GG, *S; int* sel; float* wgt; };
static size_t bufs_bytes(size_t R) { return R * 4 * (1024 + 1440 + 768 + 1024 + 768 + 512) + (1 << 20); }
static Bufs carve(float* H, char* base, size_t R) {
    Bufs b; b.H = H; char* p = base;
    b.XN = (float*)p; p += R * 1024 * 4;
    b.Z = (float*)p; p += R * 1440 * 4;
    b.Q = (float*)p; p += R * 768 * 4;
    b.KV = (float*)p; p += R * 1024 * 4;
    b.K = (float*)p; p += R * 768 * 4;
    b.A = (float*)p; p += R * 512 * 4;
    b.sel = (int*)p; b.wgt = (float*)(p + (512 << 10));
    b.ZQ = b.K; b.ZKV = b.K + R * 384;
    b.U = b.Q; b.VS = b.Q + R * 256; b.G = b.Q + R * 512;
    b.GG = b.KV; b.S = b.KV + R * 256;
    return b;
}
static void gemm(hipStream_t st, const float* A, int lda, const float* B, int ldb, float* C, int ldc, int M, int N, int K, bool acc) {
    dim3 g((N + 63) / 64, (M + 63) / 64);
    if (acc) hipLaunchKernelGGL(k_gemm<1>, g, dim3(256), 0, st, A, lda, B, ldb, C, ldc, M, N, K);
    else hipLaunchKernelGGL(k_gemm<0>, g, dim3(256), 0, st, A, lda, B, ldb, C, ldc, M, N, K);
}
static void layer(hipStream_t st, void* const* d_in, int i, const Bufs& B, int nb, int ns) {
    const int R = nb * ns;
#define IN(k, per) ((const float*)d_in[k] + (size_t)i * (per))
    hipLaunchKernelGGL(k_rmsnorm, dim3((R + 3) / 4), dim3(256), 0, st, B.H, 1024, IN(2, 1024), B.XN, 1024, 1024, R);
    gemm(st, B.XN, 1024, IN(3, 1024 * 1440), 1440, B.Z, 1440, R, 1440, 1024, false);
    hipLaunchKernelGGL(k_rmsnorm, dim3((R + 3) / 4), dim3(256), 0, st, B.Z, 1440, IN(4, 384), B.ZQ, 384, 384, R);
    hipLaunchKernelGGL(k_rmsnorm, dim3((R + 3) / 4), dim3(256), 0, st, B.Z + OFF_KV, 1440, IN(5, 256), B.ZKV, 256, 256, R);
    gemm(st, B.ZQ, 384, IN(6, 384 * 768), 768, B.Q, 768, R, 768, 384, false);
    gemm(st, B.ZKV, 256, IN(7, 256 * 1024), 1024, B.KV, 1024, R, 1024, 256, false);
    hipLaunchKernelGGL(k_qk_prep, dim3((R * 8 + 3) / 4), dim3(256), 0, st, B.Q, B.KV, B.Z, B.K, IN(8, 96), IN(9, 96), R, ns);
    hipLaunchKernelGGL(k_attn, dim3(nb * 8 * (ns / 64)), dim3(64), 0, st, B.Q, B.K, B.KV, B.A, nb, ns);
    hipLaunchKernelGGL(k_sg_prep, dim3((R * 4 + 3) / 4), dim3(256), 0, st, B.Z, IN(10, 256), IN(11, 256), B.U, B.VS, R);
    hipLaunchKernelGGL(k_sg_mix, dim3((unsigned)(((size_t)R * 256 + 255) / 256)), dim3(256), 0, st, B.U, B.VS, IN(12, 4 * 128 * 128), IN(13, 4 * 128), B.G, R);
    hipLaunchKernelGGL(k_s5, dim3(nb * 16), dim3(64), 0, st, B.Z, IN(14, 1024), IN(15, 1024), IN(16, 1024), IN(17, 16384), IN(18, 16384), IN(19, 16384), IN(20, 16384), IN(21, 256), B.GG, nb, ns);
    gemm(st, B.GG, 256, IN(22, 65536), 256, B.S, 256, R, 256, 256, false);
    hipLaunchKernelGGL(k_glu, dim3((unsigned)(((size_t)R * 256 + 255) / 256)), dim3(256), 0, st, B.GG, B.S, IN(23, 256), B.S, (size_t)R * 256);
    hipLaunchKernelGGL(k_rmsnorm, dim3((R + 3) / 4), dim3(256), 0, st, B.A, 512, IN(24, 1024), B.XN, 1024, 512, R);
    hipLaunchKernelGGL(k_rmsnorm, dim3((R + 3) / 4), dim3(256), 0, st, B.G, 256, IN(24, 1024) + 512, B.XN + 512, 1024, 256, R);
    hipLaunchKernelGGL(k_rmsnorm, dim3((R + 3) / 4), dim3(256), 0, st, B.S, 256, IN(24, 1024) + 768, B.XN + 768, 1024, 256, R);
    gemm(st, B.XN, 1024, IN(25, 1024 * 1024), 1024, B.H, 1024, R, 1024, 1024, true);
    hipLaunchKernelGGL(k_rmsnorm, dim3((R + 3) / 4), dim3(256), 0, st, B.H, 1024, IN(26, 1024), B.XN, 1024, 1024, R);
    hipLaunchKernelGGL(k_router, dim3((R + 3) / 4), dim3(256), 0, st, B.XN, IN(27, 4096), IN(28, 4), IN(29, 32768), IN(30, 32), B.sel, B.wgt, R);
    hipLaunchKernelGGL(k_moe, dim3(R), dim3(256), 0, st, B.XN, B.sel, B.wgt, IN(31, 32 * 1024 * 256), IN(32, 32 * 1024 * 256), IN(33, 32 * 256 * 1024), B.H, R);
    gemm(st, B.H, 1024, IN(34, 1024 * 1024), 1024, B.XN, 1024, R, 1024, 1024, false);
    gemm(st, (const float*)d_in[1] + (size_t)i * BATCH * SEQ * 256, 256, IN(36, 256 * 1024), 1024, B.Z, 1440, R, 1024, 256, false);
    hipLaunchKernelGGL(k_ple, dim3((unsigned)(((size_t)R * 1024 + 255) / 256)), dim3(256), 0, st, B.H, B.XN, IN(35, 1024), B.Z, 1440, (size_t)R * 1024);
#undef IN
}
}
extern "C" void kernel_launch(void* const* d_in, const int* in_sizes, int n_in, void* d_out, int out_size, void* d_ws, size_t ws_size, hipStream_t stream) {
    const size_t R = (size_t)nv::BATCH * nv::SEQ;
    if (n_in != 37 || ws_size < nv::bufs_bytes(R)) { fprintf(stderr, "kernel_launch: n_in %d ws %zu need %zu\n", n_in, ws_size, nv::bufs_bytes(R)); return; }
    hipMemcpyAsync(d_out, d_in[0], R * 1024 * 4, hipMemcpyDeviceToDevice, stream);
    nv::Bufs B = nv::carve((float*)d_out, (char*)d_ws, R);
    for (int i = 0; i < nv::DEPTH; ++i) nv::layer(stream, d_in, i, B, nv::BATCH, nv::SEQ);
}
```

```cpp
#define DBG 0
#ifndef DBG
#define DBG 0
#endif
#ifndef MK_STRONG_BAR
#define MK_STRONG_BAR 1
#endif
#ifndef MK_BAR_SCOPE
#define MK_BAR_SCOPE ""
#endif
#include <hip/hip_runtime.h>
#include <hip/hip_bf16.h>
#include <cstdio>
#include <cstdint>
#include <cmath>
#define LAS __attribute__((address_space(3)))
__device__ __forceinline__ int opaque_tid() { int t = (int)threadIdx.x; asm volatile("" : "+v"(t)); return t; }
namespace pg8 {
#define PG8_LAS __attribute__((address_space(3)))
typedef unsigned short bf16_t;
typedef short bf16x8 __attribute__((ext_vector_type(8)));
typedef float f32x4 __attribute__((ext_vector_type(4)));
typedef unsigned u32x4 __attribute__((ext_vector_type(4)));
constexpr int BM = 256, BK = 64, HALF = 128, HTB = HALF * BK * 2  , STAGE_BYTES = 8 * HTB, NXCD = 8, WGM = 8;

__host__ __device__ __forceinline__ int lds_byte(int r, int c) { const int st = (r >> 4) * 2 + (c >> 5), rr = r & 15, cc = c & 31, ob = rr * 64 + cc * 2; return st * 1024 + (ob ^ (((ob >> 9) & 1) << 5)); }
__host__ __device__ __forceinline__ void stage_rc(int b, int& R, int& C) { const int st = b / 1024, sb = b % 1024, swz = sb ^ (((sb >> 9) & 1) << 5); R = (st >> 1) * 16 + swz / 64; C = (st & 1) * 32 + (swz % 64) / 2; }
__host__ __device__ __forceinline__ int perm32(int rho) { const int n = rho >> 4, i = rho & 15; return 8 * (i >> 2) + 4 * n + (i & 3); }

struct Unit { int pm, pn; };
struct Gemm { const bf16_t* A; const bf16_t* Bt; int M, N, K; };

struct StaticOrder {
    int nM, nN, nwg, G, c;
    __host__ __device__ void init(int M, int N, int G_, int c_) { nM = M / BM; nN = N / BM; nwg = nM * nN; G = G_; c = c_; }
    __host__ __device__ bool next(int i, Unit& u) const {
        const long L = (long)i * G + c; if (L >= nwg) return false;
        int wgid = (int)L; { const int q = nwg / NXCD, r = nwg % NXCD, xcd = wgid % NXCD, off = wgid / NXCD; wgid = (xcd < r ? xcd * (q + 1) : r * (q + 1) + (xcd - r) * q) + off; }
        const int nig = WGM * nN, gid = wgid / nig, fm = gid * WGM, gsz = (nM - fm) < WGM ? (nM - fm) : WGM;
        u.pm = fm + ((wgid % nig) % gsz); u.pn = (wgid % nig) / gsz; return true;
    }
    __device__ __forceinline__ void a_ready(const Unit&) const {}
    __device__ __forceinline__ void done(const Unit&) const {}
};

__device__ __forceinline__ unsigned cvt_pk_bf16(float lo, float hi) { unsigned r; asm volatile("v_cvt_pk_bf16_f32 %0, %1, %2" : "=v"(r) : "v"(lo), "v"(hi)); return r; }
typedef float f32x2 __attribute__((ext_vector_type(2)));
template <class Epi, class Sched, bool ALIGN_EPI = false, bool SP2 = false>
__device__ __forceinline__ void gemm_phase(PG8_LAS unsigned char* lds, const Gemm g, const Sched& S, const Epi& E) {
    const int tid = opaque_tid(), wid = __builtin_amdgcn_readfirstlane(tid >> 6), lane = tid & 63, wr = wid >> 2, wc = wid & 3, fr = lane & 15, fq = lane >> 4;
    const int K = g.K, nt = K / BK;
    unsigned voffA[2], voffB[2];
#pragma unroll
    for (int i = 0; i < 2; ++i) { int R, C; stage_rc(tid * 16 + i * 8192, R, C); const int Rb = Epi::PERM ? ((R & ~31) + perm32(R & 31)) : R;
        voffA[i] = (unsigned)(R * K + C) * 2u; voffB[i] = (unsigned)(Rb * K + C) * 2u; }
    const size_t kstep = (size_t)(BK * 2);
    const size_t hstep = (size_t)HALF * K * 2;
    const size_t tstep = 2 * hstep;
    const unsigned ldsw = (unsigned)wid * 1024u;
    const int aoff = lds_byte(wr * 64 + fr, fq * 8), boff = lds_byte(wc * 32 + fr, fq * 8);
#define PG8_SA(b, h) (((b) * 2 + (h)) * HTB)
#define PG8_SB(b, h) ((4 + (b) * 2 + (h)) * HTB)
#define PG8_STAGE(bufoff, gbase, voff) do { _Pragma("unroll") for (int _i = 0; _i < 2; ++_i) \
        __builtin_amdgcn_global_load_lds((const unsigned*)((const char*)(gbase) + (voff)[_i]), (PG8_LAS unsigned*)(lds + (bufoff) + ldsw + _i * 8192), 16, 0, 0); } while (0)
#define PG8_LDA(dst, b, h) do { _Pragma("unroll") for (int m = 0; m < 4; ++m) _Pragma("unroll") for (int k = 0; k < 2; ++k) dst[m][k] = *(const PG8_LAS bf16x8*)(lds + PG8_SA(b, h) + aoff + m * 2048 + k * 1024); } while (0)
#define PG8_LDB(dst, b, h) do { _Pragma("unroll") for (int n = 0; n < 2; ++n) _Pragma("unroll") for (int k = 0; k < 2; ++k) dst[n][k] = *(const PG8_LAS bf16x8*)(lds + PG8_SB(b, h) + boff + n * 2048 + k * 1024); } while (0)
#define PG8_MMA(ai, bj, At, Bt) do { __builtin_amdgcn_s_setprio(1); _Pragma("unroll") for (int m = 0; m < 4; ++m) _Pragma("unroll") for (int n = 0; n < 2; ++n) _Pragma("unroll") for (int k = 0; k < 2; ++k) \
        acc[ai][bj][m][n] = __builtin_amdgcn_mfma_f32_16x16x32_bf16(Bt[n][k], At[m][k], acc[ai][bj][m][n], 0, 0, 0); __builtin_amdgcn_s_setprio(0); } while (0)
#define PG8_WAIT_V(n) asm volatile("s_waitcnt vmcnt(" #n ")" ::: "memory")
#define PG8_WAIT_L(n) asm volatile("s_waitcnt lgkmcnt(" #n ")" ::: "memory")
#define PG8_BAR __builtin_amdgcn_s_barrier()
#define PG8_SCHED __builtin_amdgcn_sched_barrier(0)
    Unit cur, nxt; int ui = 0;
    if (!S.next(0, cur)) return;
    f32x4 acc[2][2][4][2];
#pragma unroll
    for (int a = 0; a < 2; ++a)
#pragma unroll
        for (int b = 0; b < 2; ++b)
#pragma unroll
            for (int m = 0; m < 4; ++m)
#pragma unroll
                for (int n = 0; n < 2; ++n) acc[a][b][m][n] = (f32x4){0.f, 0.f, 0.f, 0.f};
    bf16x8 At[4][2], B0[2][2], B1[2][2];
    const char* cA = (const char*)g.A + (size_t)cur.pm * tstep; const char* cB = (const char*)g.Bt + (size_t)cur.pn * tstep;
    S.a_ready(cur);
    if constexpr (SP2) {
        PG8_STAGE(PG8_SB(0, 0), cB, voffB); PG8_STAGE(PG8_SB(0, 1), cB + hstep, voffB); PG8_STAGE(PG8_SA(0, 0), cA, voffA); PG8_STAGE(PG8_SA(0, 1), cA + hstep, voffA);
        if (wr == 1) PG8_BAR;
        PG8_WAIT_V(2); PG8_BAR;
        PG8_STAGE(PG8_SB(1, 0), cB + kstep, voffB); PG8_STAGE(PG8_SA(1, 0), cA + kstep, voffA); PG8_STAGE(PG8_SB(1, 1), cB + hstep + kstep, voffB);
        PG8_WAIT_V(6); PG8_BAR;
    } else {
        PG8_STAGE(PG8_SB(0, 0), cB, voffB); PG8_STAGE(PG8_SA(0, 0), cA, voffA); PG8_STAGE(PG8_SB(0, 1), cB + hstep, voffB); PG8_STAGE(PG8_SA(0, 1), cA + hstep, voffA);
        if (wr == 1) PG8_BAR;
        PG8_WAIT_V(4); PG8_BAR;
        PG8_STAGE(PG8_SB(1, 0), cB + kstep, voffB); PG8_STAGE(PG8_SA(1, 0), cA + kstep, voffA); PG8_STAGE(PG8_SB(1, 1), cB + hstep + kstep, voffB);
        PG8_WAIT_V(6); PG8_BAR;
    }
    for (;;) {
        const bool has_next = S.next(ui + 1, nxt);
        const char* nA = has_next ? (const char*)g.A + (size_t)nxt.pm * tstep : cA; const char* nB = has_next ? (const char*)g.Bt + (size_t)nxt.pn * tstep : cB;
        _Pragma("nounroll") for (int t = 0; t < nt; t += 2) {
            const bool last = (t == nt - 2);
            const char* a1 = cA + (size_t)(t + 1) * kstep;
            const char* a2 = last ? nA : cA + (size_t)(t + 2) * kstep; const char* b2 = last ? nB : cB + (size_t)(t + 2) * kstep;
            const char* a3 = a2 + kstep; const char* b3 = b2 + kstep;
            if (last && has_next) S.a_ready(nxt);
            if constexpr (SP2) {
            PG8_LDB(B0, 0, 0); PG8_LDB(B1, 0, 1); PG8_SCHED; PG8_LDA(At, 0, 0); PG8_STAGE(PG8_SA(1, 1), a1 + hstep, voffA);
            PG8_WAIT_V(8); PG8_WAIT_L(0); PG8_BAR; PG8_MMA(0, 0, At, B0); PG8_MMA(0, 1, At, B1); PG8_BAR; PG8_SCHED;
            PG8_LDA(At, 0, 1); PG8_STAGE(PG8_SB(0, 0), b2, voffB); PG8_STAGE(PG8_SB(0, 1), b2 + hstep, voffB); PG8_STAGE(PG8_SA(0, 0), a2, voffA);
            PG8_WAIT_V(8); PG8_WAIT_L(0); PG8_BAR; PG8_MMA(1, 0, At, B0); PG8_MMA(1, 1, At, B1); PG8_BAR; PG8_SCHED;
            PG8_LDB(B0, 1, 0); PG8_LDB(B1, 1, 1); PG8_SCHED; PG8_LDA(At, 1, 0); PG8_STAGE(PG8_SA(0, 1), a2 + hstep, voffA);
            PG8_WAIT_V(8); PG8_WAIT_L(0); PG8_BAR; PG8_MMA(0, 0, At, B0); PG8_MMA(0, 1, At, B1); PG8_BAR; PG8_SCHED;
            PG8_LDA(At, 1, 1); PG8_STAGE(PG8_SB(1, 0), b3, voffB); PG8_STAGE(PG8_SB(1, 1), b3 + hstep, voffB); PG8_STAGE(PG8_SA(1, 0), a3, voffA);
            PG8_WAIT_V(8); PG8_WAIT_L(0); PG8_BAR; PG8_MMA(1, 0, At, B0); PG8_MMA(1, 1, At, B1); PG8_BAR; PG8_SCHED;
            } else {
            PG8_LDB(B0, 0, 0); PG8_SCHED; PG8_LDA(At, 0, 0); PG8_STAGE(PG8_SA(1, 1), a1 + hstep, voffA);
            PG8_WAIT_L(8); PG8_BAR; PG8_WAIT_L(0); PG8_MMA(0, 0, At, B0); PG8_BAR; PG8_SCHED;
            PG8_LDB(B1, 0, 1); PG8_STAGE(PG8_SB(0, 0), b2, voffB);
            PG8_BAR; PG8_WAIT_L(0); PG8_MMA(0, 1, At, B1); PG8_BAR;
            PG8_LDA(At, 0, 1); PG8_STAGE(PG8_SA(0, 0), a2, voffA);
            PG8_BAR; PG8_WAIT_L(0); PG8_MMA(1, 0, At, B0); PG8_BAR; PG8_SCHED;
            PG8_STAGE(PG8_SB(0, 1), b2 + hstep, voffB);
            PG8_WAIT_V(6); PG8_BAR; PG8_MMA(1, 1, At, B1); PG8_BAR;
            PG8_LDB(B0, 1, 0); PG8_SCHED; PG8_LDA(At, 1, 0); PG8_STAGE(PG8_SA(0, 1), a2 + hstep, voffA);
            PG8_WAIT_L(8); PG8_BAR; PG8_WAIT_L(0); PG8_MMA(0, 0, At, B0); PG8_BAR; PG8_SCHED;
            PG8_LDB(B1, 1, 1); PG8_STAGE(PG8_SB(1, 0), b3, voffB);
            PG8_BAR; PG8_WAIT_L(0); PG8_MMA(0, 1, At, B1); PG8_BAR;
            PG8_LDA(At, 1, 1); PG8_STAGE(PG8_SA(1, 0), a3, voffA);
            PG8_BAR; PG8_WAIT_L(0); PG8_MMA(1, 0, At, B0); PG8_BAR; PG8_SCHED;
            PG8_STAGE(PG8_SB(1, 1), b3 + hstep, voffB);
            PG8_WAIT_V(6); PG8_BAR; PG8_MMA(1, 1, At, B1); PG8_BAR;
            }
        }
        if constexpr (ALIGN_EPI) { if (wr == 0) PG8_BAR; }
        if constexpr (!Epi::AFTER_DRAIN) { E(acc, cur, wr, wc, fr, fq); S.done(cur); }
        if (!has_next) break;
#pragma unroll
        for (int a = 0; a < 2; ++a)
#pragma unroll
            for (int b = 0; b < 2; ++b)
#pragma unroll
                for (int m = 0; m < 4; ++m)
#pragma unroll
                    for (int n = 0; n < 2; ++n) acc[a][b][m][n] = (f32x4){0.f, 0.f, 0.f, 0.f};
        cur = nxt; cA = nA; cB = nB; ++ui;
        if constexpr (ALIGN_EPI) { if (wr == 1) PG8_BAR; }
    }
    PG8_WAIT_V(0);
    if constexpr (!ALIGN_EPI) { if (wr == 0) PG8_BAR; }
    PG8_BAR;
    if constexpr (Epi::AFTER_DRAIN) { E.fused(acc, cur, wr, wc, fr, fq, lds, wid, lane); S.done(cur); }
#undef PG8_SA
#undef PG8_SB
#undef PG8_STAGE
#undef PG8_LDA
#undef PG8_LDB
#undef PG8_MMA
#undef PG8_WAIT_V
#undef PG8_WAIT_L
#undef PG8_BAR
#undef PG8_SCHED
}
}
#define XB_TMO      128
#define XB_XCNT(j)  (256  + 64 * (j))
#define XB_XSUB(j)  (1280 + 64 * (j))
#define XB_XGEN(j)  (2304 + 64 * (j))
#define XB_TOP      3328
#define XB_TOPGEN   3392
#define XCD_BAR_WORDS 3456
#define XB_SPIN_CAP (1u << 18)

__device__ __forceinline__ unsigned xb_ld(unsigned* p)              { return __hip_atomic_load(p, __ATOMIC_RELAXED, __HIP_MEMORY_SCOPE_AGENT); }
__device__ __forceinline__ unsigned xb_add(unsigned* p, unsigned v) { return __hip_atomic_fetch_add(p, v, __ATOMIC_RELAXED, __HIP_MEMORY_SCOPE_AGENT); }
__device__ __forceinline__ unsigned xb_xcc_id() { return (unsigned)__builtin_amdgcn_s_getreg((3 << 11) | 20) & 0xFu; }
#define XB_SPIN(cond, bar) do { unsigned _sp = 0; while (cond) { __builtin_amdgcn_s_sleep(1); \
    if ((++_sp & 255u) == 0u) { if (xb_ld(&(bar)[XB_TMO])) break; if (_sp > XB_SPIN_CAP) { atomicAdd(&(bar)[XB_TMO], 1u); break; } } } } while (0)

struct XcdBarrier {
    unsigned* bar; unsigned x;
    volatile LAS unsigned* st;
};

__device__ __forceinline__ XcdBarrier xcd_barrier_post(unsigned* bar, volatile LAS unsigned* st) {
    XcdBarrier b; b.bar = bar; b.x = xb_xcc_id(); b.st = st;
    if (threadIdx.x == 0) (void)xb_add(&bar[XB_XCNT(b.x)], 1u);
    return b;
}
__device__ __forceinline__ void xcd_barrier_complete(unsigned* bar, unsigned x, unsigned& nloc, unsigned& nx) {
    const unsigned G = gridDim.x * gridDim.y * gridDim.z;
    unsigned sum, cnt, mine, sp = 0u;
    for (;;) {
        sum = 0u; cnt = 0u; mine = 0u;
#pragma unroll
        for (unsigned j = 0; j < 16; ++j) { const unsigned c = xb_ld(&bar[XB_XCNT(j)]); sum += c; cnt += (c > 0u) ? 1u : 0u; mine = (j == x) ? c : mine; }
        if (sum == G) break;
        __builtin_amdgcn_s_sleep(1);
        if ((++sp & 255u) == 0u) { if (xb_ld(&bar[XB_TMO])) break; if (sp > XB_SPIN_CAP) { atomicAdd(&bar[XB_TMO], 1u); break; } }
    }
    nloc = mine > 0u ? mine : 1u; nx = cnt > 0u ? cnt : 1u;
}

__device__ __forceinline__ void xcd_barrier(const XcdBarrier& b) {
    asm volatile("s_waitcnt vmcnt(0)" ::: "memory");
    __syncthreads();
    if (threadIdx.x == 0) {
        unsigned* bar = b.bar;
        __builtin_amdgcn_s_waitcnt(0);
        unsigned nloc = b.st[0], nx = b.st[1];
        if (nloc == 0u) { xcd_barrier_complete(bar, b.x, nloc, nx); b.st[0] = nloc; b.st[1] = nx; }
#if MK_STRONG_BAR
        __builtin_amdgcn_fence(__ATOMIC_RELEASE, MK_BAR_SCOPE);
        asm volatile("s_waitcnt vmcnt(0)" ::: "memory");
#endif
        const unsigned old = xb_add(&bar[XB_XSUB(b.x)], 1u);
        const unsigned gen = old / nloc;
        if (old + 1u == (gen + 1u) * nloc) {
            __builtin_amdgcn_fence(__ATOMIC_RELEASE, MK_BAR_SCOPE);
            asm volatile("s_waitcnt vmcnt(0)" ::: "memory");
            const unsigned og = xb_add(&bar[XB_TOP], 1u);
            const unsigned tg = og / nx;
            if (og + 1u == (tg + 1u) * nx) xb_add(&bar[XB_TOPGEN], 1u);
            else XB_SPIN(xb_ld(&bar[XB_TOPGEN]) == tg, bar);
            __builtin_amdgcn_fence(__ATOMIC_ACQUIRE, MK_BAR_SCOPE);
            xb_add(&bar[XB_XGEN(b.x)], 1u);
            asm volatile("s_waitcnt vmcnt(0)" ::: "memory");
        } else {
            XB_SPIN(xb_ld(&bar[XB_XGEN(b.x)]) == gen, bar);
            __builtin_amdgcn_fence(__ATOMIC_ACQUIRE, MK_BAR_SCOPE);
            asm volatile("s_waitcnt vmcnt(0)" ::: "memory");
        }
    }
    __syncthreads();
}
namespace mk {
using pg8::bf16_t; using pg8::bf16x8; using pg8::f32x4; using pg8::u32x4; using pg8::Unit; using pg8::Gemm; using pg8::cvt_pk_bf16;
typedef float f32x16 __attribute__((ext_vector_type(16)));
typedef float f32x2v __attribute__((ext_vector_type(2)));
typedef short s16x4 __attribute__((ext_vector_type(4)));
typedef unsigned u32x2 __attribute__((ext_vector_type(2)));
constexpr int T = 32768, S = 16384, NBATCH = 2, DM = 1024, NL = 4, NW = 8;
constexpr int NPMAX = 73728;
constexpr float EPS = 1e-6f;
constexpr size_t MiB = 1u << 20;
constexpr size_t WS_CTL = 0, CTL_ZERO_BYTES = 1 * MiB;
constexpr size_t WS_COS = 1 * MiB, WS_SIN = 2 * MiB, WS_S5T = 3 * MiB, WS_WSG = 4 * MiB, WS_WR = 5 * MiB, WS_WGLU = 6 * MiB;
constexpr size_t WS_WIN = 8 * MiB, WS_WUQ = 20 * MiB, WS_WUKV = 23 * MiB, WS_WOUT = 25 * MiB, WS_WPG = 33 * MiB, WS_WPLE = 41 * MiB, WS_W13 = 43 * MiB, WS_W2T = 75 * MiB;
constexpr size_t WS_SS1 = 91 * MiB, WS_SS2 = 93 * MiB, WS_SSQ = 95 * MiB, WS_SKV = 96 * MiB, WS_SQH = 97 * MiB, WS_SA = 101 * MiB, WS_RS2 = 102 * MiB, WS_KR = 103 * MiB;
constexpr size_t WS_E = 107 * MiB, WS_HS = 111 * MiB, WS_ROUTE = 115 * MiB;
constexpr size_t WS_HBA = 118 * MiB, WS_HBB = 182 * MiB, WS_PB = 246 * MiB;
constexpr size_t WS_ZQ = 262 * MiB, WS_ZKV = 286 * MiB, WS_U = 302 * MiB, WS_VS = 318 * MiB, WS_XS = 334 * MiB, WS_Q = 350 * MiB, WS_K = 398 * MiB, WS_V = 446 * MiB, WS_MIX = 478 * MiB;
constexpr size_t WS_XG = 262 * MiB, WS_HBX = 406 * MiB, WS_Y01 = 442 * MiB, WS_PL = 570 * MiB, WS_END = 634 * MiB;
constexpr size_t RT_CNT = 0, RT_TSTART = 64 << 10, RT_ER = 128 << 10, RT_WGT = 512 << 10, RT_TOK = 1 * MiB, RT_W = 1 * MiB + (512 << 10), RT_RS = 2 * MiB;
constexpr size_t S5T_LAYER = 160 << 10, S5T_AB = 0, S5T_BBT = 16 << 10, S5T_CMT = 80 << 10, S5T_D = 144 << 10;
constexpr int CW_BAR = 4096;
constexpr int RING_BYTES = 131072, EXTRA_OFF = 131072, EXTRA_BYTES = 8192, LDSCTL_OFF = EXTRA_OFF + EXTRA_BYTES, LDS_BYTES = 147456;

#define GAS __attribute__((address_space(1)))
#define LAS __attribute__((address_space(3)))
#define LDS_WAIT() asm volatile("s_waitcnt lgkmcnt(0)" ::: "memory")
#define VM_WAIT() asm volatile("s_waitcnt vmcnt(0)" ::: "memory")
__device__ __forceinline__ unsigned f2bf(float f) { unsigned u = __builtin_bit_cast(unsigned, f); return (u + 0x7fffu + ((u >> 16) & 1u)) >> 16; }
__device__ __forceinline__ unsigned pk2(float lo, float hi) { return cvt_pk_bf16(lo, hi); }
__device__ __forceinline__ float bf2f(unsigned short b) { return __builtin_bit_cast(float, (unsigned)b << 16); }
__device__ __forceinline__ float bflo(unsigned w) { return __builtin_bit_cast(float, w << 16); }
__device__ __forceinline__ float bfhi(unsigned w) { return __builtin_bit_cast(float, w & 0xffff0000u); }
__device__ __forceinline__ float wave_sum(float v) {
#pragma unroll
    for (int o = 1; o < 64; o <<= 1) v += __shfl_xor(v, o);
    return v;
}
__device__ __forceinline__ float fq_sum(float v) { v += __shfl_xor(v, 16); v += __shfl_xor(v, 32); return v; }
__device__ __forceinline__ float gelu_t(float x) {
    const float u2 = 1.5957691216057308f * (x + 0.044715f * x * x * x);
    return x * __builtin_amdgcn_rcpf(1.0f + __builtin_amdgcn_exp2f(-1.4426950408889634f * u2));
}
__device__ __forceinline__ float sigm(float x) { return __builtin_amdgcn_rcpf(1.0f + __builtin_amdgcn_exp2f(-1.4426950408889634f * x)); }

__device__ __forceinline__ void st_wt(float* p, float v) { __hip_atomic_store(p, v, __ATOMIC_RELAXED, __HIP_MEMORY_SCOPE_AGENT); }
__device__ __forceinline__ void st_wt(int* p, int v) { __hip_atomic_store(p, v, __ATOMIC_RELAXED, __HIP_MEMORY_SCOPE_AGENT); }

struct Args { const float* in[37]; float* out; unsigned char* ws; int l_lo, l_hi, ph_lo, ph_hi; };

struct Frame {
    LAS unsigned char* lds;
    unsigned char* ws;
    int tid, lane, wave, G, vcu;
};

__device__ __forceinline__ void conv_item(const float* src, int ldsrc, int srccol0, const float* gain, bf16_t* dst, int K, int dstrow0, int k0, LAS float* scr, int lane) {
    const int c = lane & 7;
    if (srccol0 < 0) {
#pragma unroll
        for (int j = 0; j < 4; ++j) { const int n = (lane >> 3) + 8 * j; *(GAS u32x4*)(dst + (size_t)(dstrow0 + n) * K + k0 + 8 * c) = (u32x4){0u, 0u, 0u, 0u}; }
        return;
    }
#pragma unroll 8
    for (int i = 0; i < 32; ++i) { const int kk = 2 * i + (lane >> 5); float v = src[(size_t)(k0 + kk) * ldsrc + srccol0 + (lane & 31)]; if (gain) v *= gain[k0 + kk]; scr[kk * 33 + (lane & 31)] = v; }
    LDS_WAIT(); asm volatile("" ::: "memory");
#pragma unroll
    for (int j = 0; j < 4; ++j) { const int n = (lane >> 3) + 8 * j; const LAS float* s = scr + (8 * c) * 33 + n;
        u32x4 o; o.x = pk2(s[0 * 33], s[1 * 33]); o.y = pk2(s[2 * 33], s[3 * 33]); o.z = pk2(s[4 * 33], s[5 * 33]); o.w = pk2(s[6 * 33], s[7 * 33]);
        *(GAS u32x4*)(dst + (size_t)(dstrow0 + n) * K + k0 + 8 * c) = o; }
    LDS_WAIT(); asm volatile("" ::: "memory");
}
template <class ColMap>
__device__ __forceinline__ void conv_matrix(const Frame& F, int gw, int NGW, const float* src, int ldsrc, const float* gain, bf16_t* dst, int K, int N, ColMap cm) {
    LAS float* scr = (LAS float*)(F.lds + F.wave * 16384);
    const int nblk = N / 32, nitems = (K / 64) * nblk;
    for (int it = gw; it < nitems; it += NGW) { const int kb = it / nblk, nb = it % nblk; conv_item(src, ldsrc, cm(nb), gain, dst, K, 32 * nb, 64 * kb, scr, F.lane); }
}
struct CmIdent { __device__ int operator()(int nb) const { return 32 * nb; } };
struct CmWin {
    __device__ int operator()(int nb) const {
        const int n = 32 * nb;
        if (n < 384) return n;
        if (n < 416) return 640;
        if (n < 512) return -1;
        if (n < 768) return 384 + (n - 512);
        if (n < 1024) return 672 + (n - 768);
        if (n < 1280) { const int p = n - 1024, bj = p >> 7, wc = (p >> 5) & 3; return 928 + 64 * wc + 32 * bj; }
        return 1184 + (n - 1280);
    }
};
struct CmUq { __device__ int operator()(int nb) const { const int h = nb >> 2, j = nb & 3; return j < 3 ? h * 96 + 32 * j : -1; } };
struct CmUkv {
    __device__ int operator()(int nb) const { const int tile = nb >> 3, bj = (nb >> 2) & 1, wc = nb & 3; const int h = 2 * tile + (wc >> 1); return h * 128 + (wc & 1) * 64 + 32 * bj; }
};
struct CmW13 { const int dummy; };

__device__ __forceinline__ void conv_moe_layer(const Frame& F, int gw, int NGW, const Args& a, int l) {
    LAS float* scr = (LAS float*)(F.lds + F.wave * 16384);
    const float* w1 = a.in[31] + (size_t)l * 32 * 1024 * 256; const float* w3 = a.in[32] + (size_t)l * 32 * 1024 * 256; const float* w2 = a.in[33] + (size_t)l * 32 * 256 * 1024;
    const float* ln2 = a.in[26] + (size_t)l * 1024;
    bf16_t* W13 = (bf16_t*)(F.ws + WS_W13); bf16_t* W2T = (bf16_t*)(F.ws + WS_W2T);
    for (int it = gw; it < 32 * 256; it += NGW) { const int e = it >> 8, r = it & 255, kb = r >> 4, nb = r & 15;
        const int n = 32 * nb, pnl = n >> 8, bj = (n >> 7) & 1, j = n & 127; const float* src = (bj ? w3 : w1) + (size_t)e * 1024 * 256;
        conv_item(src, 256, 128 * pnl + j, ln2, W13 + (size_t)e * 512 * 1024, 1024, n, 64 * kb, scr, F.lane); }
    for (int it = gw; it < 32 * 128; it += NGW) { const int e = it >> 7, r = it & 127, kb = r >> 5, nb = r & 31;
        conv_item(w2 + (size_t)e * 256 * 1024, 1024, 32 * nb, nullptr, W2T + (size_t)e * 1024 * 256, 256, 32 * nb, 64 * kb, scr, F.lane); }
}
__device__ __forceinline__ void conv_p_layer(const Frame& F, int gw, int NGW, const Args& a, int l) {
    const float* p = a.in[1] + (size_t)l * T * 256; bf16_t* Pb = (bf16_t*)(F.ws + WS_PB);
    for (int m = gw; m < T; m += NGW) { const f32x4 v = *(const GAS f32x4*)(p + (size_t)m * 256 + 4 * F.lane);
        u32x2 o; o.x = pk2(v.x, v.y); o.y = pk2(v.z, v.w); *(GAS u32x2*)(Pb + (size_t)m * 256 + 4 * F.lane) = o; }
}

__device__ __forceinline__ void p0_prologue(const Frame& F, const Args& a) {
    const int gw = F.vcu * NW + F.wave, NGW = F.G * NW;
    const int gt = gw * 64 + F.lane, NGT = NGW * 64;
    for (int l = 0; l < NL; ++l) {
        conv_matrix(F, gw, NGW, a.in[3] + (size_t)l * 1024 * 1440, 1440, a.in[2] + l * 1024, (bf16_t*)(F.ws + WS_WIN) + (size_t)l * 1536 * 1024, 1024, 1536, CmWin());
        conv_matrix(F, gw, NGW, a.in[6] + (size_t)l * 384 * 768, 768, a.in[4] + l * 384, (bf16_t*)(F.ws + WS_WUQ) + (size_t)l * 1024 * 384, 384, 1024, CmUq());
        conv_matrix(F, gw, NGW, a.in[7] + (size_t)l * 256 * 1024, 1024, a.in[5] + l * 256, (bf16_t*)(F.ws + WS_WUKV) + (size_t)l * 1024 * 256, 256, 1024, CmUkv());
        conv_matrix(F, gw, NGW, a.in[25] + (size_t)l * 1024 * 1024, 1024, nullptr, (bf16_t*)(F.ws + WS_WOUT) + (size_t)l * 1024 * 1024, 1024, 1024, CmIdent());
        conv_matrix(F, gw, NGW, a.in[34] + (size_t)l * 1024 * 1024, 1024, nullptr, (bf16_t*)(F.ws + WS_WPG) + (size_t)l * 1024 * 1024, 1024, 1024, CmIdent());
        conv_matrix(F, gw, NGW, a.in[36] + (size_t)l * 256 * 1024, 1024, nullptr, (bf16_t*)(F.ws + WS_WPLE) + (size_t)l * 1024 * 256, 256, 1024, CmIdent());
        conv_matrix(F, gw, NGW, a.in[22] + (size_t)l * 256 * 256, 256, nullptr, (bf16_t*)(F.ws + WS_WGLU) + (size_t)l * 256 * 256, 256, 256, CmIdent());
        { bf16_t* Wr = (bf16_t*)(F.ws + WS_WR) + (size_t)l * 48 * 1024; const float* wrg = a.in[27] + (size_t)l * 4096; const float* wre = a.in[29] + (size_t)l * 32768; const float* ln2 = a.in[26] + l * 1024;
          for (int i = gt; i < 48 * 1024; i += NGT) { const int n = i >> 10, k = i & 1023; float v = 0.f; if (n < 4) v = wrg[k * 4 + n]; else if (n < 36) v = wre[k * 32 + (n - 4)]; Wr[i] = (bf16_t)f2bf(v * ln2[k]); } }
        { bf16_t* Wsg = (bf16_t*)(F.ws + WS_WSG) + (size_t)l * 4 * 128 * 128; const float* w = a.in[12] + (size_t)l * 4 * 128 * 128;
          for (int i = gt; i < 4 * 128 * 128; i += NGT) { const int p = i & 15, sb = (i & 127) & ~15, t = (i >> 7) & 127; const int q = p & 7, kp = (q & 3) + 8 * (q >> 2) + 4 * (p >> 3); const int s = sb + kp;
              const float v = (s <= t) ? w[(i & ~127) + s] : 0.f; Wsg[i] = (bf16_t)f2bf(v); } }
        { unsigned char* tb = F.ws + WS_S5T + (size_t)l * S5T_LAYER; float* ab = (float*)(tb + S5T_AB); bf16_t* BBt = (bf16_t*)(tb + S5T_BBT); bf16_t* Cmt = (bf16_t*)(tb + S5T_CMT); float* dd = (float*)(tb + S5T_D);
          const float* lre = a.in[14] + l * 1024; const float* lim = a.in[15] + l * 1024; const float* ldt = a.in[16] + l * 1024;
          const float* bre = a.in[17] + (size_t)l * 16384; const float* bim = a.in[18] + (size_t)l * 16384; const float* cre = a.in[19] + (size_t)l * 16384; const float* cim = a.in[20] + (size_t)l * 16384;
          for (int i = gt; i < 16 * 128 * 16; i += NGT) {
              const int c = i & 15, np = (i >> 4) & 127, g = i >> 11, n = np & 63, gn = g * 64 + n;
              const float lr = fminf(lre[gn], -1e-4f), li = lim[gn], dt = expf(ldt[gn]); const float mag = expf(lr * dt); float sn, cs; sincosf(li * dt, &sn, &cs);
              const float are = mag * cs, aim = mag * sn, den = lr * lr + li * li, nr = are - 1.0f, ni = aim; const float fr = (nr * lr + ni * li) / den, fi = (ni * lr - nr * li) / den;
              const float br = bre[(size_t)gn * 16 + c], bi = bim[(size_t)gn * 16 + c];
              const float v = (np < 64) ? (fr * br - fi * bi) : (fr * bi + fi * br);
              BBt[i] = (bf16_t)f2bf(v);
              if (c == 0 && np < 64) { ab[gn] = are; ab[1024 + gn] = aim; const float m64 = expf(64.0f * lr * dt); float s64, c64; sincosf(64.0f * li * dt, &s64, &c64); ab[2048 + gn] = m64 * c64; ab[3072 + gn] = m64 * s64; } }
          for (int i = gt; i < 16 * 16 * 128; i += NGT) {
              const int np = i & 127, c = (i >> 7) & 15, g = i >> 11, n = np & 63; const size_t ci = ((size_t)g * 16 + c) * 64 + n;
              Cmt[i] = (bf16_t)f2bf(np < 64 ? cre[ci] : -cim[ci]); }
          for (int i = gt; i < 256; i += NGT) dd[i] = a.in[21][l * 256 + i]; }
    }
    { float* CS = (float*)(F.ws + WS_COS); float* SN = (float*)(F.ws + WS_SIN);
      for (int i = gt; i < S * 16; i += NGT) { const int s = i >> 4, j = i & 15; const float inv = 1.0f / powf(10000.0f, (float)(2 * j) / 32.0f); const float ang = (float)s * inv; float sn, cs; sincosf(ang, &sn, &cs); CS[i] = cs; SN[i] = sn; } }
    { const float* x = a.in[0]; bf16_t* Hb = (bf16_t*)(F.ws + WS_HBA); float* SS1 = (float*)(F.ws + WS_SS1);
      for (int m = gw; m < T; m += NGW) { const GAS f32x4* xr = (const GAS f32x4*)(x + (size_t)m * DM) + F.lane; f32x4 v[4]; float s = 0.f;
#pragma unroll
          for (int j = 0; j < 4; ++j) { v[j] = xr[64 * j]; s += (v[j].x * v[j].x + v[j].y * v[j].y) + (v[j].z * v[j].z + v[j].w * v[j].w); }
          s = wave_sum(s);
          { GAS f32x4* hr = (GAS f32x4*)(a.out + (size_t)m * DM) + F.lane;
#pragma unroll
            for (int j = 0; j < 4; ++j) hr[64 * j] = v[j]; }
          GAS u32x2* o8 = (GAS u32x2*)(Hb + (size_t)m * DM) + F.lane;
#pragma unroll
          for (int j = 0; j < 4; ++j) { u32x2 o; o.x = pk2(v[j].x, v[j].y); o.y = pk2(v[j].z, v[j].w); o8[64 * j] = o; }
          if (F.lane < 16) SS1[(size_t)m * 16 + F.lane] = (F.lane == 0) ? s : 0.f; } }
    conv_moe_layer(F, gw, NGW, a, 0);
    conv_p_layer(F, gw, NGW, a, 0);
}

#define EPI_ROW(u, ai, m) ((u).pm * 256 + (ai) * 128 + wr * 64 + (m) * 16 + fr)
__device__ __forceinline__ u32x4 pack8(const f32x4 v0, const f32x4 v1) { u32x4 w; w.x = pk2(v0[0], v0[1]); w.y = pk2(v0[2], v0[3]); w.z = pk2(v1[0], v1[1]); w.w = pk2(v1[2], v1[3]); return w; }
__device__ __forceinline__ float sq8(const f32x4 a, const f32x4 b) { return (a[0] * a[0] + a[1] * a[1]) + (a[2] * a[2] + a[3] * a[3]) + (b[0] * b[0] + b[1] * b[1]) + (b[2] * b[2] + b[3] * b[3]); }
__device__ __forceinline__ float sum16(const float* p) { const f32x4 a = *(const f32x4*)p, b = *(const f32x4*)(p + 4), c = *(const f32x4*)(p + 8), d = *(const f32x4*)(p + 12);
    return ((a[0] + a[1]) + (a[2] + a[3])) + ((b[0] + b[1]) + (b[2] + b[3])) + ((c[0] + c[1]) + (c[2] + c[3])) + ((d[0] + d[1]) + (d[2] + d[3])); }

struct EpiIn {
    static constexpr bool PERM = true, AFTER_DRAIN = false;
    const float* SS1; bf16_t* ZQ; float* KR; bf16_t* ZKV; bf16_t* U; bf16_t* VS; bf16_t* XS; float* SSQ; float* SKV; const float* lng; const float* lnb;
    __device__ __forceinline__ void operator()(const f32x4 (&acc)[2][2][4][2], const Unit& u, int wr, int wc, int fr, int fq) const {
        const int pn = u.pn;
#pragma unroll
        for (int ai = 0; ai < 2; ++ai)
#pragma unroll
            for (int m = 0; m < 4; ++m) {
                const int row = EPI_ROW(u, ai, m);
                const float rs = rsqrtf(sum16(SS1 + (size_t)row * 16) * (1.0f / 1024.0f) + EPS);
                f32x4 v[2][2];
#pragma unroll
                for (int bj = 0; bj < 2; ++bj) { v[bj][0] = acc[ai][bj][m][0] * rs; v[bj][1] = acc[ai][bj][m][1] * rs; }
                const int c8 = 32 * wc + 8 * fq;
                if (pn == 0) {
#pragma unroll
                    for (int bj = 0; bj < 2; ++bj) *(u32x4*)(ZQ + (size_t)row * 384 + 128 * bj + c8) = pack8(v[bj][0], v[bj][1]);
                    const float s = fq_sum(sq8(v[0][0], v[0][1]) + sq8(v[1][0], v[1][1]));
                    if (fq == 0) st_wt(SSQ + (size_t)row * 8 + wc, s);
                } else if (pn == 1) {
                    *(u32x4*)(ZQ + (size_t)row * 384 + 256 + c8) = pack8(v[0][0], v[0][1]);
                    const float s = fq_sum(sq8(v[0][0], v[0][1]));
                    if (fq == 0) st_wt(SSQ + (size_t)row * 8 + 4 + wc, s);
                    if (wc == 0) { *(f32x4*)(KR + (size_t)row * 32 + 8 * fq) = v[1][0]; *(f32x4*)(KR + (size_t)row * 32 + 8 * fq + 4) = v[1][1]; }
                } else if (pn == 2) {
#pragma unroll
                    for (int bj = 0; bj < 2; ++bj) *(u32x4*)(ZKV + (size_t)row * 256 + 128 * bj + c8) = pack8(v[bj][0], v[bj][1]);
                    const float s = fq_sum(sq8(v[0][0], v[0][1]) + sq8(v[1][0], v[1][1]));
                    if (fq == 0) SKV[(size_t)row * 4 + wc] = s;
                } else if (pn == 3) {
#pragma unroll
                    for (int bj = 0; bj < 2; ++bj) { f32x4 g0, g1;
#pragma unroll
                        for (int e = 0; e < 4; ++e) { g0[e] = gelu_t(v[bj][0][e]); g1[e] = gelu_t(v[bj][1][e]); }
                        *(u32x4*)(U + (size_t)row * 256 + 128 * bj + c8) = pack8(g0, g1); }
                } else if (pn == 4) {
                    f32x4 g[2][2]; float s = 0.f;
#pragma unroll
                    for (int bj = 0; bj < 2; ++bj)
#pragma unroll
                        for (int n = 0; n < 2; ++n)
#pragma unroll
                            for (int e = 0; e < 4; ++e) { g[bj][n][e] = gelu_t(v[bj][n][e]); s += g[bj][n][e]; }
                    const float mu = fq_sum(s) * (1.0f / 64.0f); float q = 0.f;
#pragma unroll
                    for (int bj = 0; bj < 2; ++bj)
#pragma unroll
                        for (int n = 0; n < 2; ++n)
#pragma unroll
                            for (int e = 0; e < 4; ++e) { g[bj][n][e] -= mu; q += g[bj][n][e] * g[bj][n][e]; }
                    const float rstd = rsqrtf(fq_sum(q) * (1.0f / 64.0f) + EPS);
#pragma unroll
                    for (int bj = 0; bj < 2; ++bj) { const int lc = 64 * wc + 32 * bj + 8 * fq;
                        const f32x4 ga = *(const f32x4*)(lng + lc), gb = *(const f32x4*)(lng + lc + 4), ba = *(const f32x4*)(lnb + lc), bb = *(const f32x4*)(lnb + lc + 4);
                        *(u32x4*)(VS + (size_t)row * 256 + lc) = pack8(g[bj][0] * rstd * ga + ba, g[bj][1] * rstd * gb + bb); }
                } else {
#pragma unroll
                    for (int bj = 0; bj < 2; ++bj) *(u32x4*)(XS + (size_t)row * 256 + 128 * bj + c8) = pack8(v[bj][0], v[bj][1]);
                }
                asm volatile("" ::: "memory");
            }
    }
};
struct EpiQ {
    static constexpr bool PERM = true, AFTER_DRAIN = false;
    const float* SSQ; bf16_t* Q; float* SQH;
    __device__ __forceinline__ void operator()(const f32x4 (&acc)[2][2][4][2], const Unit& u, int wr, int wc, int fr, int fq) const {
#pragma unroll
        for (int ai = 0; ai < 2; ++ai)
#pragma unroll
            for (int m = 0; m < 4; ++m) {
                const int row = EPI_ROW(u, ai, m); const int b = row / S, s = row % S;
                const float* sp = SSQ + (size_t)row * 8; const f32x4 a = *(const f32x4*)sp, c = *(const f32x4*)(sp + 4);
                const float rq = rsqrtf((((a[0] + a[1]) + (a[2] + a[3])) + ((c[0] + c[1]) + (c[2] + c[3]))) * (1.0f / 384.0f) + EPS);
#pragma unroll
                for (int bj = 0; bj < 2; ++bj) { const int h = 2 * u.pn + bj; const f32x4 v0 = acc[ai][bj][m][0] * rq, v1 = acc[ai][bj][m][1] * rq;
                    if (wc < 3) *(u32x4*)(Q + ((size_t)(b * 8 + h) * S + s) * 96 + 32 * wc + 8 * fq) = pack8(v0, v1);
                    const float ss = fq_sum(sq8(v0, v1));
                    if (fq == 0) st_wt(SQH + (size_t)row * 32 + h * 4 + wc, ss); }
                asm volatile("" ::: "memory");
            }
    }
};
struct EpiKV {
    static constexpr bool PERM = true, AFTER_DRAIN = false;
    const float* SKV; const float* KR; const float* gkh; const float* CS; const float* SN; bf16_t* K; bf16_t* V;
    __device__ __forceinline__ void operator()(const f32x4 (&acc)[2][2][4][2], const Unit& u, int wr, int wc, int fr, int fq) const {
        const int h = 2 * u.pn + (wc >> 1);
#pragma unroll
        for (int ai = 0; ai < 2; ++ai)
#pragma unroll
            for (int m = 0; m < 4; ++m) {
                const int row = EPI_ROW(u, ai, m); const int b = row / S, s = row % S;
                const f32x4 a = *(const f32x4*)(SKV + (size_t)row * 4);
                const float rkv = rsqrtf(((a[0] + a[1]) + (a[2] + a[3])) * (1.0f / 256.0f) + EPS);
                f32x4 v[2][2];
#pragma unroll
                for (int bj = 0; bj < 2; ++bj) { v[bj][0] = acc[ai][bj][m][0] * rkv; v[bj][1] = acc[ai][bj][m][1] * rkv; }
                const size_t hrow = (size_t)(b * 8 + h) * S + s;
                if (wc & 1) {
#pragma unroll
                    for (int bj = 0; bj < 2; ++bj) *(u32x4*)(V + hrow * 64 + 32 * bj + 8 * fq) = pack8(v[bj][0], v[bj][1]);
                } else {
                    const f32x4 k0 = *(const f32x4*)(KR + (size_t)row * 32 + 8 * fq), k1 = *(const f32x4*)(KR + (size_t)row * 32 + 8 * fq + 4);
                    const float ss = fq_sum(sq8(v[0][0], v[0][1]) + sq8(v[1][0], v[1][1]) + sq8(k0, k1));
                    const float rk = rsqrtf(ss * (1.0f / 96.0f) + EPS);
#pragma unroll
                    for (int bj = 0; bj < 2; ++bj) { const int e0 = 32 * bj + 8 * fq; const f32x4 ga = *(const f32x4*)(gkh + e0), gb = *(const f32x4*)(gkh + e0 + 4);
                        *(u32x4*)(K + hrow * 96 + e0) = pack8(v[bj][0] * rk * ga, v[bj][1] * rk * gb); }
                    const f32x4 ga = *(const f32x4*)(gkh + 64 + 8 * fq), gb = *(const f32x4*)(gkh + 64 + 8 * fq + 4);
                    const f32x4 y0 = k0 * rk * ga, y1 = k1 * rk * gb; f32x4 p0, p1;
#pragma unroll
                    for (int e = 0; e < 4; ++e) { p0[e] = __shfl_xor(y0[e], 32); p1[e] = __shfl_xor(y1[e], 32); }
                    const int j0 = (8 * fq) & 15;
                    const f32x4 c0 = *(const f32x4*)(CS + (size_t)s * 16 + j0), c1 = *(const f32x4*)(CS + (size_t)s * 16 + j0 + 4), s0 = *(const f32x4*)(SN + (size_t)s * 16 + j0), s1 = *(const f32x4*)(SN + (size_t)s * 16 + j0 + 4);
                    f32x4 o0, o1;
                    if (fq < 2) { o0 = y0 * c0 - p0 * s0; o1 = y1 * c1 - p1 * s1; } else { o0 = p0 * s0 + y0 * c0; o1 = p1 * s1 + y1 * c1; }
                    *(u32x4*)(K + hrow * 96 + 64 + 8 * fq) = pack8(o0, o1);
                }
                asm volatile("" ::: "memory");
            }
    }
};
struct EpiOut {
    static constexpr bool PERM = true, AFTER_DRAIN = false;
    float* H; bf16_t* Hb; float* SS;
    __device__ __forceinline__ void operator()(const f32x4 (&acc)[2][2][4][2], const Unit& u, int wr, int wc, int fr, int fq) const {
#pragma unroll
        for (int ai = 0; ai < 2; ++ai)
#pragma unroll
            for (int m = 0; m < 4; ++m) { const int row = EPI_ROW(u, ai, m); float ss = 0.f;
#pragma unroll
                for (int bj = 0; bj < 2; ++bj) { const size_t off = (size_t)row * DM + u.pn * 256 + 128 * bj + 32 * wc + 8 * fq;
                    const f32x4 h0 = *(const f32x4*)(H + off) + acc[ai][bj][m][0], h1 = *(const f32x4*)(H + off + 4) + acc[ai][bj][m][1];
                    *(f32x4*)(H + off) = h0; *(f32x4*)(H + off + 4) = h1; *(u32x4*)(Hb + off) = pack8(h0, h1); ss += sq8(h0, h1); }
                ss = fq_sum(ss); if (fq == 0) st_wt(SS + (size_t)row * 16 + u.pn * 4 + wc, ss); asm volatile("" ::: "memory"); }
    }
};
struct EpiM1 {
    static constexpr bool PERM = true, AFTER_DRAIN = false;
    const float* RS; bf16_t* HBX;
    __device__ __forceinline__ void operator()(const f32x4 (&acc)[2][2][4][2], const Unit& u, int wr, int wc, int fr, int fq) const {
        const int ct = u.pn & 1;
#pragma unroll
        for (int ai = 0; ai < 2; ++ai)
#pragma unroll
            for (int m = 0; m < 4; ++m) { const int row = EPI_ROW(u, ai, m); const float rs = RS[row]; f32x4 o[2];
#pragma unroll
                for (int n = 0; n < 2; ++n)
#pragma unroll
                    for (int e = 0; e < 4; ++e) { const float a1 = acc[ai][0][m][n][e] * rs, a3 = acc[ai][1][m][n][e] * rs; o[n][e] = a1 * sigm(a1) * a3; }
                *(u32x4*)(HBX + (size_t)row * 256 + 128 * ct + 32 * wc + 8 * fq) = pack8(o[0], o[1]); asm volatile("" ::: "memory"); }
    }
};
struct EpiM2 {
    static constexpr bool PERM = true, AFTER_DRAIN = false;
    const int* TOK; const float* W; bf16_t* Y;
    __device__ __forceinline__ void operator()(const f32x4 (&acc)[2][2][4][2], const Unit& u, int wr, int wc, int fr, int fq) const {
        const int ct = u.pn & 3;
#pragma unroll
        for (int ai = 0; ai < 2; ++ai)
#pragma unroll
            for (int m = 0; m < 4; ++m) { const int row = EPI_ROW(u, ai, m); const int tk = TOK[row]; const float w = W[row];
                if (tk >= 0) { bf16_t* yr = Y + ((size_t)(tk & 1) * T + (tk >> 1)) * DM + 256 * ct + 32 * wc + 8 * fq;
#pragma unroll
                    for (int bj = 0; bj < 2; ++bj) *(u32x4*)(yr + 128 * bj) = pack8(acc[ai][bj][m][0] * w, acc[ai][bj][m][1] * w); } asm volatile("" ::: "memory"); }
    }
};
struct EpiPl {
    static constexpr bool PERM = true, AFTER_DRAIN = false;
    bf16_t* PL;
    __device__ __forceinline__ void operator()(const f32x4 (&acc)[2][2][4][2], const Unit& u, int wr, int wc, int fr, int fq) const {
#pragma unroll
        for (int ai = 0; ai < 2; ++ai)
#pragma unroll
            for (int m = 0; m < 4; ++m) { const int row = EPI_ROW(u, ai, m);
#pragma unroll
                for (int bj = 0; bj < 2; ++bj) *(u32x4*)(PL + (size_t)row * DM + u.pn * 256 + 128 * bj + 32 * wc + 8 * fq) = pack8(acc[ai][bj][m][0], acc[ai][bj][m][1]); asm volatile("" ::: "memory"); }
    }
};
struct EpiGate {
    static constexpr bool PERM = true, AFTER_DRAIN = false;
    float* H; const bf16_t* PL; const float* bpg; bf16_t* Hb; float* SS;
    __device__ __forceinline__ void operator()(const f32x4 (&acc)[2][2][4][2], const Unit& u, int wr, int wc, int fr, int fq) const {
#pragma unroll
        for (int ai = 0; ai < 2; ++ai)
#pragma unroll
            for (int m = 0; m < 4; ++m) { const int row = EPI_ROW(u, ai, m); float ss = 0.f;
#pragma unroll
                for (int bj = 0; bj < 2; ++bj) { const int col = u.pn * 256 + 128 * bj + 32 * wc + 8 * fq; const size_t off = (size_t)row * DM + col;
                    const u32x4 pl = *(const u32x4*)(PL + off); const f32x4 b0 = *(const f32x4*)(bpg + col), b1 = *(const f32x4*)(bpg + col + 4);
                    f32x4 h0 = *(const f32x4*)(H + off), h1 = *(const f32x4*)(H + off + 4);
                    const f32x4 a0 = acc[ai][bj][m][0] + b0, a1 = acc[ai][bj][m][1] + b1;
                    h0[0] += sigm(a0[0]) * bflo(pl.x); h0[1] += sigm(a0[1]) * bfhi(pl.x); h0[2] += sigm(a0[2]) * bflo(pl.y); h0[3] += sigm(a0[3]) * bfhi(pl.y);
                    h1[0] += sigm(a1[0]) * bflo(pl.z); h1[1] += sigm(a1[1]) * bfhi(pl.z); h1[2] += sigm(a1[2]) * bflo(pl.w); h1[3] += sigm(a1[3]) * bfhi(pl.w);
                    *(f32x4*)(H + off) = h0; *(f32x4*)(H + off + 4) = h1; *(u32x4*)(Hb + off) = pack8(h0, h1); ss += sq8(h0, h1); }
                ss = fq_sum(ss); if (fq == 0) st_wt(SS + (size_t)row * 16 + u.pn * 4 + wc, ss); asm volatile("" ::: "memory"); }
    }
};
template <int NCT>
struct MoeOrder {
    const int* TS; int G, c, total;
    __device__ __forceinline__ void init(const int* ts, int G_, int c_) { TS = ts; G = G_; c = c_; total = ts[32] * NCT; }
    __device__ __forceinline__ bool next(int i, Unit& u) const {
        const int L = i * G + c; if (L >= total) return false;
        const int rt = L / NCT, ct = L % NCT; int e = 0;
        for (int j = 1; j < 32; ++j) e += (TS[j] <= rt) ? 1 : 0;
        u.pm = rt; u.pn = e * NCT + ct; return true;
    }
    __device__ __forceinline__ void a_ready(const Unit&) const {}
    __device__ __forceinline__ void done(const Unit&) const {}
};
namespace att {
constexpr int KSLOT = 12288, VSLOT = 8192, NSLOT = 3;
constexpr int L_K = 0, L_V = NSLOT * KSLOT, L_WS = L_V + NSLOT * VSLOT, L_OST = L_WS + NW * 64 * 4, L_END = L_OST + NW * 4096;
static_assert(L_END <= RING_BYTES, "attention LDS");
constexpr float C2 = 0.10206207261596577f * 1.4426950408889634f;
__device__ __forceinline__ int crow(int r, int hi) { return (r & 3) + 8 * (r >> 2) + 4 * hi; }
__device__ __forceinline__ void glds16(const void* gsrc, unsigned lds_dst) { unsigned keep;
    asm volatile("s_mov_b32 %0, m0\n\ts_mov_b32 m0, %2\n\ts_nop 0\n\tglobal_load_lds_dwordx4 %1, off\n\ts_mov_b32 m0, %0" : "=&s"(keep) : "v"(gsrc), "s"(lds_dst) : "memory"); }
#define ATT_WAIT_BAR(N) asm volatile("s_waitcnt vmcnt(" #N ") lgkmcnt(0)\n\ts_barrier" ::: "memory")
__device__ __forceinline__ float rowmax32(const f32x16& p0, const f32x16& p1) {
    float a = fmaxf(fmaxf(p0[0], p0[1]), fmaxf(p1[0], p1[1]));
#pragma unroll
    for (int r = 2; r < 16; r += 2) a = fmaxf(a, fmaxf(fmaxf(p0[r], p0[r + 1]), fmaxf(p1[r], p1[r + 1])));
    auto rr = __builtin_amdgcn_permlane32_swap(__float_as_uint(a), __float_as_uint(a), false, false);
    return fmaxf(__uint_as_float(rr[0]), __uint_as_float(rr[1]));
}
__device__ __forceinline__ void pv(f32x16* o, int vb, bf16x8 pa0, bf16x8 pa1, bf16x8 pa2, bf16x8 pa3) {
#pragma unroll
    for (int d0 = 0; d0 < 2; ++d0) { s16x4 lo[4], hi[4];
#pragma unroll
        for (int ks = 0; ks < 4; ++ks) {
            asm volatile("ds_read_b64_tr_b16 %0,%1 offset:%c2" : "=&v"(lo[ks]) : "v"(vb), "i"(d0 * 4096 + ks * 1024) : "memory");
            asm volatile("ds_read_b64_tr_b16 %0,%1 offset:%c2" : "=&v"(hi[ks]) : "v"(vb), "i"(d0 * 4096 + ks * 1024 + 512) : "memory"); }
        asm volatile("s_waitcnt lgkmcnt(0)" ::: "memory"); __builtin_amdgcn_sched_barrier(0);
#define PK(k) (bf16x8){lo[k][0], lo[k][1], lo[k][2], lo[k][3], hi[k][0], hi[k][1], hi[k][2], hi[k][3]}
        o[d0] = __builtin_amdgcn_mfma_f32_32x32x16_bf16(pa0, PK(0), o[d0], 0, 0, 0);
        o[d0] = __builtin_amdgcn_mfma_f32_32x32x16_bf16(pa1, PK(1), o[d0], 0, 0, 0);
        o[d0] = __builtin_amdgcn_mfma_f32_32x32x16_bf16(pa2, PK(2), o[d0], 0, 0, 0);
        o[d0] = __builtin_amdgcn_mfma_f32_32x32x16_bf16(pa3, PK(3), o[d0], 0, 0, 0);
#undef PK
    }
}
__device__ __forceinline__ void attn_unit(int b, int h, int qb, const bf16_t* Q, const float* SQH, const float* gqh, const float* CS, const float* SN,
                                          const bf16_t* __restrict__ K, const bf16_t* __restrict__ V, bf16_t* MIX, float* SA, char* shm) {
    const int tid = opaque_tid(), lane = tid & 63, r32 = lane & 31, hi = lane >> 5; const int wid = __builtin_amdgcn_readfirstlane(tid >> 6);
    const int q0 = qb * 256; const size_t hbase = (size_t)(b * 8 + h) * S;
    const bf16_t* Kh = K + hbase * 96; const bf16_t* Vh = V + hbase * 64;
    const unsigned lds0 = (unsigned)(uintptr_t)shm;
    LAS float* wsf = (LAS float*)((LAS char*)shm + L_WS) + wid * 64;
    const bf16_t* ksrc0 = Kh + (size_t)lane * 96 + wid * 8; const bf16_t* ksrc1 = Kh + (size_t)lane * 96 + (8 + (wid & 3)) * 8;
    const bf16_t* vsrc = Vh + (size_t)(16 * (wid & 3) + (lane >> 2)) * 64 + (wid >> 2) * 32 + (lane & 3) * 8;
    const unsigned kdst0 = lds0 + L_K + wid * 1024, kdst1 = lds0 + L_K + (8 + (wid & 3)) * 1024, vdst = lds0 + L_V + wid * 1024;
#define ATT_DMA(t, sl) do { glds16(ksrc0 + (size_t)(t) * 64 * 96, (unsigned)__builtin_amdgcn_readfirstlane(kdst0 + (sl) * KSLOT)); \
        glds16(ksrc1 + (size_t)(t) * 64 * 96, (unsigned)__builtin_amdgcn_readfirstlane(kdst1 + (sl) * KSLOT)); \
        glds16(vsrc + (size_t)(t) * 64 * 64, (unsigned)__builtin_amdgcn_readfirstlane(vdst + (sl) * VSLOT)); } while (0)
    const int NT = (q0 + 256) / 64;
    ATT_DMA(0, 0); ATT_DMA(1, 1);
    const int qrow = q0 + wid * 32 + r32; const int trow = b * S + qrow;
    bf16x8 qr[6];
    { const f32x4 sp = *(const f32x4*)(SQH + (size_t)trow * 32 + h * 4);
      const float rq = rsqrtf(((sp[0] + sp[1]) + (sp[2] + sp[3])) * (1.0f / 96.0f) + EPS) * C2;
      const bf16_t* qp = Q + (hbase + qrow) * 96 + hi * 8;
      float qf[6][8];
#pragma unroll
      for (int d0 = 0; d0 < 6; ++d0) { const u32x4 w = *(const u32x4*)(qp + d0 * 16); const f32x4 g0 = *(const f32x4*)(gqh + d0 * 16 + hi * 8), g1 = *(const f32x4*)(gqh + d0 * 16 + hi * 8 + 4);
          qf[d0][0] = bflo(w.x) * rq * g0[0]; qf[d0][1] = bfhi(w.x) * rq * g0[1]; qf[d0][2] = bflo(w.y) * rq * g0[2]; qf[d0][3] = bfhi(w.y) * rq * g0[3];
          qf[d0][4] = bflo(w.z) * rq * g1[0]; qf[d0][5] = bfhi(w.z) * rq * g1[1]; qf[d0][6] = bflo(w.w) * rq * g1[2]; qf[d0][7] = bfhi(w.w) * rq * g1[3]; }
      const f32x4 c0 = *(const f32x4*)(CS + (size_t)qrow * 16 + 8 * hi), c1 = *(const f32x4*)(CS + (size_t)qrow * 16 + 8 * hi + 4), s0 = *(const f32x4*)(SN + (size_t)qrow * 16 + 8 * hi), s1 = *(const f32x4*)(SN + (size_t)qrow * 16 + 8 * hi + 4);
#pragma unroll
      for (int e = 0; e < 8; ++e) { const float c = e < 4 ? c0[e & 3] : c1[e & 3], sn = e < 4 ? s0[e & 3] : s1[e & 3]; const float x1 = qf[4][e], x2 = qf[5][e]; qf[4][e] = x1 * c - x2 * sn; qf[5][e] = x1 * sn + x2 * c; }
#pragma unroll
      for (int d0 = 0; d0 < 6; ++d0) { u32x4 w; w.x = pk2(qf[d0][0], qf[d0][1]); w.y = pk2(qf[d0][2], qf[d0][3]); w.z = pk2(qf[d0][4], qf[d0][5]); w.w = pk2(qf[d0][6], qf[d0][7]); qr[d0] = __builtin_bit_cast(bf16x8, w); } }
    float mrun = 0.f, l_reg = 0.f; f32x16 o[2]; o[0] = f32x16{}; o[1] = f32x16{};
    const int qrel = wid * 32 + r32;
    const int vb0 = (int)(lds0 + L_V) + ((lane >> 4) & 1) * 32 + (lane & 3) * 8 + (4 * hi + ((lane & 15) >> 2)) * 64;
    int slot = 0;
    for (int t = 0; t < NT; ++t) {
        if (t + 1 < NT) { ATT_WAIT_BAR(3); } else { ATT_WAIT_BAR(0); }
        if (t + 2 < NT) { const int s2 = (slot + 2 >= NSLOT) ? slot + 2 - NSLOT : slot + 2; ATT_DMA(t + 2, s2); }
        const int jb = t - (NT - 4);
        if (!(jb >= 0 && 64 * jb > wid * 32 + 31)) {
            const LAS char* kb = (const LAS char*)shm + L_K + slot * KSLOT + hi * 1024 + r32 * 16;
            f32x16 p0 = f32x16{}, p1 = f32x16{};
#pragma unroll
            for (int d0 = 0; d0 < 6; ++d0) { const bf16x8 b0 = *(const LAS bf16x8*)(kb + d0 * 2048), b1 = *(const LAS bf16x8*)(kb + d0 * 2048 + 512);
                p0 = __builtin_amdgcn_mfma_f32_32x32x16_bf16(b0, qr[d0], p0, 0, 0, 0); p1 = __builtin_amdgcn_mfma_f32_32x32x16_bf16(b1, qr[d0], p1, 0, 0, 0); }
            if (jb >= 0) { const int kb0 = 64 * jb + 4 * hi;
#pragma unroll
                for (int r = 0; r < 16; ++r) { const int kv = kb0 + (r & 3) + 8 * (r >> 2); if (kv > qrel) p0[r] = -INFINITY; if (kv + 32 > qrel) p1[r] = -INFINITY; } }
            const float rm = rowmax32(p0, p1);
            if (t == 0) { mrun = rm; }
            else if (__any(rm > mrun + 8.0f)) { const float mn = fmaxf(mrun, rm); const float f = __builtin_amdgcn_exp2f(mrun - mn); l_reg *= f; mrun = mn; if (hi == 0) wsf[r32] = f; LDS_WAIT();
#pragma unroll
                for (int d_ = 0; d_ < 2; ++d_)
#pragma unroll
                    for (int r = 0; r < 16; ++r) o[d_][r] *= wsf[crow(r, hi)]; }
            float sacc = 0.f;
#pragma unroll
            for (int r = 0; r < 16; ++r) { p0[r] = __builtin_amdgcn_exp2f(p0[r] - mrun); p1[r] = __builtin_amdgcn_exp2f(p1[r] - mrun); sacc += p0[r] + p1[r]; }
            l_reg += sacc;
            u32x4 pw0, pw1, pw2, pw3;
            pw0 = (u32x4){pk2(p0[0], p0[1]), pk2(p0[2], p0[3]), pk2(p0[4], p0[5]), pk2(p0[6], p0[7])}; pw1 = (u32x4){pk2(p0[8], p0[9]), pk2(p0[10], p0[11]), pk2(p0[12], p0[13]), pk2(p0[14], p0[15])};
            pw2 = (u32x4){pk2(p1[0], p1[1]), pk2(p1[2], p1[3]), pk2(p1[4], p1[5]), pk2(p1[6], p1[7])}; pw3 = (u32x4){pk2(p1[8], p1[9]), pk2(p1[10], p1[11]), pk2(p1[12], p1[13]), pk2(p1[14], p1[15])};
            pv(o, vb0 + slot * VSLOT, __builtin_bit_cast(bf16x8, pw0), __builtin_bit_cast(bf16x8, pw1), __builtin_bit_cast(bf16x8, pw2), __builtin_bit_cast(bf16x8, pw3));
        }
        slot = (slot + 1 >= NSLOT) ? 0 : slot + 1;
    }
    { auto rr = __builtin_amdgcn_permlane32_swap(__float_as_uint(l_reg), __float_as_uint(l_reg), false, false); l_reg = __uint_as_float(rr[0]) + __uint_as_float(rr[1]); }
    if (hi == 0) wsf[32 + r32] = l_reg; LDS_WAIT();
    float rli[16];
#pragma unroll
    for (int r = 0; r < 16; ++r) rli[r] = __builtin_amdgcn_rcpf(wsf[32 + crow(r, hi)]);
    { LAS bf16_t* stg = (LAS bf16_t*)((LAS char*)shm + L_OST) + wid * 2048;
#pragma unroll
      for (int r = 0; r < 16; ++r) { const int orow = crow(r, hi);
#pragma unroll
          for (int d0 = 0; d0 < 2; ++d0) stg[orow * 64 + d0 * 32 + r32] = (bf16_t)f2bf(o[d0][r] * rli[r]); }
      LDS_WAIT();
#pragma unroll
      for (int i = 0; i < 4; ++i) { const int row = i * 8 + (lane >> 3), ch = lane & 7; const u32x4 v = *(const LAS u32x4*)(stg + row * 64 + ch * 8);
          const size_t tr = (size_t)b * S + q0 + wid * 32 + row;
          *(u32x4*)(MIX + tr * DM + h * 64 + ch * 8) = v;
          float ss = bflo(v.x) * bflo(v.x) + bfhi(v.x) * bfhi(v.x) + bflo(v.y) * bflo(v.y) + bfhi(v.y) * bfhi(v.y) + bflo(v.z) * bflo(v.z) + bfhi(v.z) * bfhi(v.z) + bflo(v.w) * bflo(v.w) + bfhi(v.w) * bfhi(v.w);
          ss += __shfl_xor(ss, 1); ss += __shfl_xor(ss, 2); ss += __shfl_xor(ss, 4);
          if (ch == 0) st_wt(SA + tr * 8 + h, ss); } }
    asm volatile("s_waitcnt lgkmcnt(0)\n\ts_barrier" ::: "memory");
#undef ATT_DMA
}
}

__device__ __forceinline__ void gmlp_unit(const Frame& F, int ci, const bf16_t* U, const bf16_t* VS, const bf16_t* Wsg, const float* sgb, const float* gm, bf16_t* MIX) {
    LAS unsigned char* lds = F.lds; const int tid = F.tid, lane = F.lane, wid = F.wave, r32 = lane & 31, hi = lane >> 5;
    const size_t t0 = (size_t)ci * 128;
#pragma unroll
    for (int j = 0; j < 8; ++j) { const int g = j >> 1, sh = j & 1;
        const u32x4 v = *(const u32x4*)(VS + (t0 + 64 * sh + 16 * (wid & 3) + (lane >> 2)) * 256 + g * 64 + (wid >> 2) * 32 + (lane & 3) * 8);
        *(LAS u32x4*)(lds + j * 8192 + wid * 1024 + lane * 16) = v; }
#pragma unroll
    for (int i = 0; i < 8; ++i) { const int piece = wid + 8 * i; const u32x4 v = *(const u32x4*)(U + t0 * 256 + (size_t)piece * 512 + lane * 8); *(LAS u32x4*)(lds + 65536 + piece * 1024 + lane * 16) = v; }
    LDS_WAIT(); __syncthreads();
    const int g = wid >> 1, th = wid & 1;
    f32x16 acc[2][2];
#pragma unroll
    for (int mb = 0; mb < 2; ++mb) { acc[mb][0] = f32x16{}; acc[mb][1] = f32x16{}; }
    const int vbl = ((lane >> 4) & 1) * 32 + (lane & 3) * 8 + (4 * hi + ((lane & 15) >> 2)) * 64;
    const unsigned ldsb = (unsigned)(uintptr_t)(char*)lds;
#pragma unroll
    for (int mb = 0; mb < 2; ++mb) { const int tb = 64 * th + 32 * mb; const int nks = (tb + 32) / 16;
        const bf16_t* wrow = Wsg + ((size_t)g * 128 + tb + r32) * 128 + 8 * hi;
        for (int ks = 0; ks < nks; ++ks) { const bf16x8 a = *(const bf16x8*)(wrow + 16 * ks);
            const int vb = (int)ldsb + (g * 2 + (ks >> 2)) * 8192 + (ks & 3) * 1024 + vbl;
            s16x4 lo0, hi0, lo1, hi1;
            asm volatile("ds_read_b64_tr_b16 %0,%1" : "=&v"(lo0) : "v"(vb) : "memory");
            asm volatile("ds_read_b64_tr_b16 %0,%1 offset:512" : "=&v"(hi0) : "v"(vb) : "memory");
            asm volatile("ds_read_b64_tr_b16 %0,%1 offset:4096" : "=&v"(lo1) : "v"(vb) : "memory");
            asm volatile("ds_read_b64_tr_b16 %0,%1 offset:4608" : "=&v"(hi1) : "v"(vb) : "memory");
            asm volatile("s_waitcnt lgkmcnt(0)" ::: "memory");
            acc[mb][0] = __builtin_amdgcn_mfma_f32_32x32x16_bf16(a, (bf16x8){lo0[0], lo0[1], lo0[2], lo0[3], hi0[0], hi0[1], hi0[2], hi0[3]}, acc[mb][0], 0, 0, 0);
            acc[mb][1] = __builtin_amdgcn_mfma_f32_32x32x16_bf16(a, (bf16x8){lo1[0], lo1[1], lo1[2], lo1[3], hi1[0], hi1[1], hi1[2], hi1[3]}, acc[mb][1], 0, 0, 0); } }
    __syncthreads();
#pragma unroll
    for (int mb = 0; mb < 2; ++mb)
#pragma unroll
        for (int r = 0; r < 16; ++r) { const int t = 64 * th + 32 * mb + att::crow(r, hi); const float bias = sgb[g * 128 + t];
#pragma unroll
            for (int d0 = 0; d0 < 2; ++d0) { const int c = g * 64 + 32 * d0 + r32; const float u = bf2f(*(const LAS bf16_t*)(lds + 65536 + t * 512 + c * 2));
                *(LAS bf16_t*)(lds + t * 512 + c * 2) = (bf16_t)f2bf(u * (acc[mb][d0][r] + bias)); } }
    LDS_WAIT(); __syncthreads();
#pragma unroll 4
    for (int i = 0; i < 16; ++i) { const int row = wid * 16 + i; const u32x2 w = *(const LAS u32x2*)(lds + row * 512 + lane * 8);
        const float a0 = bflo(w.x), a1 = bfhi(w.x), a2 = bflo(w.y), a3 = bfhi(w.y);
        const float rg = rsqrtf(wave_sum((a0 * a0 + a1 * a1) + (a2 * a2 + a3 * a3)) * (1.0f / 256.0f) + EPS); const f32x4 gg = *(const f32x4*)(gm + 512 + 4 * lane);
        u32x2 o; o.x = pk2(a0 * rg * gg[0], a1 * rg * gg[1]); o.y = pk2(a2 * rg * gg[2], a3 * rg * gg[3]);
        *(u32x2*)(MIX + (t0 + row) * DM + 512 + 4 * lane) = o; }
    __syncthreads();
}

constexpr int S5_BU = 8704  , S5_GG = 8 * S5_BU  , S5_GG_ROW = 528, S5_ST_ROW = 260;
template <int MODE>
__device__ __forceinline__ void s5_block(const bf16_t* XSrow0  , const bf16x8 (&bfrag)[4], LAS unsigned char* bu, int lane, float are, float aim, float& hr, float& hi_) {
    const int r32 = lane & 31, hi = lane >> 5;
    const bf16x8 a = *(const bf16x8*)(XSrow0 + (size_t)r32 * 256 + 8 * hi);
#pragma unroll
    for (int nb = 0; nb < 4; ++nb) { const f32x16 c = __builtin_amdgcn_mfma_f32_32x32x16_bf16(a, bfrag[nb], f32x16{}, 0, 0, 0);
#pragma unroll
        for (int r = 0; r < 16; ++r) *(LAS bf16_t*)(bu + att::crow(r, hi) * 272 + (32 * nb + r32) * 2) = (bf16_t)f2bf(c[r]); }
    LDS_WAIT();
#pragma unroll 8
    for (int r = 0; r < 32; ++r) { const float ur = bf2f(*(const LAS bf16_t*)(bu + r * 272 + lane * 2)), ui = bf2f(*(const LAS bf16_t*)(bu + r * 272 + 128 + lane * 2));
        const float nr = are * hr - aim * hi_ + ur, ni = are * hi_ + aim * hr + ui; hr = nr; hi_ = ni;
        if (MODE == 3) { *(LAS bf16_t*)(bu + r * 272 + lane * 2) = (bf16_t)f2bf(nr); *(LAS bf16_t*)(bu + r * 272 + 128 + lane * 2) = (bf16_t)f2bf(ni); } }
    LDS_WAIT();
}
__device__ __forceinline__ void s5_pass1(const Frame& F, int task, const bf16_t* XS, const unsigned char* tb, float* E) {
    const int lane = F.lane, wid = F.wave, r32 = lane & 31, hi = lane >> 5;
    const float* ab = (const float*)(tb + S5T_AB); const bf16_t* BBt = (const bf16_t*)(tb + S5T_BBT);
    const size_t t0 = (size_t)task * 64;
    LAS unsigned char* bu = F.lds + wid * S5_BU;
    for (int gi = 0; gi < 2; ++gi) { const int g = 2 * wid + gi; const float are = ab[g * 64 + lane], aim = ab[1024 + g * 64 + lane];
        bf16x8 bfrag[4];
#pragma unroll
        for (int nb = 0; nb < 4; ++nb) bfrag[nb] = *(const bf16x8*)(BBt + ((size_t)g * 128 + 32 * nb + r32) * 16 + 8 * hi);
        float hr = 0.f, hi_ = 0.f;
        for (int blk = 0; blk < 2; ++blk) s5_block<1>(XS + (t0 + 32 * blk) * 256 + g * 16, bfrag, bu, lane, are, aim, hr, hi_);
        E[((size_t)task * 16 + g) * 128 + lane] = hr; E[((size_t)task * 16 + g) * 128 + 64 + lane] = hi_; }
}
__device__ __forceinline__ void s5_carry(int idx, const unsigned char* tb, const float* E, float* Hs) {
    const float* ab = (const float*)(tb + S5T_AB); const int n = idx & 63, g = (idx >> 6) & 15, b = idx >> 10;
    const float are = ab[2048 + g * 64 + n], aim = ab[3072 + g * 64 + n]; float hr = 0.f, hi_ = 0.f;
    for (int j = 0; j < 256; ++j) { const size_t o = ((size_t)(b * 256 + j) * 16 + g) * 128 + n; const float er = E[o], ei = E[o + 64];
        Hs[o] = hr; Hs[o + 64] = hi_; const float nr = are * hr - aim * hi_ + er, ni = are * hi_ + aim * hr + ei; hr = nr; hi_ = ni; }
}
__device__ __forceinline__ void s5_pass3(const Frame& F, int task, const bf16_t* XS, const unsigned char* tb, const float* Hs, const bf16_t* Wglu, const float* bglu, const float* gm, bf16_t* MIX) {
    const int lane = F.lane, wid = F.wave, r32 = lane & 31, hi = lane >> 5;
    const float* ab = (const float*)(tb + S5T_AB); const bf16_t* BBt = (const bf16_t*)(tb + S5T_BBT); const bf16_t* Cmt = (const bf16_t*)(tb + S5T_CMT); const float* dd = (const float*)(tb + S5T_D);
    const size_t t0 = (size_t)task * 64;
    LAS unsigned char* bu = F.lds + wid * S5_BU; LAS unsigned char* ggt = F.lds + S5_GG;
    for (int gi = 0; gi < 2; ++gi) { const int g = 2 * wid + gi; const float are = ab[g * 64 + lane], aim = ab[1024 + g * 64 + lane];
        bf16x8 bfrag[4];
#pragma unroll
        for (int nb = 0; nb < 4; ++nb) bfrag[nb] = *(const bf16x8*)(BBt + ((size_t)g * 128 + 32 * nb + r32) * 16 + 8 * hi);
        bf16x8 cfrag[4];
#pragma unroll
        for (int ks = 0; ks < 4; ++ks) cfrag[ks] = *(const bf16x8*)(Cmt + ((size_t)g * 16 + (lane & 15)) * 128 + 32 * ks + 8 * (lane >> 4));
        const float dv = dd[g * 16 + (lane & 15)];
        float hr = Hs[((size_t)task * 16 + g) * 128 + lane], hi_ = Hs[((size_t)task * 16 + g) * 128 + 64 + lane];
        for (int blk = 0; blk < 2; ++blk) { const bf16_t* xr0 = XS + (t0 + 32 * blk) * 256 + g * 16;
            s5_block<3>(xr0, bfrag, bu, lane, are, aim, hr, hi_);
#pragma unroll
            for (int mb = 0; mb < 2; ++mb) { f32x4 y = (f32x4){0.f, 0.f, 0.f, 0.f};
#pragma unroll
                for (int ks = 0; ks < 4; ++ks) { const bf16x8 a = *(const LAS bf16x8*)(bu + (16 * mb + (lane & 15)) * 272 + (32 * ks + 8 * (lane >> 4)) * 2);
                    y = __builtin_amdgcn_mfma_f32_16x16x32_bf16(a, cfrag[ks], y, 0, 0, 0); }
#pragma unroll
                for (int r = 0; r < 4; ++r) { const int pr = 16 * mb + 4 * (lane >> 4) + r; const float xv = bf2f(xr0[(size_t)pr * 256 + (lane & 15)]);
                    *(LAS bf16_t*)(ggt + (32 * blk + pr) * S5_GG_ROW + (g * 16 + (lane & 15)) * 2) = (bf16_t)f2bf(gelu_t(y[r] + dv * xv)); } }
            LDS_WAIT(); } }
    LDS_WAIT(); __syncthreads();
    { f32x16 acc[2]; acc[0] = f32x16{}; acc[1] = f32x16{}; const bf16_t* wr = Wglu + (size_t)(32 * wid + r32) * 256 + 8 * hi;
#pragma unroll 4
      for (int ks = 0; ks < 16; ++ks) { const bf16x8 bw = *(const bf16x8*)(wr + 16 * ks);
#pragma unroll
          for (int mb = 0; mb < 2; ++mb) { const bf16x8 a = *(const LAS bf16x8*)(ggt + (32 * mb + r32) * S5_GG_ROW + (16 * ks + 8 * hi) * 2); acc[mb] = __builtin_amdgcn_mfma_f32_32x32x16_bf16(a, bw, acc[mb], 0, 0, 0); } }
      const int n = 32 * wid + r32; const float bg = bglu[n];
#pragma unroll
      for (int mb = 0; mb < 2; ++mb)
#pragma unroll
          for (int r = 0; r < 16; ++r) { const int pos = 32 * mb + att::crow(r, hi); const float gv = bf2f(*(const LAS bf16_t*)(ggt + pos * S5_GG_ROW + n * 2));
              *(LAS float*)(F.lds + (pos * S5_ST_ROW + n) * 4) = gv * sigm(acc[mb][r] + bg); } }
    LDS_WAIT(); __syncthreads();
#pragma unroll
    for (int i = 0; i < 8; ++i) { const int row = wid * 8 + i; const f32x4 v = *(const LAS f32x4*)(F.lds + (row * S5_ST_ROW + 4 * lane) * 4);
        const float rs = rsqrtf(wave_sum((v[0] * v[0] + v[1] * v[1]) + (v[2] * v[2] + v[3] * v[3])) * (1.0f / 256.0f) + EPS); const f32x4 gg = *(const f32x4*)(gm + 768 + 4 * lane);
        u32x2 o; o.x = pk2(v[0] * rs * gg[0], v[1] * rs * gg[1]); o.y = pk2(v[2] * rs * gg[2], v[3] * rs * gg[3]);
        *(u32x2*)(MIX + (t0 + row) * DM + 768 + 4 * lane) = o; }
    __syncthreads();
}
__device__ __forceinline__ void anorm_row(int t, int lane, bf16_t* MIX, const float* SA, const float* gm) {
    const f32x4 s0 = *(const f32x4*)(SA + (size_t)t * 8), s1 = *(const f32x4*)(SA + (size_t)t * 8 + 4);
    const float ra = rsqrtf((((s0[0] + s0[1]) + (s0[2] + s0[3])) + ((s1[0] + s1[1]) + (s1[2] + s1[3]))) * (1.0f / 512.0f) + EPS);
    u32x4* p = (u32x4*)(MIX + (size_t)t * DM + 8 * lane); const u32x4 w = *p; const f32x4 g0 = *(const f32x4*)(gm + 8 * lane), g1 = *(const f32x4*)(gm + 8 * lane + 4);
    u32x4 o; o.x = pk2(bflo(w.x) * ra * g0[0], bfhi(w.x) * ra * g0[1]); o.y = pk2(bflo(w.y) * ra * g0[2], bfhi(w.y) * ra * g0[3]);
    o.z = pk2(bflo(w.z) * ra * g1[0], bfhi(w.z) * ra * g1[1]); o.w = pk2(bflo(w.w) * ra * g1[2], bfhi(w.w) * ra * g1[3]); *p = o;
}

__device__ __forceinline__ void route_block(const Frame& F, int blk, const bf16_t* Hb, const float* SS2, const bf16_t* Wr, const float* brg, const float* bre,
                                            float* RS2, int* CNT, int* ER, float* WGT) {
    const int lane = F.lane, wid = F.wave, tid = F.tid; const int t0 = blk * 128 + wid * 16;
    LAS float* lg = (LAS float*)(F.lds) + wid * (16 * 49);
    LAS int* cnt = (LAS int*)(F.lds + EXTRA_OFF);
    if (tid < 32) cnt[tid] = 0;
    f32x4 acc[3]; acc[0] = acc[1] = acc[2] = (f32x4){0.f, 0.f, 0.f, 0.f};
    const bf16_t* ap = Hb + (size_t)(t0 + (lane & 15)) * DM + 8 * (lane >> 4); const bf16_t* bp = Wr + (size_t)(lane & 15) * DM + 8 * (lane >> 4);
#pragma unroll 4
    for (int ks = 0; ks < 32; ++ks) { const bf16x8 a = *(const bf16x8*)(ap + 32 * ks);
#pragma unroll
        for (int nb = 0; nb < 3; ++nb) { const bf16x8 bw = *(const bf16x8*)(bp + (size_t)nb * 16 * DM + 32 * ks); acc[nb] = __builtin_amdgcn_mfma_f32_16x16x32_bf16(a, bw, acc[nb], 0, 0, 0); } }
#pragma unroll
    for (int nb = 0; nb < 3; ++nb)
#pragma unroll
        for (int r = 0; r < 4; ++r) lg[(4 * (lane >> 4) + r) * 49 + 16 * nb + (lane & 15)] = acc[nb][r];
    LDS_WAIT(); __syncthreads();
    if (lane < 16) { const int t = t0 + lane; const float rs = rsqrtf(sum16(SS2 + (size_t)t * 16) * (1.0f / 1024.0f) + EPS); RS2[t] = rs;
        const LAS float* q = lg + lane * 49;
        float gl[4]; int gs = 0;
#pragma unroll
        for (int j = 0; j < 4; ++j) gl[j] = q[j] * rs + brg[j];
        float gmx = gl[0];
#pragma unroll
        for (int j = 1; j < 4; ++j) if (gl[j] > gmx) { gmx = gl[j]; gs = j; }
        float se = 0.f;
#pragma unroll
        for (int j = 0; j < 4; ++j) se += __expf(gl[j] - gmx);
        const float gw = 1.0f / se;
        float el[8];
#pragma unroll
        for (int j = 0; j < 8; ++j) el[j] = q[4 + gs * 8 + j] * rs + bre[gs * 8 + j];
        int i0 = 0; float v0 = el[0];
#pragma unroll
        for (int j = 1; j < 8; ++j) if (el[j] > v0) { v0 = el[j]; i0 = j; }
        int i1 = 0; float v1 = -3.4e38f;
#pragma unroll
        for (int j = 0; j < 8; ++j) if (j != i0 && el[j] > v1) { v1 = el[j]; i1 = j; }
        const float e1 = __expf(v1 - v0); const float w0 = 1.0f / (1.0f + e1), w1 = e1 / (1.0f + e1);
        const int ea = gs * 8 + i0, eb = gs * 8 + i1;
        const int ra = atomicAdd((int*)&cnt[ea], 1), rb = atomicAdd((int*)&cnt[eb], 1);
        ER[t * 2] = (ea << 16) | ra; ER[t * 2 + 1] = (eb << 16) | rb; WGT[t * 2] = w0 * gw; WGT[t * 2 + 1] = w1 * gw; }
    LDS_WAIT(); __syncthreads();
    if (tid < 32) CNT[blk * 32 + tid] = cnt[tid];
    __syncthreads();
}
__device__ __forceinline__ void scatter_block(const Frame& F, int blk, const bf16_t* Hb, const float* RS2, const int* CNT, const int* ER, const float* WGT,
                                              int* TSTART, int* TOK, float* RW, float* RRS, bf16_t* XG) {
    const int lane = F.lane, wid = F.wave, tid = F.tid;
    LAS int* sm = (LAS int*)(F.lds);
    { const int e = tid & 31, part = tid >> 5; int pa = 0, pb = 0;
      for (int j = 0; j < 16; ++j) { const int b2 = part * 16 + j; const int c = CNT[b2 * 32 + e]; pa += c; pb += (b2 < blk) ? c : 0; }
      sm[part * 32 + e] = pa; sm[512 + part * 32 + e] = pb; }
    LDS_WAIT(); __syncthreads();
    if (tid < 32) { int ta = 0, tb2 = 0; for (int p = 0; p < 16; ++p) { ta += sm[p * 32 + tid]; tb2 += sm[512 + p * 32 + tid]; } sm[1024 + tid] = ta; sm[1088 + tid] = tb2; }
    LDS_WAIT(); __syncthreads();
    if (tid == 0) { int st = 0; for (int e = 0; e < 32; ++e) { sm[1152 + e] = st; st += (sm[1024 + e] + 255) & ~255; } sm[1152 + 32] = st; }
    LDS_WAIT(); __syncthreads();
    if (blk == 0 && tid < 33) TSTART[tid] = sm[1152 + tid] >> 8;
    if (tid < 256) { const int t = blk * 128 + (tid >> 1), k = tid & 1; const int er = ER[t * 2 + k]; const int e = er >> 16, rk = er & 0xffff;
        const int slot = sm[1152 + e] + sm[1088 + e] + rk; sm[1280 + tid] = slot; st_wt(TOK + slot, t * 2 + k); st_wt(RW + slot, WGT[t * 2 + k]); st_wt(RRS + slot, RS2[t]); }
    LDS_WAIT(); __syncthreads();
    for (int i = 0; i < 32; ++i) { const int pr = wid * 32 + i; const int t = blk * 128 + (pr >> 1); const int slot = sm[1280 + pr];
        const u32x4* src = (const u32x4*)(Hb + (size_t)t * DM) + lane; u32x4* dst = (u32x4*)(XG + (size_t)slot * DM) + lane; const u32x4 a = src[0], b2 = src[64]; dst[0] = a; dst[64] = b2; }
    if (blk < 32) { const int e = blk; const int p0 = sm[1152 + e] + sm[1024 + e], p1 = sm[1152 + e + 1];
        for (int r = p0 + wid; r < p1; r += NW) { if (lane == 0) { st_wt(TOK + r, -1); st_wt(RW + r, 0.f); st_wt(RRS + r, 0.f); } u32x4* dst = (u32x4*)(XG + (size_t)r * DM) + lane; dst[0] = (u32x4){0u, 0u, 0u, 0u}; dst[64] = (u32x4){0u, 0u, 0u, 0u}; } }
    __syncthreads();
}
__device__ __forceinline__ void combine_row(int t, int lane, float* H, const bf16_t* Y, bf16_t* Hb) {
    GAS f32x4* hr = (GAS f32x4*)(H + (size_t)t * DM) + lane; const GAS u32x2* y0 = (const GAS u32x2*)(Y + (size_t)t * DM) + lane; const GAS u32x2* y1 = (const GAS u32x2*)(Y + ((size_t)T + t) * DM) + lane;
    GAS u32x2* hb = (GAS u32x2*)(Hb + (size_t)t * DM) + lane;
#pragma unroll
    for (int j = 0; j < 4; ++j) { f32x4 h = hr[64 * j]; const u32x2 a = y0[64 * j], b = y1[64 * j];
        h[0] += bflo(a.x) + bflo(b.x); h[1] += bfhi(a.x) + bfhi(b.x); h[2] += bflo(a.y) + bflo(b.y); h[3] += bfhi(a.y) + bfhi(b.y);
        hr[64 * j] = h; u32x2 o; o.x = pk2(h[0], h[1]); o.y = pk2(h[2], h[3]); hb[64 * j] = o; }
}
constexpr int NPHASE = 12;
__global__ void __launch_bounds__(NW * 64, 2) mk_fwd(Args a) {
    extern __shared__ __attribute__((aligned(16))) unsigned char lds[];
    Frame F; F.lds = (LAS unsigned char*)lds; F.ws = a.ws;
    F.tid = threadIdx.x; F.lane = F.tid & 63; F.wave = __builtin_amdgcn_readfirstlane(F.tid >> 6);
    F.G = gridDim.x; { const int bx = blockIdx.x; F.vcu = (F.G % 8 == 0) ? (bx % 8) * (F.G / 8) + bx / 8 : bx; }
    for (int u = F.tid; u < (LDS_BYTES - LDSCTL_OFF) / 4; u += NW * 64) ((LAS unsigned*)(F.lds + LDSCTL_OFF))[u] = 0u;
    __syncthreads();
    unsigned* ctl = (unsigned*)(a.ws + WS_CTL);
    const bool one_launch = (a.ph_hi - a.ph_lo > 1) || (a.l_hi - a.l_lo > 1);
    XcdBarrier bar; bar.bar = ctl + CW_BAR; bar.x = 0; bar.st = nullptr;
    if (one_launch) bar = xcd_barrier_post(ctl + CW_BAR, (volatile LAS unsigned*)(F.lds + LDSCTL_OFF) + 8);
#define SEAM() do { if (one_launch) xcd_barrier(bar); } while (0)
#ifndef MK_PHMASK
#define MK_PHMASK 0xFFFF
#endif
#define FRESH(Fn) Frame Fn = F; { const int t_ = opaque_tid(); Fn.tid = t_; Fn.lane = t_ & 63; Fn.wave = __builtin_amdgcn_readfirstlane(t_ >> 6); }
#define INP(k) (((MK_PHMASK >> (k)) & 1) && (k) >= a.ph_lo && (k) < a.ph_hi)
    unsigned char* ws = a.ws;
    const int gw = F.vcu * NW + F.wave, NGW = F.G * NW;
    const int bx = (int)blockIdx.x, G = F.G;
    float* H = a.out;
    bf16_t* ZQ = (bf16_t*)(ws + WS_ZQ); bf16_t* ZKV = (bf16_t*)(ws + WS_ZKV); bf16_t* U = (bf16_t*)(ws + WS_U); bf16_t* VS = (bf16_t*)(ws + WS_VS); bf16_t* XS = (bf16_t*)(ws + WS_XS);
    bf16_t* Q = (bf16_t*)(ws + WS_Q); bf16_t* K = (bf16_t*)(ws + WS_K); bf16_t* V = (bf16_t*)(ws + WS_V); bf16_t* MIX = (bf16_t*)(ws + WS_MIX);
    bf16_t* XG = (bf16_t*)(ws + WS_XG); bf16_t* HBX = (bf16_t*)(ws + WS_HBX); bf16_t* Y01 = (bf16_t*)(ws + WS_Y01); bf16_t* PL = (bf16_t*)(ws + WS_PL); bf16_t* Pb = (bf16_t*)(ws + WS_PB);
    float* SS1 = (float*)(ws + WS_SS1); float* SS2 = (float*)(ws + WS_SS2); float* SSQ = (float*)(ws + WS_SSQ); float* SKV = (float*)(ws + WS_SKV); float* SQH = (float*)(ws + WS_SQH);
    float* SA = (float*)(ws + WS_SA); float* RS2 = (float*)(ws + WS_RS2); float* KR = (float*)(ws + WS_KR); float* E = (float*)(ws + WS_E); float* HS = (float*)(ws + WS_HS);
    const float* CS = (const float*)(ws + WS_COS); const float* SN = (const float*)(ws + WS_SIN);
    int* CNT = (int*)(ws + WS_ROUTE + RT_CNT); int* TSTART = (int*)(ws + WS_ROUTE + RT_TSTART); int* ER = (int*)(ws + WS_ROUTE + RT_ER); float* WGT = (float*)(ws + WS_ROUTE + RT_WGT);
    int* TOK = (int*)(ws + WS_ROUTE + RT_TOK); float* RW = (float*)(ws + WS_ROUTE + RT_W); float* RRS = (float*)(ws + WS_ROUTE + RT_RS);

    if (a.l_lo == 0 && INP(0)) { FRESH(Fp); p0_prologue(Fp, a); SEAM(); }

    for (int l = a.l_lo; l < a.l_hi; ++l) {
        bf16_t* HbCur = (bf16_t*)(ws + ((l & 1) ? WS_HBB : WS_HBA)); bf16_t* HbOth = (bf16_t*)(ws + ((l & 1) ? WS_HBA : WS_HBB));
        const unsigned char* s5tb = ws + WS_S5T + (size_t)l * S5T_LAYER;
        const float* gmix = a.in[24] + (size_t)l * 1024;
        if (INP(1)) {
            Gemm g{HbCur, (const bf16_t*)(ws + WS_WIN) + (size_t)l * 1536 * 1024, T, 1536, 1024}; pg8::StaticOrder So; So.init(T, 1536, G, bx);
            EpiIn Ei{SS1, ZQ, KR, ZKV, U, VS, XS, SSQ, SKV, a.in[10] + l * 256, a.in[11] + l * 256};
            pg8::gemm_phase<EpiIn, pg8::StaticOrder, true, true>(F.lds, g, So, Ei);
            SEAM();
        }
        if (INP(2)) {
#ifndef MK_SUB
#define MK_SUB 0xF
#endif
            if (MK_SUB & 1) { Gemm g{ZQ, (const bf16_t*)(ws + WS_WUQ) + (size_t)l * 1024 * 384, T, 1024, 384}; pg8::StaticOrder So; So.init(T, 1024, G, bx);
              EpiQ Eq{SSQ, Q, SQH}; pg8::gemm_phase<EpiQ, pg8::StaticOrder, true, true>(F.lds, g, So, Eq); }
            if (MK_SUB & 2) { Gemm g{ZKV, (const bf16_t*)(ws + WS_WUKV) + (size_t)l * 1024 * 256, T, 1024, 256}; pg8::StaticOrder So; So.init(T, 1024, G, bx);
              EpiKV Ek{SKV, KR, a.in[9] + l * 96, CS, SN, K, V}; pg8::gemm_phase<EpiKV, pg8::StaticOrder, true, true>(F.lds, g, So, Ek); }
            if (MK_SUB & 4) for (int task = bx; task < T / 64; task += G) { FRESH(Fp); s5_pass1(Fp, task, XS, s5tb, E); }
            SEAM();
        }
        if (INP(3)) {
            { const int idx = bx * (NW * 64) + opaque_tid(); if (idx < 2048) s5_carry(idx, s5tb, E, HS); }
            __syncthreads();
            for (int v = F.vcu; v < 256; v += G) { const int bh = v >> 4, s = v & 15;
#pragma unroll 1
                for (int i = 0; i < 4; ++i) { const int qb = (i == 0) ? 63 - s : (i == 1) ? 32 + s : (i == 2) ? 31 - s : s;
                    att::attn_unit(bh >> 3, bh & 7, qb, Q, SQH, a.in[8] + l * 96, CS, SN, K, V, MIX, SA, (char*)lds); } }
            SEAM();
        }
        if (INP(4)) {
            if (MK_SUB & 1) for (int task = bx; task < T / 64; task += G) { FRESH(Fp); s5_pass3(Fp, task, XS, s5tb, HS, (const bf16_t*)(ws + WS_WGLU) + (size_t)l * 65536, a.in[23] + l * 256, gmix, MIX); }
            if (MK_SUB & 2) for (int ci = bx; ci < T / 128; ci += G) { FRESH(Fp); gmlp_unit(Fp, ci, U, VS, (const bf16_t*)(ws + WS_WSG) + (size_t)l * 65536, a.in[13] + l * 512, gmix, MIX); }
            { FRESH(Fp); for (int t = Fp.vcu * NW + Fp.wave; t < T; t += NGW) anorm_row(t, Fp.lane, MIX, SA, gmix); }
            SEAM();
        }
        if (INP(5)) {
            Gemm g{MIX, (const bf16_t*)(ws + WS_WOUT) + (size_t)l * 1024 * 1024, T, 1024, 1024}; pg8::StaticOrder So; So.init(T, 1024, G, bx);
            EpiOut Eo{H, HbOth, SS2}; pg8::gemm_phase<EpiOut, pg8::StaticOrder, true, true>(F.lds, g, So, Eo);
            SEAM();
        }
        if (INP(6)) {
            for (int blk = bx; blk < 256; blk += G) { FRESH(Fp); route_block(Fp, blk, HbOth, SS2, (const bf16_t*)(ws + WS_WR) + (size_t)l * 48 * 1024, a.in[28] + l * 4, a.in[30] + l * 32, RS2, CNT, ER, WGT); }
            SEAM();
        }
        if (INP(7)) {
            for (int blk = bx; blk < 256; blk += G) { FRESH(Fp); scatter_block(Fp, blk, HbOth, RS2, CNT, ER, WGT, TSTART, TOK, RW, RRS, XG); }
            SEAM();
        }
        if (INP(8)) {
            Gemm g{XG, (const bf16_t*)(ws + WS_W13), NPMAX, 32 * 512, 1024}; MoeOrder<2> Mo; Mo.init(TSTART, G, bx);
            EpiM1 Em{RRS, HBX}; pg8::gemm_phase<EpiM1, MoeOrder<2>, true, true>(F.lds, g, Mo, Em);
            SEAM();
        }
        if (INP(9)) {
            Gemm g{HBX, (const bf16_t*)(ws + WS_W2T), NPMAX, 32 * 1024, 256}; MoeOrder<4> Mo; Mo.init(TSTART, G, bx);
            EpiM2 Em{TOK, RW, Y01}; pg8::gemm_phase<EpiM2, MoeOrder<4>, true, true>(F.lds, g, Mo, Em);
            SEAM();
        }
        if (INP(10)) {
            FRESH(Fp); const int gwp = Fp.vcu * NW + Fp.wave;
            for (int t = gwp; t < T; t += NGW) combine_row(t, Fp.lane, H, Y01, HbCur);
            conv_p_layer(Fp, gwp, NGW, a, l);
            if (l + 1 < NL) conv_moe_layer(Fp, gwp, NGW, a, l + 1);
            SEAM();
        }
        if (INP(11)) {
            if (MK_SUB & 1) { Gemm g{Pb, (const bf16_t*)(ws + WS_WPLE) + (size_t)l * 1024 * 256, T, 1024, 256}; pg8::StaticOrder So; So.init(T, 1024, G, bx);
              EpiPl Ep{PL}; pg8::gemm_phase<EpiPl, pg8::StaticOrder, true, true>(F.lds, g, So, Ep); }
            if (MK_SUB & 2) { Gemm g{HbCur, (const bf16_t*)(ws + WS_WPG) + (size_t)l * 1024 * 1024, T, 1024, 1024}; pg8::StaticOrder So; So.init(T, 1024, G, bx);
              EpiGate Eg{H, PL, a.in[35] + l * 1024, HbOth, SS1}; pg8::gemm_phase<EpiGate, pg8::StaticOrder, true, true>(F.lds, g, So, Eg); }
            if (l + 1 < a.l_hi) SEAM();
        }
    }
#undef SEAM
#undef INP
}
}
#if DBG && DBG != 100
namespace dbg {
constexpr int NT = 1024;
constexpr size_t WS_ORACLE = 640ull << 20;
__global__ void k_cmp(const void* f, int isbf, size_t f_rs, size_t f_off, const float* r, size_t r_rs, size_t r_off, int rows, int cols, int* res) {
    const int row = blockIdx.x * (blockDim.x >> 6) + (threadIdx.x >> 6), lane = threadIdx.x & 63;
    if (row >= rows) return;
    float sd = 0.f, sr = 0.f;
    for (int c = lane; c < cols; c += 64) {
        const float rv = r[(size_t)row * r_rs + r_off + c];
        float fv;
        if (isbf) { const unsigned short b = ((const unsigned short*)f)[(size_t)row * f_rs + f_off + c]; fv = __builtin_bit_cast(float, (unsigned)b << 16); }
        else fv = ((const float*)f)[(size_t)row * f_rs + f_off + c];
        const float d = fv - rv; sd += d * d; sr += rv * rv;
    }
    sd = nv::wsum(sd); sr = nv::wsum(sr);
    if (lane == 0) { const float rel = sqrtf(sd / fmaxf(sr, 1e-30f)); const int bad = (rel <= 0.05f) ? 0 : 1; atomicAdd(res, bad); atomicAdd(res + 1, 1); }
}
__global__ void k_cmpw(const unsigned short* Wt, const float* w_in, const float* ln1, int* res) {
    const int n = blockIdx.x * (blockDim.x >> 6) + (threadIdx.x >> 6), lane = threadIdx.x & 63;
    if (n >= 64) return;
    float sd = 0.f, sr = 0.f;
    for (int k = lane; k < 1024; k += 64) { const float rv = w_in[(size_t)k * 1440 + n] * ln1[k]; const float fv = __builtin_bit_cast(float, (unsigned)Wt[(size_t)n * 1024 + k] << 16); const float d = fv - rv; sd += d * d; sr += rv * rv; }
    sd = nv::wsum(sd); sr = nv::wsum(sr);
    if (lane == 0) { const float rel = sqrtf(sd / fmaxf(sr, 1e-30f)); atomicAdd(res, (rel <= 0.05f) ? 0 : 1); atomicAdd(res + 1, 1); }
}
__global__ void k_encode(const int* res, int ncodes, const float* x, float* out, size_t n) {
    int code = 0;
    for (int c = 1; c < ncodes; ++c) { const int bad = res[2 * c], tot = res[2 * c + 1]; if (tot > 0 && bad * 20 > tot) { code = c; break; } }
    if (code == 0) return;
    int mask = 0;
    for (int j = 0; j < 6 && code + j < ncodes; ++j) { const int bad = res[2 * (code + j)], tot = res[2 * (code + j) + 1]; if (tot > 0 && bad * 20 > tot) mask |= 1 << j; }
    const float sc = 1.0f + 10.0f * (float)code;
    for (size_t i = (size_t)blockIdx.x * blockDim.x + threadIdx.x; i < n; i += (size_t)gridDim.x * blockDim.x) out[i] = (i == 0) ? 1000.0f * (float)mask : x[i] * sc;
}
static void cmp(hipStream_t st, int* res, int code, const void* f, int isbf, size_t f_rs, size_t f_off, const float* r, size_t r_rs, size_t r_off, int cols) {
    hipLaunchKernelGGL(k_cmp, dim3((NT + 3) / 4), dim3(256), 0, st, f, isbf, f_rs, f_off, r, r_rs, r_off, NT, cols, res + 2 * code);
}
}
#endif


#if DBG == 100
namespace dh {
constexpr int NREP = 12, NBUF = 32;
__global__ void k_hash(const unsigned* p, size_t rows, size_t rs, size_t c0, size_t c1, unsigned long long* out) {
    unsigned long long acc = 0ull; const size_t w = c1 - c0, n = rows * w;
    for (size_t i = (size_t)blockIdx.x * blockDim.x + threadIdx.x; i < n; i += (size_t)gridDim.x * blockDim.x) { const size_t r = i / w, c = c0 + i % w; acc += (unsigned long long)p[r * rs + c] * (2ull * i + 1ull); }
    for (int o = 32; o >= 1; o >>= 1) acc += __shfl_xor(acc, o);
    if ((threadIdx.x & 63) == 0) atomicAdd(out, acc);
}
__global__ void k_encode(const unsigned long long* tab, int nbuf, const float* x, float* out, size_t n) {
    int code = 50, mask = 0;
    for (int b = 1; b <= nbuf; ++b) { bool diff = false; for (int r = 1; r < NREP; ++r) diff |= tab[b * 16 + r] != tab[b * 16];
        if (diff && code == 50) code = b;
        if (diff && code != 50 && b >= code && b < code + 6) mask |= 1 << (b - code); }
    const float sc = 1.0f + 10.0f * (float)code;
    for (size_t i = (size_t)blockIdx.x * blockDim.x + threadIdx.x; i < n; i += (size_t)gridDim.x * blockDim.x) out[i] = (i == 0) ? 1000.0f * (float)mask : x[i] * sc;
}
}
#endif

extern "C" void kernel_launch(void* const* d_in, const int* in_sizes, int n_in, void* d_out, int out_size, void* d_ws, size_t ws_size, hipStream_t stream) {
    using namespace mk;
    static int grid = 0;
    if (grid == 0) {
        size_t need = WS_END;
#if DBG && DBG != 100
        need = dbg::WS_ORACLE + (size_t)dbg::NT * 4096 + nv::bufs_bytes_noalias(dbg::NT);
#endif
        if (n_in != 37 || out_size != T * DM || ws_size < need) { fprintf(stderr, "kernel_launch: n_in %d out %d ws %zu (need %zu): nothing launched\n", n_in, out_size, ws_size, need); grid = -1; return; }
        int dev = 0, cus = 0, per_cu = 0;
        if (hipGetDevice(&dev) != hipSuccess || hipDeviceGetAttribute(&cus, hipDeviceAttributeMultiprocessorCount, dev) != hipSuccess) { grid = -1; return; }
        if (hipFuncSetAttribute((const void*)mk_fwd, hipFuncAttributeMaxDynamicSharedMemorySize, LDS_BYTES) != hipSuccess) { fprintf(stderr, "kernel_launch: hipFuncSetAttribute failed\n"); grid = -1; return; }
        if (hipOccupancyMaxActiveBlocksPerMultiprocessor(&per_cu, (const void*)mk_fwd, NW * 64, LDS_BYTES) != hipSuccess || per_cu < 1) fprintf(stderr, "kernel_launch: occupancy query says %d\n", per_cu);
        (void)hipGetLastError();
        grid = cus;
    }
    if (grid < 0) return;
    (void)hipMemsetAsync((char*)d_ws + WS_CTL, 0, CTL_ZERO_BYTES, stream);
    Args a{};
    for (int i = 0; i < 37; ++i) a.in[i] = (const float*)d_in[i];
    a.out = (float*)d_out; a.ws = (unsigned char*)d_ws;
#if DBG == 100
    {
        unsigned char* ws = (unsigned char*)d_ws;
        unsigned long long* tab = (unsigned long long*)(ws + (640ull << 20));
        (void)hipMemsetAsync(tab, 0, 64 * 16 * 8, stream);
        struct HB { size_t off; size_t rows, rs, c0, c1; bool out; };
        const size_t TT = T;
        const HB list[] = { {0, 0, 0, 0, 0, false},
            {WS_ZQ, TT, 192, 0, 192, false}, {WS_ZKV, TT, 128, 0, 128, false}, {WS_U, TT, 128, 0, 128, false}, {WS_VS, TT, 128, 0, 128, false}, {WS_XS, TT, 128, 0, 128, false},
            {WS_KR, TT, 32, 0, 32, false}, {WS_SSQ, TT, 8, 0, 8, false}, {WS_SKV, TT, 4, 0, 4, false},
            {WS_Q, TT * 8, 48, 0, 48, false}, {WS_K, TT * 8, 48, 0, 48, false}, {WS_V, TT * 8, 32, 0, 32, false}, {WS_SQH, TT, 32, 0, 32, false}, {WS_E, 512 * 16, 128, 0, 128, false},
            {WS_HS, 512 * 16, 128, 0, 128, false}, {WS_SA, TT, 8, 0, 8, false},
            {WS_MIX, TT, 512, 0, 256, false}, {WS_MIX, TT, 512, 256, 384, false}, {WS_MIX, TT, 512, 384, 512, false},
            {0, TT, 1024, 0, 1024, true}, {WS_HBB, TT, 512, 0, 512, false}, {WS_SS2, TT, 16, 0, 16, false},
            {WS_RS2, TT, 1, 0, 1, false}, {WS_ROUTE + RT_WGT, TT, 2, 0, 2, false}, {WS_ROUTE + RT_CNT, 256, 32, 0, 32, false} };
        const int nbuf = (int)(sizeof(list) / sizeof(list[0])) - 1;
        const size_t M = 1ull << 20;
        for (int rep = 0; rep < dh::NREP; ++rep) {
            (void)hipMemsetAsync(ws + WS_CTL, 0, CTL_ZERO_BYTES, stream);
            (void)hipMemsetAsync(ws + M, 0xAA, 633 * M, stream);
            (void)hipMemsetAsync(d_out, 0xAA, (size_t)T * DM * 4, stream);
            a.l_lo = 0; a.l_hi = 1; a.ph_lo = 0; a.ph_hi = 7;
            hipLaunchKernelGGL(mk_fwd, dim3(grid), dim3(NW * 64), LDS_BYTES, stream, a);
            for (int b = 1; b <= nbuf; ++b) { const HB& h = list[b];
                const unsigned* p = h.out ? (const unsigned*)d_out : (const unsigned*)(ws + h.off);
                hipLaunchKernelGGL(dh::k_hash, dim3(1024), dim3(256), 0, stream, p, h.rows, h.rs, h.c0, h.c1, tab + b * 16 + rep); }
        }
        hipLaunchKernelGGL(dh::k_encode, dim3(1024), dim3(256), 0, stream, tab, nbuf, (const float*)d_in[0], (float*)d_out, (size_t)T * DM);
        return;
    }
#endif
#if !DBG
    a.l_lo = 0; a.l_hi = NL; a.ph_lo = 0; a.ph_hi = NPHASE;
    hipLaunchKernelGGL(mk_fwd, dim3(grid), dim3(NW * 64), LDS_BYTES, stream, a);
#elif DBG != 100
    using dbg::NT;
    unsigned char* ws = (unsigned char*)d_ws;
    int* res = (int*)(ws + 32768);
    float* Hn = (float*)(ws + dbg::WS_ORACLE);
    nv::Bufs Bn = nv::carve_noalias(Hn, (char*)ws + dbg::WS_ORACLE + (size_t)NT * 4096, NT);
    (void)hipMemcpyAsync(Hn, d_in[0], (size_t)NT * 4096, hipMemcpyDeviceToDevice, stream);
    a.l_lo = 0; a.l_hi = 1; a.ph_lo = 0; a.ph_hi = 1;
    hipLaunchKernelGGL(mk_fwd, dim3(grid), dim3(NW * 64), LDS_BYTES, stream, a);
    dbg::cmp(stream, res, 1, d_out, 0, 1024, 0, (const float*)d_in[0], 1024, 0, 1024);
    dbg::cmp(stream, res, 2, ws + WS_HBA, 1, 1024, 0, (const float*)d_in[0], 1024, 0, 1024);
    hipLaunchKernelGGL(dbg::k_cmpw, dim3(16), dim3(256), 0, stream, (const unsigned short*)(ws + WS_WIN), (const float*)d_in[3], (const float*)d_in[2], res + 2 * 3);
    const int DBG_LAYERS = DBG;
    for (int l = 0; l < NL; ++l) {
        if (l < DBG_LAYERS) nv::layer(stream, d_in, l, Bn, 1, NT);
        for (int ph = 1; ph < NPHASE; ++ph) {
            a.l_lo = l; a.l_hi = l + 1; a.ph_lo = ph; a.ph_hi = ph + 1;
            hipLaunchKernelGGL(mk_fwd, dim3(grid), dim3(NW * 64), LDS_BYTES, stream, a);
            if (l >= DBG_LAYERS) continue;
            const int cb = l * 20 + 3;
            if (ph == 1) {
                dbg::cmp(stream, res, cb + 1, ws + WS_ZQ, 1, 384, 0, Bn.Z, 1440, 0, 384);
                dbg::cmp(stream, res, cb + 2, ws + WS_ZKV, 1, 256, 0, Bn.Z, 1440, 384, 256);
                dbg::cmp(stream, res, cb + 3, ws + WS_KR, 0, 32, 0, Bn.Z, 1440, 640, 32);
                dbg::cmp(stream, res, cb + 4, ws + WS_U, 1, 256, 0, Bn.U, 256, 0, 256);
                dbg::cmp(stream, res, cb + 5, ws + WS_VS, 1, 256, 0, Bn.VS, 256, 0, 256);
                dbg::cmp(stream, res, cb + 6, ws + WS_XS, 1, 256, 0, Bn.Z, 1440, 1184, 256);
            } else if (ph == 2) {
                for (int h = 0; h < 8; ++h) { dbg::cmp(stream, res, cb + 7, ws + WS_K, 1, 96, (size_t)h * S * 96, Bn.K, 768, h * 96, 96);
                    dbg::cmp(stream, res, cb + 8, ws + WS_V, 1, 64, (size_t)h * S * 64, Bn.KV, 1024, h * 128 + 64, 64); }
            } else if (ph == 3) {
                dbg::cmp(stream, res, cb + 9, ws + WS_MIX, 1, 1024, 0, Bn.A, 512, 0, 512);
            } else if (ph == 4) {
                dbg::cmp(stream, res, cb + 10, ws + WS_MIX, 1, 1024, 0, Bn.SNAP_MIX, 1024, 0, 512);
                dbg::cmp(stream, res, cb + 11, ws + WS_MIX, 1, 1024, 512, Bn.SNAP_MIX, 1024, 512, 256);
                dbg::cmp(stream, res, cb + 12, ws + WS_MIX, 1, 1024, 768, Bn.SNAP_MIX, 1024, 768, 256);
            } else if (ph == 5) {
                dbg::cmp(stream, res, cb + 13, d_out, 0, 1024, 0, Bn.SNAP_HMID, 1024, 0, 1024);
            } else if (ph == 10) {
                dbg::cmp(stream, res, cb + 14, d_out, 0, 1024, 0, Bn.SNAP_HMOE, 1024, 0, 1024);
            } else if (ph == 11) {
                dbg::cmp(stream, res, cb + 15, d_out, 0, 1024, 0, Hn, 1024, 0, 1024);
            }
        }
    }
    hipLaunchKernelGGL(dbg::k_encode, dim3(1024), dim3(256), 0, stream, res, 64, (const float*)d_in[0], (float*)d_out, (size_t)T * DM);
#endif
}
```

```cpp
#define DBG 0
#define MK_ATT_PRIO 1
#ifndef DBG
#define DBG 0
#endif
#ifndef MK_STRONG_BAR
#define MK_STRONG_BAR 0
#endif
#ifndef MK_BAR_SCOPE
#define MK_BAR_SCOPE "agent"
#endif
#ifndef MK_S5_ZERO
#define MK_S5_ZERO 4
#endif
#ifndef MK_S5_SCRUB
#define MK_S5_SCRUB 0
#endif
#ifndef MK_S5_V1
#define MK_S5_V1 0
#endif
#ifndef MK_S5_V2
#define MK_S5_V2 0
#endif
#ifndef MK_BAR_EARLY_REL
#define MK_BAR_EARLY_REL 0
#endif
#ifndef MK_ATT_PRIO
#define MK_ATT_PRIO 1
#endif
#ifndef MK_S5_SCALAR
#define MK_S5_SCALAR 1
#endif
#ifndef MK_ACQ_SCOPE
#define MK_ACQ_SCOPE "agent"
#endif
#include <hip/hip_runtime.h>
#include <hip/hip_bf16.h>
#include <cstdio>
#include <cstdint>
#include <cmath>
#define LAS __attribute__((address_space(3)))
__device__ __forceinline__ int opaque_tid() { int t = (int)threadIdx.x; asm volatile("" : "+v"(t)); return t; }
namespace pg8 {
#define PG8_LAS __attribute__((address_space(3)))
typedef unsigned short bf16_t;
typedef short bf16x8 __attribute__((ext_vector_type(8)));
typedef float f32x4 __attribute__((ext_vector_type(4)));
typedef unsigned u32x4 __attribute__((ext_vector_type(4)));
constexpr int BM = 256, BK = 64, HALF = 128, HTB = HALF * BK * 2  , STAGE_BYTES = 8 * HTB, NXCD = 8, WGM = 8;

__host__ __device__ __forceinline__ int lds_byte(int r, int c) { const int st = (r >> 4) * 2 + (c >> 5), rr = r & 15, cc = c & 31, ob = rr * 64 + cc * 2; return st * 1024 + (ob ^ (((ob >> 9) & 1) << 5)); }
__host__ __device__ __forceinline__ void stage_rc(int b, int& R, int& C) { const int st = b / 1024, sb = b % 1024, swz = sb ^ (((sb >> 9) & 1) << 5); R = (st >> 1) * 16 + swz / 64; C = (st & 1) * 32 + (swz % 64) / 2; }
__host__ __device__ __forceinline__ int perm32(int rho) { const int n = rho >> 4, i = rho & 15; return 8 * (i >> 2) + 4 * n + (i & 3); }

struct Unit { int pm, pn; };
struct Gemm { const bf16_t* A; const bf16_t* Bt; int M, N, K; };

struct StaticOrder {
    int nM, nN, nwg, G, c;
    __host__ __device__ void init(int M, int N, int G_, int c_) { nM = M / BM; nN = N / BM; nwg = nM * nN; G = G_; c = c_; }
    __host__ __device__ bool next(int i, Unit& u) const {
        const long L = (long)i * G + c; if (L >= nwg) return false;
        int wgid = (int)L; { const int q = nwg / NXCD, r = nwg % NXCD, xcd = wgid % NXCD, off = wgid / NXCD; wgid = (xcd < r ? xcd * (q + 1) : r * (q + 1) + (xcd - r) * q) + off; }
        const int nig = WGM * nN, gid = wgid / nig, fm = gid * WGM, gsz = (nM - fm) < WGM ? (nM - fm) : WGM;
        u.pm = fm + ((wgid % nig) % gsz); u.pn = (wgid % nig) / gsz; return true;
    }
    __device__ __forceinline__ void a_ready(const Unit&) const {}
    __device__ __forceinline__ void done(const Unit&) const {}
};

__device__ __forceinline__ unsigned cvt_pk_bf16(float lo, float hi) { unsigned r; asm volatile("v_cvt_pk_bf16_f32 %0, %1, %2" : "=v"(r) : "v"(lo), "v"(hi)); return r; }
typedef float f32x2 __attribute__((ext_vector_type(2)));
template <class Epi, class Sched, bool ALIGN_EPI = false, bool SP2 = false>
__device__ __forceinline__ void gemm_phase(PG8_LAS unsigned char* lds, const Gemm g, const Sched& S, const Epi& E) {
    const int tid = opaque_tid(), wid = __builtin_amdgcn_readfirstlane(tid >> 6), lane = tid & 63, wr = wid >> 2, wc = wid & 3, fr = lane & 15, fq = lane >> 4;
    const int K = g.K, nt = K / BK;
    unsigned voffA[2], voffB[2];
#pragma unroll
    for (int i = 0; i < 2; ++i) { int R, C; stage_rc(tid * 16 + i * 8192, R, C); const int Rb = Epi::PERM ? ((R & ~31) + perm32(R & 31)) : R;
        voffA[i] = (unsigned)(R * K + C) * 2u; voffB[i] = (unsigned)(Rb * K + C) * 2u; }
    const size_t kstep = (size_t)(BK * 2);
    const size_t hstep = (size_t)HALF * K * 2;
    const size_t tstep = 2 * hstep;
    const unsigned ldsw = (unsigned)wid * 1024u;
    const int aoff = lds_byte(wr * 64 + fr, fq * 8), boff = lds_byte(wc * 32 + fr, fq * 8);
#define PG8_SA(b, h) (((b) * 2 + (h)) * HTB)
#define PG8_SB(b, h) ((4 + (b) * 2 + (h)) * HTB)
#define PG8_STAGE(bufoff, gbase, voff) do { _Pragma("unroll") for (int _i = 0; _i < 2; ++_i) \
        __builtin_amdgcn_global_load_lds((const unsigned*)((const char*)(gbase) + (voff)[_i]), (PG8_LAS unsigned*)(lds + (bufoff) + ldsw + _i * 8192), 16, 0, 0); } while (0)
#define PG8_LDA(dst, b, h) do { _Pragma("unroll") for (int m = 0; m < 4; ++m) _Pragma("unroll") for (int k = 0; k < 2; ++k) dst[m][k] = *(const PG8_LAS bf16x8*)(lds + PG8_SA(b, h) + aoff + m * 2048 + k * 1024); } while (0)
#define PG8_LDB(dst, b, h) do { _Pragma("unroll") for (int n = 0; n < 2; ++n) _Pragma("unroll") for (int k = 0; k < 2; ++k) dst[n][k] = *(const PG8_LAS bf16x8*)(lds + PG8_SB(b, h) + boff + n * 2048 + k * 1024); } while (0)
#define PG8_MMA(ai, bj, At, Bt) do { __builtin_amdgcn_s_setprio(1); _Pragma("unroll") for (int m = 0; m < 4; ++m) _Pragma("unroll") for (int n = 0; n < 2; ++n) _Pragma("unroll") for (int k = 0; k < 2; ++k) \
        acc[ai][bj][m][n] = __builtin_amdgcn_mfma_f32_16x16x32_bf16(Bt[n][k], At[m][k], acc[ai][bj][m][n], 0, 0, 0); __builtin_amdgcn_s_setprio(0); } while (0)
#define PG8_WAIT_V(n) asm volatile("s_waitcnt vmcnt(" #n ")" ::: "memory")
#define PG8_WAIT_L(n) asm volatile("s_waitcnt lgkmcnt(" #n ")" ::: "memory")
#define PG8_BAR __builtin_amdgcn_s_barrier()
#define PG8_SCHED __builtin_amdgcn_sched_barrier(0)
    Unit cur, nxt; int ui = 0;
    if (!S.next(0, cur)) return;
    f32x4 acc[2][2][4][2];
#pragma unroll
    for (int a = 0; a < 2; ++a)
#pragma unroll
        for (int b = 0; b < 2; ++b)
#pragma unroll
            for (int m = 0; m < 4; ++m)
#pragma unroll
                for (int n = 0; n < 2; ++n) acc[a][b][m][n] = (f32x4){0.f, 0.f, 0.f, 0.f};
    bf16x8 At[4][2], B0[2][2], B1[2][2];
    const char* cA = (const char*)g.A + (size_t)cur.pm * tstep; const char* cB = (const char*)g.Bt + (size_t)cur.pn * tstep;
    S.a_ready(cur);
    if constexpr (SP2) {
        PG8_STAGE(PG8_SB(0, 0), cB, voffB); PG8_STAGE(PG8_SB(0, 1), cB + hstep, voffB); PG8_STAGE(PG8_SA(0, 0), cA, voffA); PG8_STAGE(PG8_SA(0, 1), cA + hstep, voffA);
        if (wr == 1) PG8_BAR;
        PG8_WAIT_V(2); PG8_BAR;
        PG8_STAGE(PG8_SB(1, 0), cB + kstep, voffB); PG8_STAGE(PG8_SA(1, 0), cA + kstep, voffA); PG8_STAGE(PG8_SB(1, 1), cB + hstep + kstep, voffB);
        PG8_WAIT_V(6); PG8_BAR;
    } else {
        PG8_STAGE(PG8_SB(0, 0), cB, voffB); PG8_STAGE(PG8_SA(0, 0), cA, voffA); PG8_STAGE(PG8_SB(0, 1), cB + hstep, voffB); PG8_STAGE(PG8_SA(0, 1), cA + hstep, voffA);
        if (wr == 1) PG8_BAR;
        PG8_WAIT_V(4); PG8_BAR;
        PG8_STAGE(PG8_SB(1, 0), cB + kstep, voffB); PG8_STAGE(PG8_SA(1, 0), cA + kstep, voffA); PG8_STAGE(PG8_SB(1, 1), cB + hstep + kstep, voffB);
        PG8_WAIT_V(6); PG8_BAR;
    }
    for (;;) {
        const bool has_next = S.next(ui + 1, nxt);
        const char* nA = has_next ? (const char*)g.A + (size_t)nxt.pm * tstep : cA; const char* nB = has_next ? (const char*)g.Bt + (size_t)nxt.pn * tstep : cB;
        _Pragma("nounroll") for (int t = 0; t < nt; t += 2) {
            const bool last = (t == nt - 2);
            const char* a1 = cA + (size_t)(t + 1) * kstep;
            const char* a2 = last ? nA : cA + (size_t)(t + 2) * kstep; const char* b2 = last ? nB : cB + (size_t)(t + 2) * kstep;
            const char* a3 = a2 + kstep; const char* b3 = b2 + kstep;
            if (last && has_next) S.a_ready(nxt);
            if constexpr (SP2) {
            PG8_LDB(B0, 0, 0); PG8_LDB(B1, 0, 1); PG8_SCHED; PG8_LDA(At, 0, 0); PG8_STAGE(PG8_SA(1, 1), a1 + hstep, voffA);
            PG8_WAIT_V(8); PG8_WAIT_L(0); PG8_BAR; PG8_MMA(0, 0, At, B0); PG8_MMA(0, 1, At, B1); PG8_BAR; PG8_SCHED;
            PG8_LDA(At, 0, 1); PG8_STAGE(PG8_SB(0, 0), b2, voffB); PG8_STAGE(PG8_SB(0, 1), b2 + hstep, voffB); PG8_STAGE(PG8_SA(0, 0), a2, voffA);
            PG8_WAIT_V(8); PG8_WAIT_L(0); PG8_BAR; PG8_MMA(1, 0, At, B0); PG8_MMA(1, 1, At, B1); PG8_BAR; PG8_SCHED;
            PG8_LDB(B0, 1, 0); PG8_LDB(B1, 1, 1); PG8_SCHED; PG8_LDA(At, 1, 0); PG8_STAGE(PG8_SA(0, 1), a2 + hstep, voffA);
            PG8_WAIT_V(8); PG8_WAIT_L(0); PG8_BAR; PG8_MMA(0, 0, At, B0); PG8_MMA(0, 1, At, B1); PG8_BAR; PG8_SCHED;
            PG8_LDA(At, 1, 1); PG8_STAGE(PG8_SB(1, 0), b3, voffB); PG8_STAGE(PG8_SB(1, 1), b3 + hstep, voffB); PG8_STAGE(PG8_SA(1, 0), a3, voffA);
            PG8_WAIT_V(8); PG8_WAIT_L(0); PG8_BAR; PG8_MMA(1, 0, At, B0); PG8_MMA(1, 1, At, B1); PG8_BAR; PG8_SCHED;
            } else {
            PG8_LDB(B0, 0, 0); PG8_SCHED; PG8_LDA(At, 0, 0); PG8_STAGE(PG8_SA(1, 1), a1 + hstep, voffA);
            PG8_WAIT_L(8); PG8_BAR; PG8_WAIT_L(0); PG8_MMA(0, 0, At, B0); PG8_BAR; PG8_SCHED;
            PG8_LDB(B1, 0, 1); PG8_STAGE(PG8_SB(0, 0), b2, voffB);
            PG8_BAR; PG8_WAIT_L(0); PG8_MMA(0, 1, At, B1); PG8_BAR;
            PG8_LDA(At, 0, 1); PG8_STAGE(PG8_SA(0, 0), a2, voffA);
            PG8_BAR; PG8_WAIT_L(0); PG8_MMA(1, 0, At, B0); PG8_BAR; PG8_SCHED;
            PG8_STAGE(PG8_SB(0, 1), b2 + hstep, voffB);
            PG8_WAIT_V(6); PG8_BAR; PG8_MMA(1, 1, At, B1); PG8_BAR;
            PG8_LDB(B0, 1, 0); PG8_SCHED; PG8_LDA(At, 1, 0); PG8_STAGE(PG8_SA(0, 1), a2 + hstep, voffA);
            PG8_WAIT_L(8); PG8_BAR; PG8_WAIT_L(0); PG8_MMA(0, 0, At, B0); PG8_BAR; PG8_SCHED;
            PG8_LDB(B1, 1, 1); PG8_STAGE(PG8_SB(1, 0), b3, voffB);
            PG8_BAR; PG8_WAIT_L(0); PG8_MMA(0, 1, At, B1); PG8_BAR;
            PG8_LDA(At, 1, 1); PG8_STAGE(PG8_SA(1, 0), a3, voffA);
            PG8_BAR; PG8_WAIT_L(0); PG8_MMA(1, 0, At, B0); PG8_BAR; PG8_SCHED;
            PG8_STAGE(PG8_SB(1, 1), b3 + hstep, voffB);
            PG8_WAIT_V(6); PG8_BAR; PG8_MMA(1, 1, At, B1); PG8_BAR;
            }
        }
        if constexpr (ALIGN_EPI) { if (wr == 0) PG8_BAR; }
        if constexpr (!Epi::AFTER_DRAIN) { E(acc, cur, wr, wc, fr, fq); S.done(cur); }
        if (!has_next) break;
#pragma unroll
        for (int a = 0; a < 2; ++a)
#pragma unroll
            for (int b = 0; b < 2; ++b)
#pragma unroll
                for (int m = 0; m < 4; ++m)
#pragma unroll
                    for (int n = 0; n < 2; ++n) acc[a][b][m][n] = (f32x4){0.f, 0.f, 0.f, 0.f};
        cur = nxt; cA = nA; cB = nB; ++ui;
        if constexpr (ALIGN_EPI) { if (wr == 1) PG8_BAR; }
    }
    PG8_WAIT_V(0);
    if constexpr (!ALIGN_EPI) { if (wr == 0) PG8_BAR; }
    PG8_BAR;
    if constexpr (Epi::AFTER_DRAIN) { E.fused(acc, cur, wr, wc, fr, fq, lds, wid, lane); S.done(cur); }
#undef PG8_SA
#undef PG8_SB
#undef PG8_STAGE
#undef PG8_LDA
#undef PG8_LDB
#undef PG8_MMA
#undef PG8_WAIT_V
#undef PG8_WAIT_L
#undef PG8_BAR
#undef PG8_SCHED
}
template <class Epi, class Sched, bool ALIGN_EPI = false, bool SP2 = false>
__device__ __forceinline__ void gemm_phase_g(PG8_LAS unsigned char* lds, const Gemm g, const Sched& S, const Epi& E, const unsigned* RTO) {
    const int tid = opaque_tid(), wid = __builtin_amdgcn_readfirstlane(tid >> 6), lane = tid & 63, wr = wid >> 2, wc = wid & 3, fr = lane & 15, fq = lane >> 4;
    const int K = g.K, nt = K / BK;
    unsigned voffA[2], voffB[2]; int RA[2]; unsigned CA2[2]; unsigned vA[2][2], nvA[2][2];
#define PG8_GVA(dst, pm_) do { _Pragma("unroll") for (int h_ = 0; h_ < 2; ++h_) _Pragma("unroll") for (int i_ = 0; i_ < 2; ++i_) dst[h_][i_] = RTO[(pm_) * 256 + h_ * 128 + RA[i_]] + CA2[i_]; } while (0)
#pragma unroll
    for (int i = 0; i < 2; ++i) { int R, C; stage_rc(tid * 16 + i * 8192, R, C); const int Rb = Epi::PERM ? ((R & ~31) + perm32(R & 31)) : R;
        voffA[i] = (unsigned)(R * K + C) * 2u; voffB[i] = (unsigned)(Rb * K + C) * 2u; RA[i] = R; CA2[i] = (unsigned)C * 2u; }
    const size_t kstep = (size_t)(BK * 2);
    const size_t hstep = (size_t)HALF * K * 2;
    const size_t tstep = 2 * hstep;
    const unsigned ldsw = (unsigned)wid * 1024u;
    const int aoff = lds_byte(wr * 64 + fr, fq * 8), boff = lds_byte(wc * 32 + fr, fq * 8);
#define PG8_SA(b, h) (((b) * 2 + (h)) * HTB)
#define PG8_SB(b, h) ((4 + (b) * 2 + (h)) * HTB)
#define PG8_STAGE(bufoff, gbase, voff) do { _Pragma("unroll") for (int _i = 0; _i < 2; ++_i) \
        __builtin_amdgcn_global_load_lds((const unsigned*)((const char*)(gbase) + (voff)[_i]), (PG8_LAS unsigned*)(lds + (bufoff) + ldsw + _i * 8192), 16, 0, 0); } while (0)
#define PG8_LDA(dst, b, h) do { _Pragma("unroll") for (int m = 0; m < 4; ++m) _Pragma("unroll") for (int k = 0; k < 2; ++k) dst[m][k] = *(const PG8_LAS bf16x8*)(lds + PG8_SA(b, h) + aoff + m * 2048 + k * 1024); } while (0)
#define PG8_LDB(dst, b, h) do { _Pragma("unroll") for (int n = 0; n < 2; ++n) _Pragma("unroll") for (int k = 0; k < 2; ++k) dst[n][k] = *(const PG8_LAS bf16x8*)(lds + PG8_SB(b, h) + boff + n * 2048 + k * 1024); } while (0)
#define PG8_MMA(ai, bj, At, Bt) do { __builtin_amdgcn_s_setprio(1); _Pragma("unroll") for (int m = 0; m < 4; ++m) _Pragma("unroll") for (int n = 0; n < 2; ++n) _Pragma("unroll") for (int k = 0; k < 2; ++k) \
        acc[ai][bj][m][n] = __builtin_amdgcn_mfma_f32_16x16x32_bf16(Bt[n][k], At[m][k], acc[ai][bj][m][n], 0, 0, 0); __builtin_amdgcn_s_setprio(0); } while (0)
#define PG8_WAIT_V(n) asm volatile("s_waitcnt vmcnt(" #n ")" ::: "memory")
#define PG8_WAIT_L(n) asm volatile("s_waitcnt lgkmcnt(" #n ")" ::: "memory")
#define PG8_BAR __builtin_amdgcn_s_barrier()
#define PG8_SCHED __builtin_amdgcn_sched_barrier(0)
    Unit cur, nxt; int ui = 0;
    if (!S.next(0, cur)) return;
    f32x4 acc[2][2][4][2];
#pragma unroll
    for (int a = 0; a < 2; ++a)
#pragma unroll
        for (int b = 0; b < 2; ++b)
#pragma unroll
            for (int m = 0; m < 4; ++m)
#pragma unroll
                for (int n = 0; n < 2; ++n) acc[a][b][m][n] = (f32x4){0.f, 0.f, 0.f, 0.f};
    bf16x8 At[4][2], B0[2][2], B1[2][2];
    const char* const gA = (const char*)g.A; const char* cA = gA; const char* cB = (const char*)g.Bt + (size_t)cur.pn * tstep;
    PG8_GVA(vA, cur.pm);
    S.a_ready(cur);
    if constexpr (SP2) {
        PG8_STAGE(PG8_SB(0, 0), cB, voffB); PG8_STAGE(PG8_SB(0, 1), cB + hstep, voffB); PG8_STAGE(PG8_SA(0, 0), gA, vA[0]); PG8_STAGE(PG8_SA(0, 1), gA, vA[1]);
        if (wr == 1) PG8_BAR;
        PG8_WAIT_V(2); PG8_BAR;
        PG8_STAGE(PG8_SB(1, 0), cB + kstep, voffB); PG8_STAGE(PG8_SA(1, 0), gA + kstep, vA[0]); PG8_STAGE(PG8_SB(1, 1), cB + hstep + kstep, voffB);
        PG8_WAIT_V(6); PG8_BAR;
    } else {
        PG8_STAGE(PG8_SB(0, 0), cB, voffB); PG8_STAGE(PG8_SA(0, 0), gA, vA[0]); PG8_STAGE(PG8_SB(0, 1), cB + hstep, voffB); PG8_STAGE(PG8_SA(0, 1), gA, vA[1]);
        if (wr == 1) PG8_BAR;
        PG8_WAIT_V(4); PG8_BAR;
        PG8_STAGE(PG8_SB(1, 0), cB + kstep, voffB); PG8_STAGE(PG8_SA(1, 0), gA + kstep, vA[0]); PG8_STAGE(PG8_SB(1, 1), cB + hstep + kstep, voffB);
        PG8_WAIT_V(6); PG8_BAR;
    }
    for (;;) {
        const bool has_next = S.next(ui + 1, nxt);
        const char* nA = gA; const char* nB = has_next ? (const char*)g.Bt + (size_t)nxt.pn * tstep : cB;
        if (has_next) { PG8_GVA(nvA, nxt.pm); } else { nvA[0][0] = vA[0][0]; nvA[0][1] = vA[0][1]; nvA[1][0] = vA[1][0]; nvA[1][1] = vA[1][1]; }
        _Pragma("nounroll") for (int t = 0; t < nt; t += 2) {
            const bool last = (t == nt - 2);
            const char* a1 = gA + (size_t)(t + 1) * kstep;
            const unsigned xA0[2] = {last ? nvA[0][0] : vA[0][0], last ? nvA[0][1] : vA[0][1]}, xA1[2] = {last ? nvA[1][0] : vA[1][0], last ? nvA[1][1] : vA[1][1]};
            const char* a2 = last ? gA : gA + (size_t)(t + 2) * kstep; const char* b2 = last ? nB : cB + (size_t)(t + 2) * kstep;
            const char* a3 = a2 + kstep; const char* b3 = b2 + kstep;
            if (last && has_next) S.a_ready(nxt);
            if constexpr (SP2) {
            PG8_LDB(B0, 0, 0); PG8_LDB(B1, 0, 1); PG8_SCHED; PG8_LDA(At, 0, 0); PG8_STAGE(PG8_SA(1, 1), a1, vA[1]);
            PG8_WAIT_V(8); PG8_WAIT_L(0); PG8_BAR; PG8_MMA(0, 0, At, B0); PG8_MMA(0, 1, At, B1); PG8_BAR; PG8_SCHED;
            PG8_LDA(At, 0, 1); PG8_STAGE(PG8_SB(0, 0), b2, voffB); PG8_STAGE(PG8_SB(0, 1), b2 + hstep, voffB); PG8_STAGE(PG8_SA(0, 0), a2, xA0);
            PG8_WAIT_V(8); PG8_WAIT_L(0); PG8_BAR; PG8_MMA(1, 0, At, B0); PG8_MMA(1, 1, At, B1); PG8_BAR; PG8_SCHED;
            PG8_LDB(B0, 1, 0); PG8_LDB(B1, 1, 1); PG8_SCHED; PG8_LDA(At, 1, 0); PG8_STAGE(PG8_SA(0, 1), a2, xA1);
            PG8_WAIT_V(8); PG8_WAIT_L(0); PG8_BAR; PG8_MMA(0, 0, At, B0); PG8_MMA(0, 1, At, B1); PG8_BAR; PG8_SCHED;
            PG8_LDA(At, 1, 1); PG8_STAGE(PG8_SB(1, 0), b3, voffB); PG8_STAGE(PG8_SB(1, 1), b3 + hstep, voffB); PG8_STAGE(PG8_SA(1, 0), a3, xA0);
            PG8_WAIT_V(8); PG8_WAIT_L(0); PG8_BAR; PG8_MMA(1, 0, At, B0); PG8_MMA(1, 1, At, B1); PG8_BAR; PG8_SCHED;
            } else {
            PG8_LDB(B0, 0, 0); PG8_SCHED; PG8_LDA(At, 0, 0); PG8_STAGE(PG8_SA(1, 1), a1, vA[1]);
            PG8_WAIT_L(8); PG8_BAR; PG8_WAIT_L(0); PG8_MMA(0, 0, At, B0); PG8_BAR; PG8_SCHED;
            PG8_LDB(B1, 0, 1); PG8_STAGE(PG8_SB(0, 0), b2, voffB);
            PG8_BAR; PG8_WAIT_L(0); PG8_MMA(0, 1, At, B1); PG8_BAR;
            PG8_LDA(At, 0, 1); PG8_STAGE(PG8_SA(0, 0), a2, xA0);
            PG8_BAR; PG8_WAIT_L(0); PG8_MMA(1, 0, At, B0); PG8_BAR; PG8_SCHED;
            PG8_STAGE(PG8_SB(0, 1), b2 + hstep, voffB);
            PG8_WAIT_V(6); PG8_BAR; PG8_MMA(1, 1, At, B1); PG8_BAR;
            PG8_LDB(B0, 1, 0); PG8_SCHED; PG8_LDA(At, 1, 0); PG8_STAGE(PG8_SA(0, 1), a2, xA1);
            PG8_WAIT_L(8); PG8_BAR; PG8_WAIT_L(0); PG8_MMA(0, 0, At, B0); PG8_BAR; PG8_SCHED;
            PG8_LDB(B1, 1, 1); PG8_STAGE(PG8_SB(1, 0), b3, voffB);
            PG8_BAR; PG8_WAIT_L(0); PG8_MMA(0, 1, At, B1); PG8_BAR;
            PG8_LDA(At, 1, 1); PG8_STAGE(PG8_SA(1, 0), a3, xA0);
            PG8_BAR; PG8_WAIT_L(0); PG8_MMA(1, 0, At, B0); PG8_BAR; PG8_SCHED;
            PG8_STAGE(PG8_SB(1, 1), b3 + hstep, voffB);
            PG8_WAIT_V(6); PG8_BAR; PG8_MMA(1, 1, At, B1); PG8_BAR;
            }
        }
        if constexpr (ALIGN_EPI) { if (wr == 0) PG8_BAR; }
        if constexpr (!Epi::AFTER_DRAIN) { E(acc, cur, wr, wc, fr, fq); S.done(cur); }
        if (!has_next) break;
#pragma unroll
        for (int a = 0; a < 2; ++a)
#pragma unroll
            for (int b = 0; b < 2; ++b)
#pragma unroll
                for (int m = 0; m < 4; ++m)
#pragma unroll
                    for (int n = 0; n < 2; ++n) acc[a][b][m][n] = (f32x4){0.f, 0.f, 0.f, 0.f};
        cur = nxt; cA = nA; cB = nB; ++ui; vA[0][0] = nvA[0][0]; vA[0][1] = nvA[0][1]; vA[1][0] = nvA[1][0]; vA[1][1] = nvA[1][1];
        if constexpr (ALIGN_EPI) { if (wr == 1) PG8_BAR; }
    }
    PG8_WAIT_V(0);
    if constexpr (!ALIGN_EPI) { if (wr == 0) PG8_BAR; }
    PG8_BAR;
    if constexpr (Epi::AFTER_DRAIN) { E.fused(acc, cur, wr, wc, fr, fq, lds, wid, lane); S.done(cur); }
#undef PG8_SA
#undef PG8_SB
#undef PG8_STAGE
#undef PG8_LDA
#undef PG8_LDB
#undef PG8_MMA
#undef PG8_WAIT_V
#undef PG8_WAIT_L
#undef PG8_BAR
#undef PG8_SCHED
#undef PG8_GVA
}
}
#define XB_TMO      128
#define XB_XCNT(j)  (256  + 64 * (j))
#define XB_XSUB(j)  (1280 + 64 * (j))
#define XB_XGEN(j)  (2304 + 64 * (j))
#define XB_TOP      3328
#define XB_TOPGEN   3392
#define XCD_BAR_WORDS 3456
#define XB_SPIN_CAP (1u << 18)

__device__ __forceinline__ unsigned xb_ld(unsigned* p)              { return __hip_atomic_load(p, __ATOMIC_RELAXED, __HIP_MEMORY_SCOPE_AGENT); }
__device__ __forceinline__ unsigned xb_add(unsigned* p, unsigned v) { return __hip_atomic_fetch_add(p, v, __ATOMIC_RELAXED, __HIP_MEMORY_SCOPE_AGENT); }
__device__ __forceinline__ unsigned xb_xcc_id() { return (unsigned)__builtin_amdgcn_s_getreg((3 << 11) | 20) & 0xFu; }
#define XB_SPIN(cond, bar) do { unsigned _sp = 0; while (cond) { __builtin_amdgcn_s_sleep(1); \
    if ((++_sp & 255u) == 0u) { if (xb_ld(&(bar)[XB_TMO])) break; if (_sp > XB_SPIN_CAP) { atomicAdd(&(bar)[XB_TMO], 1u); break; } } } } while (0)

struct XcdBarrier {
    unsigned* bar; unsigned x;
    volatile LAS unsigned* st;
};

__device__ __forceinline__ XcdBarrier xcd_barrier_post(unsigned* bar, volatile LAS unsigned* st) {
    XcdBarrier b; b.bar = bar; b.x = xb_xcc_id(); b.st = st;
    if (threadIdx.x == 0) (void)xb_add(&bar[XB_XCNT(b.x)], 1u);
    return b;
}
__device__ __forceinline__ void xcd_barrier_complete(unsigned* bar, unsigned x, unsigned& nloc, unsigned& nx) {
    const unsigned G = gridDim.x * gridDim.y * gridDim.z;
    unsigned sum, cnt, mine, sp = 0u;
    for (;;) {
        sum = 0u; cnt = 0u; mine = 0u;
#pragma unroll
        for (unsigned j = 0; j < 16; ++j) { const unsigned c = xb_ld(&bar[XB_XCNT(j)]); sum += c; cnt += (c > 0u) ? 1u : 0u; mine = (j == x) ? c : mine; }
        if (sum == G) break;
        __builtin_amdgcn_s_sleep(1);
        if ((++sp & 255u) == 0u) { if (xb_ld(&bar[XB_TMO])) break; if (sp > XB_SPIN_CAP) { atomicAdd(&bar[XB_TMO], 1u); break; } }
    }
    nloc = mine > 0u ? mine : 1u; nx = cnt > 0u ? cnt : 1u;
}

__device__ __forceinline__ void xcd_barrier(const XcdBarrier& b) {
#if MK_STRONG_BAR
    __builtin_amdgcn_fence(__ATOMIC_RELEASE, MK_BAR_SCOPE);
#endif
    asm volatile("s_waitcnt vmcnt(0)" ::: "memory");
    __syncthreads();
    if (threadIdx.x == 0) {
        unsigned* bar = b.bar;
        __builtin_amdgcn_s_waitcnt(0);
        unsigned nloc = b.st[0], nx = b.st[1];
        if (nloc == 0u) { xcd_barrier_complete(bar, b.x, nloc, nx); b.st[0] = nloc; b.st[1] = nx; }
#if MK_STRONG_BAR
        __builtin_amdgcn_fence(__ATOMIC_RELEASE, MK_BAR_SCOPE);
        asm volatile("s_waitcnt vmcnt(0)" ::: "memory");
#endif
        const unsigned old = xb_add(&bar[XB_XSUB(b.x)], 1u);
        const unsigned gen = old / nloc;
        if (old + 1u == (gen + 1u) * nloc) {
            __builtin_amdgcn_fence(__ATOMIC_RELEASE, MK_BAR_SCOPE);
            asm volatile("s_waitcnt vmcnt(0)" ::: "memory");
            const unsigned og = xb_add(&bar[XB_TOP], 1u);
            const unsigned tg = og / nx;
            if (og + 1u == (tg + 1u) * nx) xb_add(&bar[XB_TOPGEN], 1u);
            else XB_SPIN(xb_ld(&bar[XB_TOPGEN]) == tg, bar);
#if MK_BAR_EARLY_REL
            xb_add(&bar[XB_XGEN(b.x)], 1u);
            __builtin_amdgcn_fence(__ATOMIC_ACQUIRE, MK_ACQ_SCOPE);
#else
            __builtin_amdgcn_fence(__ATOMIC_ACQUIRE, MK_ACQ_SCOPE);
            xb_add(&bar[XB_XGEN(b.x)], 1u);
#endif
            asm volatile("s_waitcnt vmcnt(0)" ::: "memory");
        } else {
            XB_SPIN(xb_ld(&bar[XB_XGEN(b.x)]) == gen, bar);
            __builtin_amdgcn_fence(__ATOMIC_ACQUIRE, MK_ACQ_SCOPE);
            asm volatile("s_waitcnt vmcnt(0)" ::: "memory");
        }
    }
    __syncthreads();
}
namespace mk {
using pg8::bf16_t; using pg8::bf16x8; using pg8::f32x4; using pg8::u32x4; using pg8::Unit; using pg8::Gemm; using pg8::cvt_pk_bf16;
typedef float f32x16 __attribute__((ext_vector_type(16)));
typedef float f32x2v __attribute__((ext_vector_type(2)));
typedef short s16x4 __attribute__((ext_vector_type(4)));
typedef unsigned u32x2 __attribute__((ext_vector_type(2)));
constexpr int T = 32768, S = 16384, NBATCH = 2, DM = 1024, NL = 4, NW = 8;
constexpr int NPMAX = 73728;
constexpr float EPS = 1e-6f;
constexpr size_t MiB = 1u << 20;
constexpr size_t WS_CTL = 0, CTL_ZERO_BYTES = 1 * MiB;
constexpr size_t WS_COS = 1 * MiB, WS_SIN = 2 * MiB, WS_S5T = 3 * MiB, WS_WSG = 4 * MiB, WS_WR = 5 * MiB, WS_WGLU = 6 * MiB;
constexpr size_t WS_WIN = 8 * MiB, WS_WUQ = 20 * MiB, WS_WUKV = 23 * MiB, WS_WOUT = 25 * MiB, WS_WPG = 33 * MiB, WS_WPLE = 41 * MiB, WS_W13 = 43 * MiB, WS_W2T = 75 * MiB;
constexpr size_t WS_SS1 = 91 * MiB, WS_SS2 = 93 * MiB, WS_SSQ = 95 * MiB, WS_SKV = 96 * MiB, WS_SQH = 97 * MiB, WS_SA = 101 * MiB, WS_RS2 = 102 * MiB, WS_KR = 103 * MiB;
constexpr size_t WS_E = 107 * MiB, WS_HS = 111 * MiB, WS_ROUTE = 115 * MiB;
constexpr size_t WS_HBA = 118 * MiB, WS_HBB = 182 * MiB, WS_PB = 246 * MiB;
constexpr size_t WS_ZQ = 262 * MiB, WS_ZKV = 286 * MiB, WS_U = 302 * MiB, WS_VS = 318 * MiB, WS_XS = 334 * MiB, WS_Q = 350 * MiB, WS_K = 398 * MiB, WS_V = 446 * MiB, WS_MIX = 478 * MiB;
constexpr size_t WS_XG = 262 * MiB, WS_HBX = 406 * MiB, WS_Y01 = 442 * MiB, WS_PL = 570 * MiB, WS_END = 634 * MiB;
constexpr size_t WS_W13B = 634 * MiB, WS_W2TB = 666 * MiB, WS_END2 = 682 * MiB;
constexpr size_t RT_CNT = 0, RT_TSTART = 64 << 10, RT_ER = 128 << 10, RT_WGT = 512 << 10, RT_TOK = 1 * MiB, RT_W = 1 * MiB + (512 << 10), RT_RS = 2 * MiB, RT_RTO = 2 * MiB + (512 << 10);
constexpr unsigned ZERO_OFF = 512u << 10;
constexpr size_t S5T_LAYER = 160 << 10, S5T_AB = 0, S5T_BBT = 16 << 10, S5T_CMT = 80 << 10, S5T_D = 144 << 10;
constexpr int CW_BAR = 4096;
constexpr int RING_BYTES = 131072, EXTRA_OFF = 131072, EXTRA_BYTES = 8192, LDSCTL_OFF = EXTRA_OFF + EXTRA_BYTES, LDS_BYTES = 147456;

#define GAS __attribute__((address_space(1)))
#define LAS __attribute__((address_space(3)))
#define MFMA_PAD(x) asm volatile("s_nop 15\n\ts_nop 7" : "+v"(x))
#define PHASE_SYNC() do { asm volatile("s_waitcnt vmcnt(0) lgkmcnt(0)" ::: "memory"); __syncthreads(); } while (0)
#define LDS_WAIT() asm volatile("s_waitcnt lgkmcnt(0)" ::: "memory")
#define VM_WAIT() asm volatile("s_waitcnt vmcnt(0)" ::: "memory")
__device__ __forceinline__ unsigned f2bf(float f) { unsigned u = __builtin_bit_cast(unsigned, f); return (u + 0x7fffu + ((u >> 16) & 1u)) >> 16; }
typedef float f32x2_t __attribute__((ext_vector_type(2))); typedef __bf16 bf16x2_t __attribute__((ext_vector_type(2)));
__device__ __forceinline__ unsigned pk2(float lo, float hi) { f32x2_t v = {lo, hi}; bf16x2_t b = __builtin_convertvector(v, bf16x2_t); return __builtin_bit_cast(unsigned, b); }
__device__ __forceinline__ float bf2f(unsigned short b) { return __builtin_bit_cast(float, (unsigned)b << 16); }
__device__ __forceinline__ float bflo(unsigned w) { return __builtin_bit_cast(float, w << 16); }
__device__ __forceinline__ float bfhi(unsigned w) { return __builtin_bit_cast(float, w & 0xffff0000u); }
__device__ __forceinline__ float shx(float v, int o) {
    const int l = opaque_tid() & 63; return __builtin_bit_cast(float, __builtin_amdgcn_ds_bpermute((l ^ o) << 2, __builtin_bit_cast(int, v))); }
__device__ __forceinline__ float wave_sum(float v) {
    const int l = opaque_tid() & 63;
#pragma unroll
    for (int o = 1; o < 64; o <<= 1) v += __builtin_bit_cast(float, __builtin_amdgcn_ds_bpermute((l ^ o) << 2, __builtin_bit_cast(int, v)));
    return v;
}
__device__ __forceinline__ float fq_sum(float v) { v += shx(v, 16); v += shx(v, 32); return v; }
__device__ __forceinline__ float gelu_t(float x) {
    const float u2 = 1.5957691216057308f * (x + 0.044715f * x * x * x);
    return x * __builtin_amdgcn_rcpf(1.0f + __builtin_amdgcn_exp2f(-1.4426950408889634f * u2));
}
__device__ __forceinline__ float sigm(float x) { return __builtin_amdgcn_rcpf(1.0f + __builtin_amdgcn_exp2f(-1.4426950408889634f * x)); }

__device__ __forceinline__ void st_wt(float* p, float v) { *p = v; }
__device__ __forceinline__ void st_wt(int* p, int v) { *p = v; }

struct Args { const float* in[37]; float* out; unsigned char* ws; int l_lo, l_hi, ph_lo, ph_hi, shift, pad; };

struct Frame {
    LAS unsigned char* lds;
    unsigned char* ws;
    int tid, lane, wave, G, vcu;
};

__device__ __forceinline__ void conv_item(const float* src, int ldsrc, int srccol0, const float* gain, bf16_t* dst, int K, int dstrow0, int k0, LAS float* scr, int lane, int gain_kmax = 1 << 30) {
    const int c = lane & 7;
    if (srccol0 < 0) {
#pragma unroll
        for (int j = 0; j < 4; ++j) { const int n = (lane >> 3) + 8 * j; *(GAS u32x4*)(dst + (size_t)(dstrow0 + n) * K + k0 + 8 * c) = (u32x4){0u, 0u, 0u, 0u}; }
        return;
    }
    { f32x4 v[8]; const int rr = lane >> 3, c4 = 4 * (lane & 7);
#pragma unroll
      for (int i = 0; i < 8; ++i) v[i] = *(const GAS f32x4*)(src + (size_t)(k0 + 8 * i + rr) * ldsrc + srccol0 + c4);
      f32x4 g0 = (f32x4){1.f, 1.f, 1.f, 1.f}, g1 = g0;
      if (gain && k0 < gain_kmax) { g0 = *(const GAS f32x4*)(gain + k0 + 8 * c); g1 = *(const GAS f32x4*)(gain + k0 + 8 * c + 4); }
#pragma unroll
      for (int i = 0; i < 8; ++i) { LAS float* d = scr + (8 * i + rr) * 33 + c4; d[0] = v[i][0]; d[1] = v[i][1]; d[2] = v[i][2]; d[3] = v[i][3]; }
      LDS_WAIT(); asm volatile("" ::: "memory");
#pragma unroll
      for (int j = 0; j < 4; ++j) { const int n = (lane >> 3) + 8 * j; const LAS float* sp = scr + (8 * c) * 33 + n;
          u32x4 o; o.x = pk2(sp[0 * 33] * g0[0], sp[1 * 33] * g0[1]); o.y = pk2(sp[2 * 33] * g0[2], sp[3 * 33] * g0[3]); o.z = pk2(sp[4 * 33] * g1[0], sp[5 * 33] * g1[1]); o.w = pk2(sp[6 * 33] * g1[2], sp[7 * 33] * g1[3]);
          *(GAS u32x4*)(dst + (size_t)(dstrow0 + n) * K + k0 + 8 * c) = o; }
      LDS_WAIT(); asm volatile("" ::: "memory"); }
}
template <class ColMap>
__device__ __forceinline__ void conv_matrix(const Frame& F, int gw, int NGW, const float* src, int ldsrc, const float* gain, bf16_t* dst, int K, int N, ColMap cm, int gain_kmax = 1 << 30) {
    LAS float* scr = (LAS float*)(F.lds + F.wave * 16384);
    const int nblk = N / 32, nitems = (K / 64) * nblk;
    for (int it = gw; it < nitems; it += NGW) { const int kb = it / nblk, nb = it % nblk; conv_item(src, ldsrc, cm(nb), gain, dst, K, 32 * nb, 64 * kb, scr, F.lane, gain_kmax); }
}
struct CmIdent { __device__ int operator()(int nb) const { return 32 * nb; } };
struct CmWin {
    __device__ int operator()(int nb) const {
        const int n = 32 * nb;
        if (n < 384) return n;
        if (n < 416) return 640;
        if (n < 512) return -1;
        if (n < 768) return 384 + (n - 512);
        if (n < 1024) return 672 + (n - 768);
        if (n < 1280) { const int p = n - 1024, bj = p >> 7, wc = (p >> 5) & 3; return 928 + 64 * wc + 32 * bj; }
        return 1184 + (n - 1280);
    }
};
struct CmUq { __device__ int operator()(int nb) const { const int h = nb >> 2, j = nb & 3; return j < 3 ? h * 96 + 32 * j : -1; } };
struct CmUkv {
    __device__ int operator()(int nb) const { const int tile = nb >> 3, bj = (nb >> 2) & 1, wc = nb & 3; const int h = 2 * tile + (wc >> 1); return h * 128 + (wc & 1) * 64 + 32 * bj; }
};
struct CmW13 { const int dummy; };

__device__ __forceinline__ void conv_moe_layer(const Frame& F, int gw, int NGW, const Args& a, int l, int par = 0) {
    LAS float* scr = (LAS float*)(F.lds + F.wave * 16384);
    const float* w1 = a.in[31] + (size_t)l * 32 * 1024 * 256; const float* w3 = a.in[32] + (size_t)l * 32 * 1024 * 256; const float* w2 = a.in[33] + (size_t)l * 32 * 256 * 1024;
    const float* ln2 = a.in[26] + (size_t)l * 1024;
    bf16_t* W13 = (bf16_t*)(F.ws + (par ? WS_W13B : WS_W13)); bf16_t* W2T = (bf16_t*)(F.ws + (par ? WS_W2TB : WS_W2T));
    for (int it = gw; it < 32 * 256; it += NGW) { const int e = it >> 8, r = it & 255, kb = r >> 4, nb = r & 15;
        const int n = 32 * nb, pnl = n >> 8, bj = (n >> 7) & 1, j = n & 127; const float* src = (bj ? w3 : w1) + (size_t)e * 1024 * 256;
        conv_item(src, 256, 128 * pnl + j, ln2, W13 + (size_t)e * 512 * 1024, 1024, n, 64 * kb, scr, F.lane); }
    for (int it = gw; it < 32 * 128; it += NGW) { const int e = it >> 7, r = it & 127, kb = r >> 5, nb = r & 31;
        conv_item(w2 + (size_t)e * 256 * 1024, 1024, 32 * nb, nullptr, W2T + (size_t)e * 1024 * 256, 256, 32 * nb, 64 * kb, scr, F.lane); }
}
__device__ __forceinline__ void conv_p_layer(const Frame& F, int gw, int NGW, const Args& a, int l) {
    const float* p = a.in[1] + (size_t)l * T * 256; bf16_t* Pb = (bf16_t*)(F.ws + WS_PB);
    for (int m = gw; m < T; m += NGW) { const f32x4 v = *(const GAS f32x4*)(p + (size_t)m * 256 + 4 * F.lane);
        u32x2 o; o.x = pk2(v.x, v.y); o.y = pk2(v.z, v.w); *(GAS u32x2*)(Pb + (size_t)m * 256 + 4 * F.lane) = o; }
}

__device__ __forceinline__ void p0_prologue(const Frame& F, const Args& a) {
    const int gw = F.vcu * NW + F.wave, NGW = F.G * NW;
    const int gt = gw * 64 + F.lane, NGT = NGW * 64;
#ifndef MK_PRO_REP
#define MK_PRO_REP 0
#endif
#define PREP(k) (((MK_PRO_REP >> (k)) & 1) ? 2 : 1)
    for (int l = 0; l < NL; ++l) {
        for (int r_ = 0; r_ < PREP(0); ++r_) {
        conv_matrix(F, gw, NGW, a.in[3] + (size_t)l * 1024 * 1440, 1440, a.in[2] + l * 1024, (bf16_t*)(F.ws + WS_WIN) + (size_t)l * 1536 * 1024, 1024, 1536, CmWin());
        conv_matrix(F, gw, NGW, a.in[6] + (size_t)l * 384 * 768, 768, a.in[4] + l * 384, (bf16_t*)(F.ws + WS_WUQ) + (size_t)l * 1024 * 384, 384, 1024, CmUq());
        conv_matrix(F, gw, NGW, a.in[7] + (size_t)l * 256 * 1024, 1024, a.in[5] + l * 256, (bf16_t*)(F.ws + WS_WUKV) + (size_t)l * 1024 * 256, 256, 1024, CmUkv());
        conv_matrix(F, gw, NGW, a.in[25] + (size_t)l * 1024 * 1024, 1024, a.in[24] + (size_t)l * 1024, (bf16_t*)(F.ws + WS_WOUT) + (size_t)l * 1024 * 1024, 1024, 1024, CmIdent(), 512);
        conv_matrix(F, gw, NGW, a.in[34] + (size_t)l * 1024 * 1024, 1024, nullptr, (bf16_t*)(F.ws + WS_WPG) + (size_t)l * 1024 * 1024, 1024, 1024, CmIdent());
        conv_matrix(F, gw, NGW, a.in[36] + (size_t)l * 256 * 1024, 1024, nullptr, (bf16_t*)(F.ws + WS_WPLE) + (size_t)l * 1024 * 256, 256, 1024, CmIdent());
        conv_matrix(F, gw, NGW, a.in[22] + (size_t)l * 256 * 256, 256, nullptr, (bf16_t*)(F.ws + WS_WGLU) + (size_t)l * 256 * 256, 256, 256, CmIdent());
        }
        for (int r_ = 0; r_ < PREP(1); ++r_) {
        { bf16_t* Wr = (bf16_t*)(F.ws + WS_WR) + (size_t)l * 48 * 1024; const float* wrg = a.in[27] + (size_t)l * 4096; const float* wre = a.in[29] + (size_t)l * 32768; const float* ln2 = a.in[26] + l * 1024;
          for (int i = gt; i < 48 * 1024; i += NGT) { const int n = i >> 10, k = i & 1023; float v = 0.f; if (n < 4) v = wrg[k * 4 + n]; else if (n < 36) v = wre[k * 32 + (n - 4)]; Wr[i] = (bf16_t)f2bf(v * ln2[k]); } }
        { bf16_t* Wsg = (bf16_t*)(F.ws + WS_WSG) + (size_t)l * 4 * 128 * 128; const float* w = a.in[12] + (size_t)l * 4 * 128 * 128;
          for (int i = gt; i < 4 * 128 * 128; i += NGT) { const int p = i & 15, sb = (i & 127) & ~15, t = (i >> 7) & 127; const int q = p & 7, kp = (q & 3) + 8 * (q >> 2) + 4 * (p >> 3); const int s = sb + kp;
              const float v = (s <= t) ? w[(i & ~127) + s] : 0.f; Wsg[i] = (bf16_t)f2bf(v); } }
        { unsigned char* tb = F.ws + WS_S5T + (size_t)l * S5T_LAYER; float* ab = (float*)(tb + S5T_AB); bf16_t* BBt = (bf16_t*)(tb + S5T_BBT); bf16_t* Cmt = (bf16_t*)(tb + S5T_CMT); float* dd = (float*)(tb + S5T_D);
          const float* lre = a.in[14] + l * 1024; const float* lim = a.in[15] + l * 1024; const float* ldt = a.in[16] + l * 1024;
          const float* bre = a.in[17] + (size_t)l * 16384; const float* bim = a.in[18] + (size_t)l * 16384; const float* cre = a.in[19] + (size_t)l * 16384; const float* cim = a.in[20] + (size_t)l * 16384;
          for (int i = gt; i < 16 * 128 * 16; i += NGT) {
              const int c = i & 15, np = (i >> 4) & 127, g = i >> 11, n = np & 63, gn = g * 64 + n;
              const float lr = fminf(lre[gn], -1e-4f), li = lim[gn], dt = expf(ldt[gn]); const float mag = expf(lr * dt); float sn, cs; sincosf(li * dt, &sn, &cs);
              const float are = mag * cs, aim = mag * sn, den = lr * lr + li * li, nr = are - 1.0f, ni = aim; const float fr = (nr * lr + ni * li) / den, fi = (ni * lr - nr * li) / den;
              const float br = bre[(size_t)gn * 16 + c], bi = bim[(size_t)gn * 16 + c];
              const float v = (np < 64) ? (fr * br - fi * bi) : (fr * bi + fi * br);
              BBt[i] = (bf16_t)f2bf(v);
              if (c == 0 && np < 64) { ab[gn] = are; ab[1024 + gn] = aim; const float m64 = expf(64.0f * lr * dt); float s64, c64; sincosf(64.0f * li * dt, &s64, &c64); ab[2048 + gn] = m64 * c64; ab[3072 + gn] = m64 * s64; } }
          for (int i = gt; i < 16 * 16 * 128; i += NGT) {
              const int np = i & 127, c = (i >> 7) & 15, g = i >> 11, n = np >> 1; const size_t ci = ((size_t)g * 16 + c) * 64 + n;
              Cmt[i] = (bf16_t)f2bf((np & 1) ? -cim[ci] : cre[ci]); }
          for (int i = gt; i < 256; i += NGT) dd[i] = a.in[21][l * 256 + i]; }
        }
    }
    for (int r_ = 0; r_ < PREP(1); ++r_) { float* CS = (float*)(F.ws + WS_COS); float* SN = (float*)(F.ws + WS_SIN);
      for (int i = gt; i < S * 16; i += NGT) { const int s = i >> 4, j = i & 15; const float inv = 1.0f / powf(10000.0f, (float)(2 * j) / 32.0f); const float ang = (float)s * inv; float sn, cs; sincosf(ang, &sn, &cs); CS[i] = cs; SN[i] = sn; } }
    for (int r_ = 0; r_ < PREP(2); ++r_) { const float* x = a.in[0]; bf16_t* Hb = (bf16_t*)(F.ws + WS_HBA); float* SS1 = (float*)(F.ws + WS_SS1);
      for (int m = gw; m < T; m += NGW) { const GAS f32x4* xr = (const GAS f32x4*)(x + (size_t)m * DM) + F.lane; f32x4 v[4]; float s = 0.f;
#pragma unroll
          for (int j = 0; j < 4; ++j) { v[j] = xr[64 * j]; s += (v[j].x * v[j].x + v[j].y * v[j].y) + (v[j].z * v[j].z + v[j].w * v[j].w); }
          s = wave_sum(s);
          GAS u32x2* o8 = (GAS u32x2*)(Hb + (size_t)m * DM) + F.lane;
#pragma unroll
          for (int j = 0; j < 4; ++j) { u32x2 o; o.x = pk2(v[j].x, v[j].y); o.y = pk2(v[j].z, v[j].w); o8[64 * j] = o; }
          if (F.lane < 16) SS1[(size_t)m * 16 + F.lane] = (F.lane == 0) ? s : 0.f; } }
    for (int r_ = 0; r_ < PREP(3); ++r_) conv_moe_layer(F, gw, NGW, a, 0);
    if (a.pad == 0) for (int r_ = 0; r_ < PREP(4); ++r_) conv_p_layer(F, gw, NGW, a, 0);
}

#define EPI_ROW(u, ai, m) ((u).pm * 256 + (ai) * 128 + wr * 64 + (m) * 16 + fr)
__device__ __forceinline__ u32x4 pack8(const f32x4 v0, const f32x4 v1) { u32x4 w; w.x = pk2(v0[0], v0[1]); w.y = pk2(v0[2], v0[3]); w.z = pk2(v1[0], v1[1]); w.w = pk2(v1[2], v1[3]); return w; }
__device__ __forceinline__ float sq8(const f32x4 a, const f32x4 b) { return (a[0] * a[0] + a[1] * a[1]) + (a[2] * a[2] + a[3] * a[3]) + (b[0] * b[0] + b[1] * b[1]) + (b[2] * b[2] + b[3] * b[3]); }
__device__ __forceinline__ float sum16(const float* p) { const f32x4 a = *(const f32x4*)p, b = *(const f32x4*)(p + 4), c = *(const f32x4*)(p + 8), d = *(const f32x4*)(p + 12);
    return ((a[0] + a[1]) + (a[2] + a[3])) + ((b[0] + b[1]) + (b[2] + b[3])) + ((c[0] + c[1]) + (c[2] + c[3])) + ((d[0] + d[1]) + (d[2] + d[3])); }

struct EpiIn {
    static constexpr bool PERM = true, AFTER_DRAIN = false;
    const float* SS1; bf16_t* ZQ; float* KR; bf16_t* ZKV; bf16_t* U; bf16_t* VS; bf16_t* XS; float* SSQ; float* SKV; const float* lng; const float* lnb;
    __device__ __forceinline__ void operator()(const f32x4 (&acc)[2][2][4][2], const Unit& u, int wr, int wc, int fr, int fq) const {
        const int pn = u.pn;
        float rsv[2][4];
#pragma unroll
        for (int ai = 0; ai < 2; ++ai)
#pragma unroll
            for (int m = 0; m < 4; ++m) { const f32x4 p = *(const f32x4*)(SS1 + (size_t)EPI_ROW(u, ai, m) * 16 + 4 * fq); rsv[ai][m] = (p[0] + p[1]) + (p[2] + p[3]); }
#pragma unroll
        for (int ai = 0; ai < 2; ++ai)
#pragma unroll
            for (int m = 0; m < 4; ++m) rsv[ai][m] = rsqrtf(fq_sum(rsv[ai][m]) * (1.0f / 1024.0f) + EPS);
#pragma unroll
        for (int ai = 0; ai < 2; ++ai)
#pragma unroll
            for (int m = 0; m < 4; ++m) {
                const int row = EPI_ROW(u, ai, m);
                const float rs = rsv[ai][m];
                f32x4 v[2][2];
#pragma unroll
                for (int bj = 0; bj < 2; ++bj) { v[bj][0] = acc[ai][bj][m][0] * rs; v[bj][1] = acc[ai][bj][m][1] * rs; }
                const int c8 = 32 * wc + 8 * fq;
                if (pn == 0) {
#pragma unroll
                    for (int bj = 0; bj < 2; ++bj) *(u32x4*)(ZQ + (size_t)row * 384 + 128 * bj + c8) = pack8(v[bj][0], v[bj][1]);
                    const float s = fq_sum(sq8(v[0][0], v[0][1]) + sq8(v[1][0], v[1][1]));
                    if (fq == 0) st_wt(SSQ + (size_t)row * 8 + wc, s);
                } else if (pn == 1) {
                    *(u32x4*)(ZQ + (size_t)row * 384 + 256 + c8) = pack8(v[0][0], v[0][1]);
                    const float s = fq_sum(sq8(v[0][0], v[0][1]));
                    if (fq == 0) st_wt(SSQ + (size_t)row * 8 + 4 + wc, s);
                    if (wc == 0) { *(f32x4*)(KR + (size_t)row * 32 + 8 * fq) = v[1][0]; *(f32x4*)(KR + (size_t)row * 32 + 8 * fq + 4) = v[1][1]; }
                } else if (pn == 2) {
#pragma unroll
                    for (int bj = 0; bj < 2; ++bj) *(u32x4*)(ZKV + (size_t)row * 256 + 128 * bj + c8) = pack8(v[bj][0], v[bj][1]);
                    const float s = fq_sum(sq8(v[0][0], v[0][1]) + sq8(v[1][0], v[1][1]));
                    if (fq == 0) SKV[(size_t)row * 4 + wc] = s;
                } else if (pn == 3) {
#pragma unroll
                    for (int bj = 0; bj < 2; ++bj) { f32x4 g0, g1;
#pragma unroll
                        for (int e = 0; e < 4; ++e) { g0[e] = gelu_t(v[bj][0][e]); g1[e] = gelu_t(v[bj][1][e]); }
                        *(u32x4*)(U + (size_t)row * 256 + 128 * bj + c8) = pack8(g0, g1); }
                } else if (pn == 4) {
                    f32x4 g[2][2]; float s = 0.f;
#pragma unroll
                    for (int bj = 0; bj < 2; ++bj)
#pragma unroll
                        for (int n = 0; n < 2; ++n)
#pragma unroll
                            for (int e = 0; e < 4; ++e) { g[bj][n][e] = gelu_t(v[bj][n][e]); s += g[bj][n][e]; }
                    const float mu = fq_sum(s) * (1.0f / 64.0f); float q = 0.f;
#pragma unroll
                    for (int bj = 0; bj < 2; ++bj)
#pragma unroll
                        for (int n = 0; n < 2; ++n)
#pragma unroll
                            for (int e = 0; e < 4; ++e) { g[bj][n][e] -= mu; q += g[bj][n][e] * g[bj][n][e]; }
                    const float rstd = rsqrtf(fq_sum(q) * (1.0f / 64.0f) + EPS);
#pragma unroll
                    for (int bj = 0; bj < 2; ++bj) { const int lc = 64 * wc + 32 * bj + 8 * fq;
                        const f32x4 ga = *(const f32x4*)(lng + lc), gb = *(const f32x4*)(lng + lc + 4), ba = *(const f32x4*)(lnb + lc), bb = *(const f32x4*)(lnb + lc + 4);
                        *(u32x4*)(VS + (size_t)row * 256 + lc) = pack8(g[bj][0] * rstd * ga + ba, g[bj][1] * rstd * gb + bb); }
                } else {
#pragma unroll
                    for (int bj = 0; bj < 2; ++bj) *(u32x4*)(XS + (size_t)row * 256 + 128 * bj + c8) = pack8(v[bj][0], v[bj][1]);
                }
                asm volatile("" ::: "memory");
            }
    }
};
struct EpiQ {
    static constexpr bool PERM = true, AFTER_DRAIN = false;
    const float* SSQ; bf16_t* Q; float* SQH;
    __device__ __forceinline__ void operator()(const f32x4 (&acc)[2][2][4][2], const Unit& u, int wr, int wc, int fr, int fq) const {
        float rqv[2][4];
#pragma unroll
        for (int ai = 0; ai < 2; ++ai)
#pragma unroll
            for (int m = 0; m < 4; ++m) { const f32x2_t p = *(const f32x2_t*)(SSQ + (size_t)EPI_ROW(u, ai, m) * 8 + 2 * fq); rqv[ai][m] = p[0] + p[1]; }
#pragma unroll
        for (int ai = 0; ai < 2; ++ai)
#pragma unroll
            for (int m = 0; m < 4; ++m) rqv[ai][m] = rsqrtf(fq_sum(rqv[ai][m]) * (1.0f / 384.0f) + EPS);
#pragma unroll
        for (int ai = 0; ai < 2; ++ai)
#pragma unroll
            for (int m = 0; m < 4; ++m) {
                const int row = EPI_ROW(u, ai, m); const int b = row / S, s = row % S;
                const float rq = rqv[ai][m];
#pragma unroll
                for (int bj = 0; bj < 2; ++bj) { const int h = 2 * u.pn + bj; const f32x4 v0 = acc[ai][bj][m][0] * rq, v1 = acc[ai][bj][m][1] * rq;
                    if (wc < 3) *(u32x4*)(Q + ((size_t)(b * 8 + h) * S + s) * 96 + 32 * wc + 8 * fq) = pack8(v0, v1);
                    const float ss = fq_sum(sq8(v0, v1));
                    if (fq == 0) st_wt(SQH + (size_t)row * 32 + h * 4 + wc, ss); }
                asm volatile("" ::: "memory");
            }
    }
};
struct EpiKV {
    static constexpr bool PERM = true, AFTER_DRAIN = false;
    const float* SKV; const float* KR; const float* gkh; const float* CS; const float* SN; bf16_t* K; bf16_t* V;
    __device__ __forceinline__ void operator()(const f32x4 (&acc)[2][2][4][2], const Unit& u, int wr, int wc, int fr, int fq) const {
        const int h = 2 * u.pn + (wc >> 1);
#pragma unroll
        for (int ai = 0; ai < 2; ++ai)
#pragma unroll
            for (int m = 0; m < 4; ++m) {
                const int row = EPI_ROW(u, ai, m); const int b = row / S, s = row % S;
                const f32x4 a = *(const f32x4*)(SKV + (size_t)row * 4);
                const float rkv = rsqrtf(((a[0] + a[1]) + (a[2] + a[3])) * (1.0f / 256.0f) + EPS);
                f32x4 v[2][2];
#pragma unroll
                for (int bj = 0; bj < 2; ++bj) { v[bj][0] = acc[ai][bj][m][0] * rkv; v[bj][1] = acc[ai][bj][m][1] * rkv; }
                const size_t hrow = (size_t)(b * 8 + h) * S + s;
                if (wc & 1) {
#pragma unroll
                    for (int bj = 0; bj < 2; ++bj) *(u32x4*)(V + hrow * 64 + 32 * bj + 8 * fq) = pack8(v[bj][0], v[bj][1]);
                } else {
                    const f32x4 k0 = *(const f32x4*)(KR + (size_t)row * 32 + 8 * fq), k1 = *(const f32x4*)(KR + (size_t)row * 32 + 8 * fq + 4);
                    const float ss = fq_sum(sq8(v[0][0], v[0][1]) + sq8(v[1][0], v[1][1]) + sq8(k0, k1));
                    const float rk = rsqrtf(ss * (1.0f / 96.0f) + EPS);
#pragma unroll
                    for (int bj = 0; bj < 2; ++bj) { const int e0 = 32 * bj + 8 * fq; const f32x4 ga = *(const f32x4*)(gkh + e0), gb = *(const f32x4*)(gkh + e0 + 4);
                        *(u32x4*)(K + hrow * 96 + e0) = pack8(v[bj][0] * rk * ga, v[bj][1] * rk * gb); }
                    const f32x4 ga = *(const f32x4*)(gkh + 64 + 8 * fq), gb = *(const f32x4*)(gkh + 64 + 8 * fq + 4);
                    const f32x4 y0 = k0 * rk * ga, y1 = k1 * rk * gb; f32x4 p0, p1;
#pragma unroll
                    for (int e = 0; e < 4; ++e) { p0[e] = shx(y0[e], 32); p1[e] = shx(y1[e], 32); }
                    const int j0 = (8 * fq) & 15;
                    const f32x4 c0 = *(const f32x4*)(CS + (size_t)s * 16 + j0), c1 = *(const f32x4*)(CS + (size_t)s * 16 + j0 + 4), s0 = *(const f32x4*)(SN + (size_t)s * 16 + j0), s1 = *(const f32x4*)(SN + (size_t)s * 16 + j0 + 4);
                    f32x4 o0, o1;
                    if (fq < 2) { o0 = y0 * c0 - p0 * s0; o1 = y1 * c1 - p1 * s1; } else { o0 = p0 * s0 + y0 * c0; o1 = p1 * s1 + y1 * c1; }
                    *(u32x4*)(K + hrow * 96 + 64 + 8 * fq) = pack8(o0, o1);
                }
                asm volatile("" ::: "memory");
            }
    }
};
__device__ __forceinline__ void unpack8(const u32x4 w, f32x4& a, f32x4& b) { a[0] = bflo(w.x); a[1] = bfhi(w.x); a[2] = bflo(w.y); a[3] = bfhi(w.y); b[0] = bflo(w.z); b[1] = bfhi(w.z); b[2] = bflo(w.w); b[3] = bfhi(w.w); }
struct EpiOut {
    static constexpr bool PERM = true, AFTER_DRAIN = false;
    const bf16_t* Hin; bf16_t* Hout; float* SS; const float* SA;
    __device__ __forceinline__ void operator()(const f32x4 (&acc)[2][2][4][2], const Unit& u, int wr, int wc, int fr, int fq) const {
        float rav[2][4];
#pragma unroll
        for (int ai = 0; ai < 2; ++ai)
#pragma unroll
            for (int m = 0; m < 4; ++m) { const f32x2_t p = *(const f32x2_t*)(SA + (size_t)EPI_ROW(u, ai, m) * 8 + 2 * fq); rav[ai][m] = p[0] + p[1]; }
#pragma unroll
        for (int ai = 0; ai < 2; ++ai)
#pragma unroll
            for (int m = 0; m < 4; ++m) rav[ai][m] = rsqrtf(fq_sum(rav[ai][m]) * (1.0f / 512.0f) + EPS);
#pragma unroll
        for (int ai = 0; ai < 2; ++ai)
#pragma unroll
            for (int m = 0; m < 4; ++m) { const int row = EPI_ROW(u, ai, m); float ss = 0.f; const float ra = rav[ai][m];
#pragma unroll
                for (int bj = 0; bj < 2; ++bj) { const size_t off = (size_t)row * DM + u.pn * 256 + 128 * bj + 32 * wc + 8 * fq;
                    f32x4 h0, h1; unpack8(*(const u32x4*)(Hin + off), h0, h1); h0 = h0 + acc[ai][bj][m][0] * ra; h1 = h1 + acc[ai][bj][m][1] * ra;
                    *(u32x4*)(Hout + off) = pack8(h0, h1); ss += sq8(h0, h1); }
                ss = fq_sum(ss); if (fq == 0) st_wt(SS + (size_t)row * 16 + u.pn * 4 + wc, ss); asm volatile("" ::: "memory"); }
    }
};
struct EpiM1 {
    static constexpr bool PERM = true, AFTER_DRAIN = false;
    const float* RS; bf16_t* HBX;
    __device__ __forceinline__ void operator()(const f32x4 (&acc)[2][2][4][2], const Unit& u, int wr, int wc, int fr, int fq) const {
        const int ct = u.pn & 1;
        float rsv[2][4];
#pragma unroll
        for (int ai = 0; ai < 2; ++ai)
#pragma unroll
            for (int m = 0; m < 4; ++m) rsv[ai][m] = RS[EPI_ROW(u, ai, m)];
#pragma unroll
        for (int ai = 0; ai < 2; ++ai)
#pragma unroll
            for (int m = 0; m < 4; ++m) { const int row = EPI_ROW(u, ai, m); const float rs = rsv[ai][m]; f32x4 o[2];
#pragma unroll
                for (int n = 0; n < 2; ++n)
#pragma unroll
                    for (int e = 0; e < 4; ++e) { const float a1 = acc[ai][0][m][n][e] * rs, a3 = acc[ai][1][m][n][e] * rs; o[n][e] = a1 * sigm(a1) * a3; }
                *(u32x4*)(HBX + (size_t)row * 256 + 128 * ct + 32 * wc + 8 * fq) = pack8(o[0], o[1]); asm volatile("" ::: "memory"); }
    }
};
struct EpiM2 {
    static constexpr bool PERM = true, AFTER_DRAIN = false;
    const int* TOK; const float* W; bf16_t* Y;
    __device__ __forceinline__ void operator()(const f32x4 (&acc)[2][2][4][2], const Unit& u, int wr, int wc, int fr, int fq) const {
        const int ct = u.pn & 3;
        int tkv[2][4]; float wv[2][4];
#pragma unroll
        for (int ai = 0; ai < 2; ++ai)
#pragma unroll
            for (int m = 0; m < 4; ++m) { const int row = EPI_ROW(u, ai, m); tkv[ai][m] = TOK[row]; wv[ai][m] = W[row]; }
#pragma unroll
        for (int ai = 0; ai < 2; ++ai)
#pragma unroll
            for (int m = 0; m < 4; ++m) { const int tk = tkv[ai][m]; const float w = wv[ai][m];
                if (tk >= 0) { bf16_t* yr = Y + ((size_t)(tk & 1) * T + (tk >> 1)) * DM + 256 * ct + 32 * wc + 8 * fq;
#pragma unroll
                    for (int bj = 0; bj < 2; ++bj) *(u32x4*)(yr + 128 * bj) = pack8(acc[ai][bj][m][0] * w, acc[ai][bj][m][1] * w); } }
        asm volatile("" ::: "memory");
    }
};
struct EpiPl {
    static constexpr bool PERM = true, AFTER_DRAIN = false;
    bf16_t* PL;
    __device__ __forceinline__ void operator()(const f32x4 (&acc)[2][2][4][2], const Unit& u, int wr, int wc, int fr, int fq) const {
#pragma unroll
        for (int ai = 0; ai < 2; ++ai)
#pragma unroll
            for (int m = 0; m < 4; ++m) { const int row = EPI_ROW(u, ai, m);
#pragma unroll
                for (int bj = 0; bj < 2; ++bj) *(u32x4*)(PL + (size_t)row * DM + u.pn * 256 + 128 * bj + 32 * wc + 8 * fq) = pack8(acc[ai][bj][m][0], acc[ai][bj][m][1]); asm volatile("" ::: "memory"); }
    }
};
struct EpiGate {
    static constexpr bool PERM = true, AFTER_DRAIN = false;
    const bf16_t* Hin; const bf16_t* PL; const float* bpg; bf16_t* Hout; float* SS; float* OutF;
    __device__ __forceinline__ void operator()(const f32x4 (&acc)[2][2][4][2], const Unit& u, int wr, int wc, int fr, int fq) const {
#pragma unroll
        for (int ai = 0; ai < 2; ++ai)
#pragma unroll
            for (int m = 0; m < 4; ++m) { const int row = EPI_ROW(u, ai, m); float ss = 0.f;
#pragma unroll
                for (int bj = 0; bj < 2; ++bj) { const int col = u.pn * 256 + 128 * bj + 32 * wc + 8 * fq; const size_t off = (size_t)row * DM + col;
                    const u32x4 pl = *(const u32x4*)(PL + off); const f32x4 b0 = *(const f32x4*)(bpg + col), b1 = *(const f32x4*)(bpg + col + 4);
                    f32x4 h0, h1; unpack8(*(const u32x4*)(Hin + off), h0, h1);
                    const f32x4 a0 = acc[ai][bj][m][0] + b0, a1 = acc[ai][bj][m][1] + b1;
                    h0[0] += sigm(a0[0]) * bflo(pl.x); h0[1] += sigm(a0[1]) * bfhi(pl.x); h0[2] += sigm(a0[2]) * bflo(pl.y); h0[3] += sigm(a0[3]) * bfhi(pl.y);
                    h1[0] += sigm(a1[0]) * bflo(pl.z); h1[1] += sigm(a1[1]) * bfhi(pl.z); h1[2] += sigm(a1[2]) * bflo(pl.w); h1[3] += sigm(a1[3]) * bfhi(pl.w);
                    if (OutF) { *(f32x4*)(OutF + off) = h0; *(f32x4*)(OutF + off + 4) = h1; }
                    else { *(u32x4*)(Hout + off) = pack8(h0, h1); ss += sq8(h0, h1); } }
                if (!OutF) { ss = fq_sum(ss); if (fq == 0) st_wt(SS + (size_t)row * 16 + u.pn * 4 + wc, ss); } asm volatile("" ::: "memory"); }
    }
};
template <int NCT>
struct MoeOrder {
    const int* TS; int G, c, total;
    __device__ __forceinline__ void init(const int* ts, int G_, int c_) { TS = ts; G = G_; c = c_; total = __builtin_amdgcn_readfirstlane(ts[32]) * NCT; }
    __device__ __forceinline__ bool next(int i, Unit& u) const {
        const int L = i * G + c; if (L >= total) return false;
        const int rt = L / NCT, ct = L % NCT; int e = 0;
        for (int j = 1; j < 32; ++j) e += (__builtin_amdgcn_readfirstlane(TS[j]) <= rt) ? 1 : 0;
        u.pm = rt; u.pn = e * NCT + ct; return true;
    }
    __device__ __forceinline__ void a_ready(const Unit&) const {}
    __device__ __forceinline__ void done(const Unit&) const {}
};
namespace att {
constexpr int KSLOT = 12288, VSLOT = 8192, NSLOT = 3;
constexpr int L_K = 0, L_V = NSLOT * KSLOT, L_WS = L_V + NSLOT * VSLOT, L_OST = L_WS + NW * 64 * 4, L_END = L_OST + NW * 4096;
static_assert(L_END <= RING_BYTES, "attention LDS");
constexpr float C2 = 0.10206207261596577f * 1.4426950408889634f;
__device__ __forceinline__ int crow(int r, int hi) { return (r & 3) + 8 * (r >> 2) + 4 * hi; }
__device__ __forceinline__ void glds16(const void* gsrc, unsigned lds_dst) { unsigned keep;
    asm volatile("s_mov_b32 %0, m0\n\ts_mov_b32 m0, %2\n\ts_nop 0\n\tglobal_load_lds_dwordx4 %1, off\n\ts_mov_b32 m0, %0" : "=&s"(keep) : "v"(gsrc), "s"(lds_dst) : "memory"); }
#define ATT_WAIT_BAR(N) asm volatile("s_waitcnt vmcnt(" #N ") lgkmcnt(0)\n\ts_barrier" ::: "memory")
__device__ __forceinline__ float rowmax32(const f32x16& p0, const f32x16& p1) {
    float a = fmaxf(fmaxf(p0[0], p0[1]), fmaxf(p1[0], p1[1]));
#pragma unroll
    for (int r = 2; r < 16; r += 2) a = fmaxf(a, fmaxf(fmaxf(p0[r], p0[r + 1]), fmaxf(p1[r], p1[r + 1])));
    auto rr = __builtin_amdgcn_permlane32_swap(__float_as_uint(a), __float_as_uint(a), false, false);
    return fmaxf(__uint_as_float(rr[0]), __uint_as_float(rr[1]));
}
__device__ __forceinline__ void pv(f32x16* o, int vb, bf16x8 pa0, bf16x8 pa1, bf16x8 pa2, bf16x8 pa3) {
#pragma unroll
    for (int d0 = 0; d0 < 2; ++d0) { s16x4 lo[4], hi[4];
#pragma unroll
        for (int ks = 0; ks < 4; ++ks) {
            asm volatile("ds_read_b64_tr_b16 %0,%1 offset:%c2" : "=&v"(lo[ks]) : "v"(vb), "i"(d0 * 4096 + ks * 1024) : "memory");
            asm volatile("ds_read_b64_tr_b16 %0,%1 offset:%c2" : "=&v"(hi[ks]) : "v"(vb), "i"(d0 * 4096 + ks * 1024 + 512) : "memory"); }
        asm volatile("s_waitcnt lgkmcnt(0)" ::: "memory"); __builtin_amdgcn_sched_barrier(0);
#define PK(k) (bf16x8){lo[k][0], lo[k][1], lo[k][2], lo[k][3], hi[k][0], hi[k][1], hi[k][2], hi[k][3]}
        o[d0] = __builtin_amdgcn_mfma_f32_32x32x16_bf16(pa0, PK(0), o[d0], 0, 0, 0);
        o[d0] = __builtin_amdgcn_mfma_f32_32x32x16_bf16(pa1, PK(1), o[d0], 0, 0, 0);
        o[d0] = __builtin_amdgcn_mfma_f32_32x32x16_bf16(pa2, PK(2), o[d0], 0, 0, 0);
        o[d0] = __builtin_amdgcn_mfma_f32_32x32x16_bf16(pa3, PK(3), o[d0], 0, 0, 0);
#undef PK
    }
}
__device__ __forceinline__ void attn_unit(int b, int h, int qb, const bf16_t* Q, const float* SQH, const float* gqh, const float* CS, const float* SN,
                                          const bf16_t* __restrict__ K, const bf16_t* __restrict__ V, bf16_t* MIX, float* SA, char* shm) {
    const int tid = opaque_tid(), lane = tid & 63, r32 = lane & 31, hi = lane >> 5; const int wid = __builtin_amdgcn_readfirstlane(tid >> 6);
    const int q0 = qb * 256; const size_t hbase = (size_t)(b * 8 + h) * S;
    const bf16_t* Kh = K + hbase * 96; const bf16_t* Vh = V + hbase * 64;
    const unsigned lds0 = (unsigned)(uintptr_t)shm;
    LAS float* wsf = (LAS float*)((LAS char*)shm + L_WS) + wid * 64;
    const bf16_t* ksrc0 = Kh + (size_t)lane * 96 + wid * 8; const bf16_t* ksrc1 = Kh + (size_t)lane * 96 + (8 + (wid & 3)) * 8;
    const bf16_t* vsrc = Vh + (size_t)(16 * (wid & 3) + (lane >> 2)) * 64 + (wid >> 2) * 32 + (lane & 3) * 8;
    const unsigned kdst0 = lds0 + L_K + wid * 1024, kdst1 = lds0 + L_K + (8 + (wid & 3)) * 1024, vdst = lds0 + L_V + wid * 1024;
#define ATT_DMA(t, sl) do { glds16(ksrc0 + (size_t)(t) * 64 * 96, (unsigned)__builtin_amdgcn_readfirstlane(kdst0 + (sl) * KSLOT)); \
        glds16(ksrc1 + (size_t)(t) * 64 * 96, (unsigned)__builtin_amdgcn_readfirstlane(kdst1 + (sl) * KSLOT)); \
        glds16(vsrc + (size_t)(t) * 64 * 64, (unsigned)__builtin_amdgcn_readfirstlane(vdst + (sl) * VSLOT)); } while (0)
    const int NT = (q0 + 256) / 64;
    ATT_DMA(0, 0); ATT_DMA(1, 1);
    const int qrow = q0 + wid * 32 + r32; const int trow = b * S + qrow;
    bf16x8 qr[6];
    { const f32x4 sp = *(const f32x4*)(SQH + (size_t)trow * 32 + h * 4);
      const float rq = rsqrtf(((sp[0] + sp[1]) + (sp[2] + sp[3])) * (1.0f / 96.0f) + EPS) * C2;
      const bf16_t* qp = Q + (hbase + qrow) * 96 + hi * 8;
      float qf[6][8];
#pragma unroll
      for (int d0 = 0; d0 < 6; ++d0) { const u32x4 w = *(const u32x4*)(qp + d0 * 16); const f32x4 g0 = *(const f32x4*)(gqh + d0 * 16 + hi * 8), g1 = *(const f32x4*)(gqh + d0 * 16 + hi * 8 + 4);
          qf[d0][0] = bflo(w.x) * rq * g0[0]; qf[d0][1] = bfhi(w.x) * rq * g0[1]; qf[d0][2] = bflo(w.y) * rq * g0[2]; qf[d0][3] = bfhi(w.y) * rq * g0[3];
          qf[d0][4] = bflo(w.z) * rq * g1[0]; qf[d0][5] = bfhi(w.z) * rq * g1[1]; qf[d0][6] = bflo(w.w) * rq * g1[2]; qf[d0][7] = bfhi(w.w) * rq * g1[3]; }
      const f32x4 c0 = *(const f32x4*)(CS + (size_t)qrow * 16 + 8 * hi), c1 = *(const f32x4*)(CS + (size_t)qrow * 16 + 8 * hi + 4), s0 = *(const f32x4*)(SN + (size_t)qrow * 16 + 8 * hi), s1 = *(const f32x4*)(SN + (size_t)qrow * 16 + 8 * hi + 4);
#pragma unroll
      for (int e = 0; e < 8; ++e) { const float c = e < 4 ? c0[e & 3] : c1[e & 3], sn = e < 4 ? s0[e & 3] : s1[e & 3]; const float x1 = qf[4][e], x2 = qf[5][e]; qf[4][e] = x1 * c - x2 * sn; qf[5][e] = x1 * sn + x2 * c; }
#pragma unroll
      for (int d0 = 0; d0 < 6; ++d0) { u32x4 w; w.x = pk2(qf[d0][0], qf[d0][1]); w.y = pk2(qf[d0][2], qf[d0][3]); w.z = pk2(qf[d0][4], qf[d0][5]); w.w = pk2(qf[d0][6], qf[d0][7]); qr[d0] = __builtin_bit_cast(bf16x8, w); } }
    float mrun = 0.f, l_reg = 0.f; f32x16 o[2]; o[0] = f32x16{}; o[1] = f32x16{};
    const int qrel = wid * 32 + r32;
    const int vb0 = (int)(lds0 + L_V) + ((lane >> 4) & 1) * 32 + (lane & 3) * 8 + (4 * hi + ((lane & 15) >> 2)) * 64;
    int slot = 0;
    for (int t = 0; t < NT; ++t) {
        if (t + 1 < NT) { ATT_WAIT_BAR(3); } else { ATT_WAIT_BAR(0); }
        if (t + 2 < NT) { const int s2 = (slot + 2 >= NSLOT) ? slot + 2 - NSLOT : slot + 2; ATT_DMA(t + 2, s2); }
        const int jb = t - (NT - 4);
        if (!(jb >= 0 && 64 * jb > wid * 32 + 31)) {
            const LAS char* kb = (const LAS char*)shm + L_K + slot * KSLOT + hi * 1024 + r32 * 16;
            f32x16 p0 = f32x16{}, p1 = f32x16{};
#pragma unroll
            for (int d0 = 0; d0 < 6; ++d0) { const bf16x8 b0 = *(const LAS bf16x8*)(kb + d0 * 2048), b1 = *(const LAS bf16x8*)(kb + d0 * 2048 + 512);
                p0 = __builtin_amdgcn_mfma_f32_32x32x16_bf16(b0, qr[d0], p0, 0, 0, 0); p1 = __builtin_amdgcn_mfma_f32_32x32x16_bf16(b1, qr[d0], p1, 0, 0, 0); }
            if (jb >= 0) { const int kb0 = 64 * jb + 4 * hi;
#pragma unroll
                for (int r = 0; r < 16; ++r) { const int kv = kb0 + (r & 3) + 8 * (r >> 2); if (kv > qrel) p0[r] = -INFINITY; if (kv + 32 > qrel) p1[r] = -INFINITY; } }
            const float rm = rowmax32(p0, p1);
            if (t == 0) { mrun = rm; }
            else if (__any(rm > mrun + 8.0f)) { const float mn = fmaxf(mrun, rm); const float f = __builtin_amdgcn_exp2f(mrun - mn); l_reg *= f; mrun = mn; if (hi == 0) wsf[r32] = f; LDS_WAIT();
#pragma unroll
                for (int d_ = 0; d_ < 2; ++d_)
#pragma unroll
                    for (int r = 0; r < 16; ++r) o[d_][r] *= wsf[crow(r, hi)]; }
            float sacc = 0.f;
#pragma unroll
            for (int r = 0; r < 16; ++r) { p0[r] = __builtin_amdgcn_exp2f(p0[r] - mrun); p1[r] = __builtin_amdgcn_exp2f(p1[r] - mrun); sacc += p0[r] + p1[r]; }
            l_reg += sacc;
            u32x4 pw0, pw1, pw2, pw3;
            pw0 = (u32x4){pk2(p0[0], p0[1]), pk2(p0[2], p0[3]), pk2(p0[4], p0[5]), pk2(p0[6], p0[7])}; pw1 = (u32x4){pk2(p0[8], p0[9]), pk2(p0[10], p0[11]), pk2(p0[12], p0[13]), pk2(p0[14], p0[15])};
            pw2 = (u32x4){pk2(p1[0], p1[1]), pk2(p1[2], p1[3]), pk2(p1[4], p1[5]), pk2(p1[6], p1[7])}; pw3 = (u32x4){pk2(p1[8], p1[9]), pk2(p1[10], p1[11]), pk2(p1[12], p1[13]), pk2(p1[14], p1[15])};
            pv(o, vb0 + slot * VSLOT, __builtin_bit_cast(bf16x8, pw0), __builtin_bit_cast(bf16x8, pw1), __builtin_bit_cast(bf16x8, pw2), __builtin_bit_cast(bf16x8, pw3));
        }
        slot = (slot + 1 >= NSLOT) ? 0 : slot + 1;
    }
    { auto rr = __builtin_amdgcn_permlane32_swap(__float_as_uint(l_reg), __float_as_uint(l_reg), false, false); l_reg = __uint_as_float(rr[0]) + __uint_as_float(rr[1]); }
    if (hi == 0) wsf[32 + r32] = l_reg; LDS_WAIT();
    float rli[16];
#pragma unroll
    for (int r = 0; r < 16; ++r) rli[r] = __builtin_amdgcn_rcpf(wsf[32 + crow(r, hi)]);
    { LAS bf16_t* stg = (LAS bf16_t*)((LAS char*)shm + L_OST) + wid * 2048;
#pragma unroll
      for (int r = 0; r < 16; ++r) { const int orow = crow(r, hi);
#pragma unroll
          for (int d0 = 0; d0 < 2; ++d0) stg[orow * 64 + d0 * 32 + r32] = (bf16_t)f2bf(o[d0][r] * rli[r]); }
      LDS_WAIT();
#pragma unroll
      for (int i = 0; i < 4; ++i) { const int row = i * 8 + (lane >> 3), ch = lane & 7; const u32x4 v = *(const LAS u32x4*)(stg + row * 64 + ch * 8);
          const size_t tr = (size_t)b * S + q0 + wid * 32 + row;
          *(u32x4*)(MIX + tr * DM + h * 64 + ch * 8) = v;
          float ss = bflo(v.x) * bflo(v.x) + bfhi(v.x) * bfhi(v.x) + bflo(v.y) * bflo(v.y) + bfhi(v.y) * bfhi(v.y) + bflo(v.z) * bflo(v.z) + bfhi(v.z) * bfhi(v.z) + bflo(v.w) * bflo(v.w) + bfhi(v.w) * bfhi(v.w);
          ss += shx(ss, 1); ss += shx(ss, 2); ss += shx(ss, 4);
          if (ch == 0) st_wt(SA + tr * 8 + h, ss); } }
    asm volatile("s_waitcnt lgkmcnt(0)\n\ts_barrier" ::: "memory");
#undef ATT_DMA
}

#define A3_SB() __builtin_amdgcn_sched_barrier(0)
#define A3_PIN(x) asm volatile("" : "+v"(x))
#define A3_EX(v) __builtin_amdgcn_exp2f(v)
__device__ __forceinline__ void attn_unit3(int b, int h, int qb, const bf16_t* Q, const float* SQH, const float* gqh, const float* CS, const float* SN,
                                           const bf16_t* __restrict__ K, const bf16_t* __restrict__ V, bf16_t* MIX, float* SA, char* shm) {
    const int tid = opaque_tid(), lane = tid & 63, r32 = lane & 31, hi = lane >> 5; const int wid = __builtin_amdgcn_readfirstlane(tid >> 6);
    const int q0 = qb * 256; const size_t hbase = (size_t)(b * 8 + h) * S;
    const bf16_t* Kh = K + hbase * 96; const bf16_t* Vh = V + hbase * 64;
    const unsigned lds0 = (unsigned)(uintptr_t)shm;
    LAS float* wsf = (LAS float*)((LAS char*)shm + L_WS) + wid * 64;
    const bf16_t* ksrc0 = Kh + (size_t)lane * 96 + wid * 8; const bf16_t* ksrc1 = Kh + (size_t)lane * 96 + (8 + (wid & 3)) * 8;
    const bf16_t* vsrc = Vh + (size_t)(16 * (wid & 3) + (lane >> 2)) * 64 + (wid >> 2) * 32 + (lane & 3) * 8;
    const unsigned kdst0 = lds0 + L_K + wid * 1024, kdst1 = lds0 + L_K + (8 + (wid & 3)) * 1024, vdst = lds0 + L_V + wid * 1024;
#define A3_DMAK(t, sl) do { glds16(ksrc0 + (size_t)(t) * 64 * 96, (unsigned)__builtin_amdgcn_readfirstlane(kdst0 + (sl) * KSLOT)); \
        glds16(ksrc1 + (size_t)(t) * 64 * 96, (unsigned)__builtin_amdgcn_readfirstlane(kdst1 + (sl) * KSLOT)); } while (0)
#define A3_DMAV(t, sl) glds16(vsrc + (size_t)(t) * 64 * 64, (unsigned)__builtin_amdgcn_readfirstlane(vdst + (sl) * VSLOT))
    const int NT = (q0 + 256) / 64;
    A3_DMAK(0, 0); A3_DMAK(1, 1); A3_DMAK(2, 2); A3_DMAV(0, 0); A3_DMAV(1, 1);
    const int qrow = q0 + wid * 32 + r32; const int trow = b * S + qrow;
    bf16x8 qr[6];
    { const f32x4 sp = *(const f32x4*)(SQH + (size_t)trow * 32 + h * 4);
      const float rq = rsqrtf(((sp[0] + sp[1]) + (sp[2] + sp[3])) * (1.0f / 96.0f) + EPS) * C2;
      const bf16_t* qp = Q + (hbase + qrow) * 96 + hi * 8;
      float qf[6][8];
#pragma unroll
      for (int d0 = 0; d0 < 6; ++d0) { const u32x4 w = *(const u32x4*)(qp + d0 * 16); const f32x4 g0 = *(const f32x4*)(gqh + d0 * 16 + hi * 8), g1 = *(const f32x4*)(gqh + d0 * 16 + hi * 8 + 4);
          qf[d0][0] = bflo(w.x) * rq * g0[0]; qf[d0][1] = bfhi(w.x) * rq * g0[1]; qf[d0][2] = bflo(w.y) * rq * g0[2]; qf[d0][3] = bfhi(w.y) * rq * g0[3];
          qf[d0][4] = bflo(w.z) * rq * g1[0]; qf[d0][5] = bfhi(w.z) * rq * g1[1]; qf[d0][6] = bflo(w.w) * rq * g1[2]; qf[d0][7] = bfhi(w.w) * rq * g1[3]; }
      const f32x4 c0 = *(const f32x4*)(CS + (size_t)qrow * 16 + 8 * hi), c1 = *(const f32x4*)(CS + (size_t)qrow * 16 + 8 * hi + 4), s0 = *(const f32x4*)(SN + (size_t)qrow * 16 + 8 * hi), s1 = *(const f32x4*)(SN + (size_t)qrow * 16 + 8 * hi + 4);
#pragma unroll
      for (int e = 0; e < 8; ++e) { const float c = e < 4 ? c0[e & 3] : c1[e & 3], sn = e < 4 ? s0[e & 3] : s1[e & 3]; const float x1 = qf[4][e], x2 = qf[5][e]; qf[4][e] = x1 * c - x2 * sn; qf[5][e] = x1 * sn + x2 * c; }
#pragma unroll
      for (int d0 = 0; d0 < 6; ++d0) { u32x4 w; w.x = pk2(qf[d0][0], qf[d0][1]); w.y = pk2(qf[d0][2], qf[d0][3]); w.z = pk2(qf[d0][4], qf[d0][5]); w.w = pk2(qf[d0][6], qf[d0][7]); qr[d0] = __builtin_bit_cast(bf16x8, w); } }
    float l_reg = 0.f; f32x16 o[2]; o[0] = f32x16{}; o[1] = f32x16{};
    const int qrel = wid * 32 + r32;
    const int vb0 = (int)(lds0 + L_V) + ((lane >> 4) & 1) * 32 + (lane & 3) * 8 + (4 * hi + ((lane & 15) >> 2)) * 64;
    const LAS char* kbase = (const LAS char*)shm + L_K + hi * 1024 + r32 * 16;
#define A3_MASK(C0_, C1_, tt) do { const int jb_ = (tt) - (NT - 4); if (jb_ >= 0) { const int kb0_ = 64 * jb_ + 4 * hi; \
        _Pragma("unroll") for (int r = 0; r < 16; ++r) { const int kv_ = kb0_ + (r & 3) + 8 * (r >> 2); if (kv_ > qrel) C0_[r] = -INFINITY; if (kv_ + 32 > qrel) C1_[r] = -INFINITY; } } } while (0)
#define A3_KLOAD(j, kb_) do { kf[2 * (j)] = *(const LAS bf16x8*)((kb_) + (j) * 2048); kf[2 * (j) + 1] = *(const LAS bf16x8*)((kb_) + (j) * 2048 + 512); } while (0)
    f32x16 P0, P1; bf16x8 kf[12];
    asm volatile("s_waitcnt vmcnt(0) lgkmcnt(0)\n\ts_barrier" ::: "memory");
    { P0 = f32x16{}; P1 = f32x16{};
#pragma unroll
      for (int d0 = 0; d0 < 6; ++d0) { const bf16x8 b0 = *(const LAS bf16x8*)(kbase + d0 * 2048), b1 = *(const LAS bf16x8*)(kbase + d0 * 2048 + 512);
          P0 = __builtin_amdgcn_mfma_f32_32x32x16_bf16(b0, qr[d0], P0, 0, 0, 0); P1 = __builtin_amdgcn_mfma_f32_32x32x16_bf16(b1, qr[d0], P1, 0, 0, 0); }
      A3_MASK(P0, P1, 0);
      const LAS char* kb1 = kbase + KSLOT;
#pragma unroll
      for (int j = 0; j < 6; ++j) A3_KLOAD(j, kb1); }
    asm volatile("s_waitcnt lgkmcnt(0)\n\ts_barrier" ::: "memory");
    A3_DMAK(3, 0);
    int ks = 2, vs = 0;
#define A3_GA0(MF, X, e0) do { MF; X[e0] = A3_EX(X[e0]); X[(e0) + 1] = A3_EX(X[(e0) + 1]); A3_PIN(X); A3_SB(); } while (0)
#define A3_GA(MF, X, e0, Y, f0) do { MF; X[e0] = A3_EX(X[e0]); X[(e0) + 1] = A3_EX(X[(e0) + 1]); sacc += Y[f0] + Y[(f0) + 1]; A3_PIN(X); A3_PIN(sacc); A3_SB(); } while (0)
#define A3_VRD(i) do { asm volatile("ds_read_b64_tr_b16 %0,%1 offset:%c2" : "=&v"(vl[i]) : "v"(vb), "i"(((i) & 1) * 4096 + ((i) >> 1) * 1024) : "memory"); \
                        asm volatile("ds_read_b64_tr_b16 %0,%1 offset:%c2" : "=&v"(vh[i]) : "v"(vb), "i"(((i) & 1) * 4096 + ((i) >> 1) * 1024 + 512) : "memory"); } while (0)
#define A3_VF(i) (bf16x8){vl[i][0], vl[i][1], vl[i][2], vl[i][3], vh[i][0], vh[i][1], vh[i][2], vh[i][3]}
#define A3_LW(n) asm volatile("s_waitcnt lgkmcnt(" #n ")" ::: "memory")
#define A3_STEP(PA0, PA1, CA0, CA1, tt) do { \
        if ((tt) + 3 < NT) { asm volatile("s_waitcnt vmcnt(3) lgkmcnt(0)\n\ts_barrier" ::: "memory"); } \
        else if ((tt) + 1 < NT) { asm volatile("s_waitcnt vmcnt(1) lgkmcnt(0)\n\ts_barrier" ::: "memory"); } \
        else { asm volatile("s_waitcnt vmcnt(0) lgkmcnt(0)\n\ts_barrier" ::: "memory"); } \
        const int ks4 = (ks + 2 >= 3) ? ks - 1 : ks + 2; \
        const int vs2 = (vs + 2 >= 3) ? vs - 1 : vs + 2; \
        if ((tt) + 2 < NT) A3_DMAV((tt) + 2, vs2); \
        const bool has_next = ((tt) + 1 < NT); \
        CA0 = f32x16{}; CA1 = f32x16{}; \
        u32x4 pw0, pw1, pw2, pw3; float sacc = 0.f; \
        const int vb = vb0 + vs * VSLOT; s16x4 vl[8], vh[8]; \
        { \
            A3_SB(); A3_VRD(0); A3_VRD(1); A3_VRD(2); A3_SB(); \
            A3_GA0(CA0 = __builtin_amdgcn_mfma_f32_32x32x16_bf16(kf[0], qr[0], CA0, 0, 0, 0), PA0, 0); \
            A3_GA(CA1 = __builtin_amdgcn_mfma_f32_32x32x16_bf16(kf[1], qr[0], CA1, 0, 0, 0), PA0, 2, PA0, 0); \
            A3_GA(CA0 = __builtin_amdgcn_mfma_f32_32x32x16_bf16(kf[2], qr[1], CA0, 0, 0, 0), PA0, 4, PA0, 2); \
            A3_GA(CA1 = __builtin_amdgcn_mfma_f32_32x32x16_bf16(kf[3], qr[1], CA1, 0, 0, 0), PA0, 6, PA0, 4); \
            A3_GA(CA0 = __builtin_amdgcn_mfma_f32_32x32x16_bf16(kf[4], qr[2], CA0, 0, 0, 0), PA0, 8, PA0, 6); \
            pw0 = (u32x4){pk2(PA0[0], PA0[1]), pk2(PA0[2], PA0[3]), pk2(PA0[4], PA0[5]), pk2(PA0[6], PA0[7])}; A3_PIN(pw0); \
            A3_GA(CA1 = __builtin_amdgcn_mfma_f32_32x32x16_bf16(kf[5], qr[2], CA1, 0, 0, 0), PA0, 10, PA0, 8); \
            A3_GA(CA0 = __builtin_amdgcn_mfma_f32_32x32x16_bf16(kf[6], qr[3], CA0, 0, 0, 0), PA0, 12, PA0, 10); \
            A3_GA(CA1 = __builtin_amdgcn_mfma_f32_32x32x16_bf16(kf[7], qr[3], CA1, 0, 0, 0), PA0, 14, PA0, 12); \
            A3_GA(CA0 = __builtin_amdgcn_mfma_f32_32x32x16_bf16(kf[8], qr[4], CA0, 0, 0, 0), PA1, 0, PA0, 14); \
            pw1 = (u32x4){pk2(PA0[8], PA0[9]), pk2(PA0[10], PA0[11]), pk2(PA0[12], PA0[13]), pk2(PA0[14], PA0[15])}; A3_PIN(pw1); \
            A3_GA(CA1 = __builtin_amdgcn_mfma_f32_32x32x16_bf16(kf[9], qr[4], CA1, 0, 0, 0), PA1, 2, PA1, 0); \
            A3_GA(CA0 = __builtin_amdgcn_mfma_f32_32x32x16_bf16(kf[10], qr[5], CA0, 0, 0, 0), PA1, 4, PA1, 2); \
            A3_GA(CA1 = __builtin_amdgcn_mfma_f32_32x32x16_bf16(kf[11], qr[5], CA1, 0, 0, 0), PA1, 6, PA1, 4); \
        } \
        { const LAS char* kb2 = kbase + ks * KSLOT; \
          A3_SB(); A3_LW(4); A3_SB(); \
          o[0] = __builtin_amdgcn_mfma_f32_32x32x16_bf16(__builtin_bit_cast(bf16x8, pw0), A3_VF(0), o[0], 0, 0, 0); \
          PA1[8] = A3_EX(PA1[8]); PA1[9] = A3_EX(PA1[9]); sacc += PA1[6] + PA1[7]; A3_PIN(PA1); A3_PIN(sacc); A3_SB(); \
          A3_VRD(3); A3_SB(); A3_LW(4); A3_SB(); \
          o[1] = __builtin_amdgcn_mfma_f32_32x32x16_bf16(__builtin_bit_cast(bf16x8, pw0), A3_VF(1), o[1], 0, 0, 0); \
          PA1[10] = A3_EX(PA1[10]); PA1[11] = A3_EX(PA1[11]); sacc += PA1[8] + PA1[9]; A3_PIN(PA1); A3_PIN(sacc); \
          pw2 = (u32x4){pk2(PA1[0], PA1[1]), pk2(PA1[2], PA1[3]), pk2(PA1[4], PA1[5]), pk2(PA1[6], PA1[7])}; A3_PIN(pw2); A3_SB(); \
          A3_VRD(4); A3_SB(); A3_LW(4); A3_SB(); \
          o[0] = __builtin_amdgcn_mfma_f32_32x32x16_bf16(__builtin_bit_cast(bf16x8, pw1), A3_VF(2), o[0], 0, 0, 0); \
          PA1[12] = A3_EX(PA1[12]); PA1[13] = A3_EX(PA1[13]); sacc += PA1[10] + PA1[11]; A3_PIN(PA1); A3_PIN(sacc); A3_SB(); \
          A3_VRD(5); A3_SB(); A3_LW(4); A3_SB(); \
          o[1] = __builtin_amdgcn_mfma_f32_32x32x16_bf16(__builtin_bit_cast(bf16x8, pw1), A3_VF(3), o[1], 0, 0, 0); \
          PA1[14] = A3_EX(PA1[14]); PA1[15] = A3_EX(PA1[15]); sacc += PA1[12] + PA1[13]; A3_PIN(PA1); A3_PIN(sacc); A3_SB(); \
          A3_VRD(6); A3_SB(); A3_LW(4); A3_SB(); \
          o[0] = __builtin_amdgcn_mfma_f32_32x32x16_bf16(__builtin_bit_cast(bf16x8, pw2), A3_VF(4), o[0], 0, 0, 0); \
          sacc += PA1[14] + PA1[15]; A3_PIN(sacc); \
          pw3 = (u32x4){pk2(PA1[8], PA1[9]), pk2(PA1[10], PA1[11]), pk2(PA1[12], PA1[13]), pk2(PA1[14], PA1[15])}; A3_PIN(pw3); A3_SB(); \
          A3_VRD(7); A3_SB(); A3_LW(4); A3_SB(); \
          o[1] = __builtin_amdgcn_mfma_f32_32x32x16_bf16(__builtin_bit_cast(bf16x8, pw2), A3_VF(5), o[1], 0, 0, 0); A3_SB(); \
          A3_KLOAD(0, kb2); A3_KLOAD(1, kb2); A3_KLOAD(2, kb2); A3_SB(); \
          A3_LW(8); A3_SB(); \
          o[0] = __builtin_amdgcn_mfma_f32_32x32x16_bf16(__builtin_bit_cast(bf16x8, pw3), A3_VF(6), o[0], 0, 0, 0); A3_SB(); \
          A3_KLOAD(3, kb2); A3_KLOAD(4, kb2); A3_KLOAD(5, kb2); A3_SB(); \
          A3_LW(12); A3_SB(); \
          o[1] = __builtin_amdgcn_mfma_f32_32x32x16_bf16(__builtin_bit_cast(bf16x8, pw3), A3_VF(7), o[1], 0, 0, 0); A3_SB(); \
          if ((tt) + 4 < NT) { A3_DMAK((tt) + 4, ks4); } A3_SB(); \
        } \
        l_reg += sacc; \
        if (has_next) { A3_MASK(CA0, CA1, (tt) + 1); } \
        ks = (ks + 1 >= 3) ? 0 : ks + 1; vs = (vs + 1 >= 3) ? 0 : vs + 1; \
    } while (0)
    f32x16 C0, C1;
#if MK_ATT_PRIO
    if (wid >= 4) __builtin_amdgcn_s_setprio(1);
#endif
#pragma unroll 1
    for (int t = 0; t < NT; t += 2) { A3_STEP(P0, P1, C0, C1, t); A3_STEP(C0, C1, P0, P1, t + 1); }
#if MK_ATT_PRIO
    __builtin_amdgcn_s_setprio(0);
#endif
#undef A3_STEP
#undef A3_GA
#undef A3_GA0
#undef A3_VRD
#undef A3_VF
#undef A3_LW
    { auto rr = __builtin_amdgcn_permlane32_swap(__float_as_uint(l_reg), __float_as_uint(l_reg), false, false); l_reg = __uint_as_float(rr[0]) + __uint_as_float(rr[1]); }
    if (hi == 0) wsf[32 + r32] = l_reg; LDS_WAIT();
    float rli[16];
#pragma unroll
    for (int r = 0; r < 16; ++r) rli[r] = __builtin_amdgcn_rcpf(wsf[32 + crow(r, hi)]);
    { LAS bf16_t* stg = (LAS bf16_t*)((LAS char*)shm + L_OST) + wid * 2048;
#pragma unroll
      for (int r = 0; r < 16; ++r) { const int orow = crow(r, hi);
#pragma unroll
          for (int d0 = 0; d0 < 2; ++d0) stg[orow * 64 + d0 * 32 + r32] = (bf16_t)f2bf(o[d0][r] * rli[r]); }
      LDS_WAIT();
#pragma unroll
      for (int i = 0; i < 4; ++i) { const int row = i * 8 + (lane >> 3), ch = lane & 7; const u32x4 v = *(const LAS u32x4*)(stg + row * 64 + ch * 8);
          const size_t tr = (size_t)b * S + q0 + wid * 32 + row;
          *(u32x4*)(MIX + tr * DM + h * 64 + ch * 8) = v;
          float ss = bflo(v.x) * bflo(v.x) + bfhi(v.x) * bfhi(v.x) + bflo(v.y) * bflo(v.y) + bfhi(v.y) * bfhi(v.y) + bflo(v.z) * bflo(v.z) + bfhi(v.z) * bfhi(v.z) + bflo(v.w) * bflo(v.w) + bfhi(v.w) * bfhi(v.w);
          ss += shx(ss, 1); ss += shx(ss, 2); ss += shx(ss, 4);
          if (ch == 0) st_wt(SA + tr * 8 + h, ss); } }
    asm volatile("s_waitcnt lgkmcnt(0)\n\ts_barrier" ::: "memory");
#undef A3_DMAK
#undef A3_DMAV
#undef A3_MASK
#undef A3_KLOAD
}
}

__device__ __forceinline__ float inv_ra(const float* SA, size_t t) { const f32x4 s0 = *(const f32x4*)(SA + t * 8), s1 = *(const f32x4*)(SA + t * 8 + 4);
    return sqrtf((((s0[0] + s0[1]) + (s0[2] + s0[3])) + ((s1[0] + s1[1]) + (s1[2] + s1[3]))) * (1.0f / 512.0f) + EPS); }
__device__ __forceinline__ void gmlp_unit(const Frame& F, int ci, const bf16_t* U, const bf16_t* VS, const bf16_t* Wsg, const float* sgb, const float* gm, bf16_t* MIX, const float* SA) {
    LAS unsigned char* lds = F.lds; const int tid = F.tid, lane = F.lane, wid = F.wave, r32 = lane & 31, hi = lane >> 5;
    const size_t t0 = (size_t)ci * 128;
#pragma unroll
    for (int j = 0; j < 8; ++j) { const int g = j >> 1, sh = j & 1;
        const u32x4 v = *(const u32x4*)(VS + (t0 + 64 * sh + 16 * (wid & 3) + (lane >> 2)) * 256 + g * 64 + (wid >> 2) * 32 + (lane & 3) * 8);
        *(LAS u32x4*)(lds + j * 8192 + wid * 1024 + lane * 16) = v; }
#pragma unroll
    for (int i = 0; i < 8; ++i) { const int piece = wid + 8 * i; const u32x4 v = *(const u32x4*)(U + t0 * 256 + (size_t)piece * 512 + lane * 8); *(LAS u32x4*)(lds + 65536 + piece * 1024 + lane * 16) = v; }
    LDS_WAIT(); __syncthreads();
    const int g = wid >> 1, th = wid & 1;
    f32x16 acc[2][2];
#pragma unroll
    for (int mb = 0; mb < 2; ++mb) { acc[mb][0] = f32x16{}; acc[mb][1] = f32x16{}; }
    const int vbl = ((lane >> 4) & 1) * 32 + (lane & 3) * 8 + (4 * hi + ((lane & 15) >> 2)) * 64;
    const unsigned ldsb = (unsigned)(uintptr_t)(char*)lds;
#pragma unroll
    for (int mb = 0; mb < 2; ++mb) { const int tb = 64 * th + 32 * mb; const int nks = (tb + 32) / 16;
        const bf16_t* wrow = Wsg + ((size_t)g * 128 + tb + r32) * 128 + 8 * hi;
        bf16x8 af[8];
#pragma unroll
        for (int ks = 0; ks < 8; ++ks) if (ks < nks) af[ks] = *(const bf16x8*)(wrow + 16 * ks);
#pragma unroll
        for (int ks = 0; ks < 8; ++ks) if (ks < nks) { const bf16x8 a = af[ks];
            const int vb = (int)ldsb + (g * 2 + (ks >> 2)) * 8192 + (ks & 3) * 1024 + vbl;
            s16x4 lo0, hi0, lo1, hi1;
            asm volatile("ds_read_b64_tr_b16 %0,%1" : "=&v"(lo0) : "v"(vb) : "memory");
            asm volatile("ds_read_b64_tr_b16 %0,%1 offset:512" : "=&v"(hi0) : "v"(vb) : "memory");
            asm volatile("ds_read_b64_tr_b16 %0,%1 offset:4096" : "=&v"(lo1) : "v"(vb) : "memory");
            asm volatile("ds_read_b64_tr_b16 %0,%1 offset:4608" : "=&v"(hi1) : "v"(vb) : "memory");
            asm volatile("s_waitcnt lgkmcnt(0)" ::: "memory"); __builtin_amdgcn_sched_barrier(0);
            acc[mb][0] = __builtin_amdgcn_mfma_f32_32x32x16_bf16(a, (bf16x8){lo0[0], lo0[1], lo0[2], lo0[3], hi0[0], hi0[1], hi0[2], hi0[3]}, acc[mb][0], 0, 0, 0);
            acc[mb][1] = __builtin_amdgcn_mfma_f32_32x32x16_bf16(a, (bf16x8){lo1[0], lo1[1], lo1[2], lo1[3], hi1[0], hi1[1], hi1[2], hi1[3]}, acc[mb][1], 0, 0, 0); } }
    MFMA_PAD(acc[0][0]); MFMA_PAD(acc[0][1]); MFMA_PAD(acc[1][0]); MFMA_PAD(acc[1][1]);
    __syncthreads();
#pragma unroll
    for (int mb = 0; mb < 2; ++mb)
#pragma unroll
        for (int r = 0; r < 16; ++r) { const int t = 64 * th + 32 * mb + att::crow(r, hi); const float bias = sgb[g * 128 + t];
#pragma unroll
            for (int d0 = 0; d0 < 2; ++d0) { const int c = g * 64 + 32 * d0 + r32; const float u = bf2f(*(const LAS bf16_t*)(lds + 65536 + t * 512 + c * 2));
                *(LAS bf16_t*)(lds + t * 512 + c * 2) = (bf16_t)f2bf(u * (acc[mb][d0][r] + bias)); } }
    LDS_WAIT(); __syncthreads();
#pragma unroll 4
    for (int i = 0; i < 16; ++i) { const int row = wid * 16 + i; const u32x2 w = *(const LAS u32x2*)(lds + row * 512 + lane * 8);
        const float a0 = bflo(w.x), a1 = bfhi(w.x), a2 = bflo(w.y), a3 = bfhi(w.y);
        const float rg = rsqrtf(wave_sum((a0 * a0 + a1 * a1) + (a2 * a2 + a3 * a3)) * (1.0f / 256.0f) + EPS) * inv_ra(SA, t0 + row); const f32x4 gg = *(const f32x4*)(gm + 512 + 4 * lane);
        u32x2 o; o.x = pk2(a0 * rg * gg[0], a1 * rg * gg[1]); o.y = pk2(a2 * rg * gg[2], a3 * rg * gg[3]);
        *(u32x2*)(MIX + (t0 + row) * DM + 512 + 4 * lane) = o; }
    __syncthreads();
}

constexpr int S5_BU = 8704  , S5_GG = 8 * S5_BU  , S5_GG_ROW = 528, S5_ST_ROW = 260;
template <int MODE>
__device__ __forceinline__ void s5_block(const bf16_t* XSrow0  , const bf16x8 (&bfrag)[4], LAS unsigned char* bu, int lane, float are, float aim, float& hr, float& hi_, unsigned& g_rgx, unsigned& g_ux) {
    const int r32 = lane & 31, hi = lane >> 5;
    const bf16x8 a = *(const bf16x8*)(XSrow0 + (size_t)r32 * 256 + 8 * hi);
#pragma unroll
    for (int hb = 0; hb < 2; ++hb) {
        f32x16 cr = __builtin_amdgcn_mfma_f32_32x32x16_bf16(a, bfrag[hb], f32x16{}, 0, 0, 0);
        f32x16 ci = __builtin_amdgcn_mfma_f32_32x32x16_bf16(a, bfrag[2 + hb], f32x16{}, 0, 0, 0);
        MFMA_PAD(cr); MFMA_PAD(ci);
#pragma unroll
        for (int r = 0; r < 16; ++r) *(LAS unsigned*)(bu + att::crow(r, hi) * 272 + (32 * hb + r32) * 4) = pk2(cr[r], ci[r]); }
    LDS_WAIT();
#if MK_S5_V2 == 8 || MK_S5_V2 == 7
    float ar_ = hr, ai_ = hi_;
    if (MODE == 3) {
#pragma unroll 8
        for (int r = 0; r < 32; ++r) { const unsigned w = *(const LAS unsigned*)(bu + r * 272 + lane * 4); const float ur = bflo(w), ui = bfhi(w);
            const float nr = are * ar_ - aim * ai_ + ur, ni = are * ai_ + aim * ar_ + ui; ar_ = nr; ai_ = ni; }
        asm volatile("" : "+v"(ar_), "+v"(ai_));
    }
#endif
#pragma unroll 8
    for (int r = 0; r < 32; ++r) { const unsigned w = *(const LAS unsigned*)(bu + r * 272 + lane * 4); const float ur = bflo(w), ui = bfhi(w);
#if MK_S5_V2 == 7
        if (MODE == 3) g_ux ^= w * (2u * r + 1u);
#endif
#if MK_S5_SCALAR
        float nr = are * hr - aim * hi_ + ur; float hi2 = hi_; asm volatile("" : "+v"(nr), "+v"(hi2));
        const float ni = are * hi2 + aim * hr + ui; hr = nr; hi_ = ni;
#else
        const float nr = are * hr - aim * hi_ + ur, ni = are * hi_ + aim * hr + ui; hr = nr; hi_ = ni;
#endif
        if (MODE == 3) { const unsigned pw = pk2(nr, ni); *(LAS unsigned*)(bu + r * 272 + lane * 4) = pw;

        } }
#if MK_S5_V2 == 7
    if (MODE == 3) g_rgx = (__builtin_bit_cast(unsigned, ar_) != __builtin_bit_cast(unsigned, hr) || __builtin_bit_cast(unsigned, ai_) != __builtin_bit_cast(unsigned, hi_)) ? 0x12345u : 0u;
#endif
#if MK_S5_V2 == 8
    if (MODE == 3) g_rgx |= (__builtin_bit_cast(unsigned, ar_) != __builtin_bit_cast(unsigned, hr) || __builtin_bit_cast(unsigned, ai_) != __builtin_bit_cast(unsigned, hi_)) ? 1u : 0u;
#endif
    LDS_WAIT();
}
__device__ __forceinline__ void s5_pass1(const Frame& F, int task, const bf16_t* XS, const unsigned char* tb, float* E) {
    const int lane = F.lane, wid = F.wave, r32 = lane & 31, hi = lane >> 5;
    const float* ab = (const float*)(tb + S5T_AB); const bf16_t* BBt = (const bf16_t*)(tb + S5T_BBT);
    const size_t t0 = (size_t)task * 64;
    LAS unsigned char* bu = F.lds + wid * S5_BU;
    for (int gi = 0; gi < 2; ++gi) { const int g = 2 * wid + gi; const float are = ab[g * 64 + lane], aim = ab[1024 + g * 64 + lane];
        bf16x8 bfrag[4];
#pragma unroll
        for (int nb = 0; nb < 4; ++nb) bfrag[nb] = *(const bf16x8*)(BBt + ((size_t)g * 128 + 32 * nb + r32) * 16 + 8 * hi);
        float hr = 0.f, hi_ = 0.f;
        for (int blk = 0; blk < 2; ++blk) { unsigned dum_ = 0u, dum2_ = 0u; s5_block<1>(XS + (t0 + 32 * blk) * 256 + g * 16, bfrag, bu, lane, are, aim, hr, hi_, dum_, dum2_); }
        E[((size_t)task * 16 + g) * 128 + lane] = hr; E[((size_t)task * 16 + g) * 128 + 64 + lane] = hi_; }
}
__device__ __forceinline__ void s5_carry(int idx, const unsigned char* tb, const float* __restrict__ E, float* __restrict__ Hs) {
    const float* ab = (const float*)(tb + S5T_AB); const int n = idx & 63, g = (idx >> 6) & 15, b = idx >> 10;
    const float are = ab[2048 + g * 64 + n], aim = ab[3072 + g * 64 + n]; float hr = 0.f, hi_ = 0.f;
    const size_t o0 = ((size_t)(b * 256) * 16 + g) * 128 + n;
#pragma unroll 1
    for (int jb = 0; jb < 256; jb += 16) { float er[16], ei[16];
#pragma unroll
        for (int k = 0; k < 16; ++k) { const size_t o = o0 + (size_t)(jb + k) * 2048; er[k] = E[o]; ei[k] = E[o + 64]; }
#pragma unroll
        for (int k = 0; k < 16; ++k) { const size_t o = o0 + (size_t)(jb + k) * 2048; Hs[o] = hr; Hs[o + 64] = hi_;
            const float nr = are * hr - aim * hi_ + er[k], ni = are * hi_ + aim * hr + ei[k]; hr = nr; hi_ = ni; } }
}
__device__ __forceinline__ void s5_carry_seg(const Frame& F, int bg, const unsigned char* tb, const float* __restrict__ E, float* __restrict__ Hs) {
    const float* ab = (const float*)(tb + S5T_AB); const int n = F.lane, w = F.wave, g = bg & 15, b = bg >> 4;
    const float are = ab[2048 + g * 64 + n], aim = ab[3072 + g * 64 + n];
    float sr = are, si = aim;
#pragma unroll
    for (int k = 0; k < 5; ++k) { const float tr = sr * sr - si * si, ti = 2.0f * sr * si; sr = tr; si = ti; }
    const size_t o0 = ((size_t)(b * 256 + 32 * w) * 16 + g) * 128 + n;
    float er[32], ei[32];
#pragma unroll
    for (int k = 0; k < 32; ++k) { er[k] = E[o0 + (size_t)k * 2048]; ei[k] = E[o0 + (size_t)k * 2048 + 64]; }
    float hr = 0.f, hi_ = 0.f;
#pragma unroll
    for (int k = 0; k < 32; ++k) { const float nr = are * hr - aim * hi_ + er[k], ni = are * hi_ + aim * hr + ei[k]; hr = nr; hi_ = ni; }
    LAS float* tot = (LAS float*)F.lds;
    tot[w * 128 + n] = hr; tot[w * 128 + 64 + n] = hi_;
    LDS_WAIT(); __syncthreads();
    hr = 0.f; hi_ = 0.f;
    for (int k = 0; k < w; ++k) { const float tr = tot[k * 128 + n], ti = tot[k * 128 + 64 + n]; const float nr = sr * hr - si * hi_ + tr, ni = sr * hi_ + si * hr + ti; hr = nr; hi_ = ni; }
#pragma unroll
    for (int k = 0; k < 32; ++k) { Hs[o0 + (size_t)k * 2048] = hr; Hs[o0 + (size_t)k * 2048 + 64] = hi_;
        const float nr = are * hr - aim * hi_ + er[k], ni = are * hi_ + aim * hr + ei[k]; hr = nr; hi_ = ni; }
    __syncthreads();
}
__device__ __forceinline__ void s5_pass3(const Frame& F, int task, const bf16_t* XS, const unsigned char* tb, const float* Hs, const bf16_t* Wglu, const float* bglu, const float* gm, bf16_t* MIX, const float* SA) {
    const int lane = F.lane, wid = F.wave, r32 = lane & 31, hi = lane >> 5;
    const float* ab = (const float*)(tb + S5T_AB); const bf16_t* BBt = (const bf16_t*)(tb + S5T_BBT); const bf16_t* Cmt = (const bf16_t*)(tb + S5T_CMT); const float* dd = (const float*)(tb + S5T_D);
    const size_t t0 = (size_t)task * 64;
    LAS unsigned char* bu = F.lds + wid * S5_BU; LAS unsigned char* ggt = F.lds + S5_GG;
#if MK_S5_SCRUB
    asm volatile("v_mov_b32 v150, 0\n\tv_mov_b32 v151, 0\n\tv_mov_b32 v152, 0\n\tv_mov_b32 v153, 0\n\tv_mov_b32 v154, 0\n\tv_mov_b32 v155, 0\n\tv_mov_b32 v156, 0\n\tv_mov_b32 v157, 0\n\tv_mov_b32 v158, 0\n\tv_mov_b32 v159, 0\n\tv_mov_b32 v160, 0\n\tv_mov_b32 v161, 0\n\tv_mov_b32 v162, 0\n\tv_mov_b32 v163, 0\n\tv_mov_b32 v164, 0\n\tv_mov_b32 v165, 0\n\tv_mov_b32 v166, 0\n\tv_mov_b32 v167, 0\n\tv_mov_b32 v168, 0\n\tv_mov_b32 v169, 0\n\tv_mov_b32 v170, 0\n\tv_mov_b32 v171, 0\n\tv_mov_b32 v172, 0\n\tv_mov_b32 v173, 0\n\tv_mov_b32 v174, 0\n\tv_mov_b32 v175, 0\n\tv_mov_b32 v176, 0\n\tv_mov_b32 v177, 0\n\tv_mov_b32 v178, 0\n\tv_mov_b32 v179, 0\n\tv_mov_b32 v180, 0\n\tv_mov_b32 v181, 0\n\tv_mov_b32 v182, 0\n\tv_mov_b32 v183, 0\n\tv_mov_b32 v184, 0\n\tv_mov_b32 v185, 0\n\tv_mov_b32 v186, 0\n\tv_mov_b32 v187, 0\n\tv_mov_b32 v188, 0\n\tv_mov_b32 v189, 0\n\tv_mov_b32 v190, 0\n\tv_mov_b32 v191, 0\n\tv_mov_b32 v192, 0\n\tv_mov_b32 v193, 0\n\tv_mov_b32 v194, 0\n\tv_mov_b32 v195, 0\n\tv_mov_b32 v196, 0\n\tv_mov_b32 v197, 0\n\tv_mov_b32 v198, 0\n\tv_mov_b32 v199, 0\n\tv_mov_b32 v200, 0\n\tv_mov_b32 v201, 0\n\tv_mov_b32 v202, 0\n\tv_mov_b32 v203, 0\n\tv_mov_b32 v204, 0\n\tv_mov_b32 v205, 0\n\tv_mov_b32 v206, 0\n\tv_mov_b32 v207, 0\n\tv_mov_b32 v208, 0\n\tv_mov_b32 v209, 0\n\tv_mov_b32 v210, 0\n\tv_mov_b32 v211, 0\n\tv_mov_b32 v212, 0\n\tv_mov_b32 v213, 0\n\tv_mov_b32 v214, 0\n\tv_mov_b32 v215, 0\n\tv_mov_b32 v216, 0\n\tv_mov_b32 v217, 0\n\tv_mov_b32 v218, 0\n\tv_mov_b32 v219, 0\n\tv_mov_b32 v220, 0\n\tv_mov_b32 v221, 0\n\tv_mov_b32 v222, 0\n\tv_mov_b32 v223, 0\n\tv_mov_b32 v224, 0\n\tv_mov_b32 v225, 0\n\tv_mov_b32 v226, 0\n\tv_mov_b32 v227, 0\n\tv_mov_b32 v228, 0\n\tv_mov_b32 v229, 0\n\tv_mov_b32 v230, 0\n\tv_mov_b32 v231, 0\n\tv_mov_b32 v232, 0\n\tv_mov_b32 v233, 0\n\tv_mov_b32 v234, 0\n\tv_mov_b32 v235, 0\n\tv_mov_b32 v236, 0\n\tv_mov_b32 v237, 0\n\tv_mov_b32 v238, 0\n\tv_mov_b32 v239, 0\n\tv_mov_b32 v240, 0\n\tv_mov_b32 v241, 0\n\tv_mov_b32 v242, 0\n\tv_mov_b32 v243, 0\n\tv_mov_b32 v244, 0\n\tv_mov_b32 v245, 0\n\tv_mov_b32 v246, 0\n\tv_mov_b32 v247, 0\n\tv_mov_b32 v248, 0\n\tv_mov_b32 v249, 0" ::: "v150", "v151", "v152", "v153", "v154", "v155", "v156", "v157", "v158", "v159", "v160", "v161", "v162", "v163", "v164", "v165", "v166", "v167", "v168", "v169", "v170", "v171", "v172", "v173", "v174", "v175", "v176", "v177", "v178", "v179", "v180", "v181", "v182", "v183", "v184", "v185", "v186", "v187", "v188", "v189", "v190", "v191", "v192", "v193", "v194", "v195", "v196", "v197", "v198", "v199", "v200", "v201", "v202", "v203", "v204", "v205", "v206", "v207", "v208", "v209", "v210", "v211", "v212", "v213", "v214", "v215", "v216", "v217", "v218", "v219", "v220", "v221", "v222", "v223", "v224", "v225", "v226", "v227", "v228", "v229", "v230", "v231", "v232", "v233", "v234", "v235", "v236", "v237", "v238", "v239", "v240", "v241", "v242", "v243", "v244", "v245", "v246", "v247", "v248", "v249");
#endif
#if MK_S5_ZERO
    if (MK_S5_ZERO != 4) for (int i = F.tid; i < ((MK_S5_ZERO == 1 || MK_S5_ZERO == 5) ? S5_GG : (S5_GG + 64 * S5_GG_ROW)) / 16; i += NW * 64) if (MK_S5_ZERO != 3 || i >= S5_GG / 16) *(LAS u32x4*)(F.lds + i * 16) = (MK_S5_ZERO == 5) ? (u32x4){0x7FC07FC0u, 0x7FC07FC0u, 0x7FC07FC0u, 0x7FC07FC0u} : (u32x4){0u, 0u, 0u, 0u};
    LDS_WAIT(); __syncthreads();
#endif
    for (int gi = 0; gi < 2; ++gi) { const int g = 2 * wid + gi; const float are = ab[g * 64 + lane], aim = ab[1024 + g * 64 + lane];
        bf16x8 bfrag[4];
#pragma unroll
        for (int nb = 0; nb < 4; ++nb) bfrag[nb] = *(const bf16x8*)(BBt + ((size_t)g * 128 + 32 * nb + r32) * 16 + 8 * hi);
        bf16x8 cfrag[8];
#pragma unroll
        for (int ks = 0; ks < 8; ++ks) { u32x4 w = (u32x4){0u, 0u, 0u, 0u}; if (r32 < 16) w = *(const u32x4*)(Cmt + ((size_t)g * 16 + r32) * 128 + 16 * ks + 8 * hi); cfrag[ks] = __builtin_bit_cast(bf16x8, w); }
        const float dv = dd[g * 16 + (lane & 15)];
#if MK_S5_V2 == 6
        { unsigned hx = 0u;
#pragma unroll
          for (int ks = 0; ks < 8; ++ks) { const u32x4 w = __builtin_bit_cast(u32x4, cfrag[ks]); hx ^= w.x * (8u * ks + 1u) ^ w.y * (8u * ks + 3u) ^ w.z * (8u * ks + 5u) ^ w.w * (8u * ks + 7u); }
          ((unsigned*)(F.ws + (650ull << 20)))[((size_t)task * 16 + g) * 64 + lane] = hx; }
#endif
        float hr = Hs[((size_t)task * 16 + g) * 128 + lane], hi_ = Hs[((size_t)task * 16 + g) * 128 + 64 + lane];
#if MK_S5_V2 == 7
        asm volatile("s_waitcnt vmcnt(0)" ::: "memory");
        const unsigned hs_r = __hip_atomic_load((const unsigned*)Hs + ((size_t)task * 16 + g) * 128 + lane, __ATOMIC_RELAXED, __HIP_MEMORY_SCOPE_SYSTEM), hs_i = __hip_atomic_load((const unsigned*)Hs + ((size_t)task * 16 + g) * 128 + 64 + lane, __ATOMIC_RELAXED, __HIP_MEMORY_SCOPE_SYSTEM);
        ((unsigned*)(F.ws + (666ull << 20)))[(((size_t)task * 16 + g) * 2 + 0) * 64 + lane] = hs_r * 3u ^ hs_i * 5u;
        ((unsigned*)(F.ws + (666ull << 20)))[(((size_t)task * 16 + g) * 2 + 1) * 64 + lane] = __builtin_bit_cast(unsigned, hr) * 3u ^ __builtin_bit_cast(unsigned, hi_) * 5u;
#endif
#if MK_S5_V1
        hr = 0.f; hi_ = 0.f;
#endif
        for (int blk = 0; blk < 2; ++blk) { const bf16_t* xr0 = XS + (t0 + 32 * blk) * 256 + g * 16;
            unsigned short xraw[16];
#pragma unroll
            for (int r = 0; r < 16; ++r) xraw[r] = xr0[(size_t)att::crow(r, hi) * 256 + (r32 & 15)];
            unsigned rgx = 0u, ux = 0u;
            const float h0raw = hr;
            const unsigned h0x = __builtin_bit_cast(unsigned, hr) * 3u ^ __builtin_bit_cast(unsigned, hi_) * 5u, abx = __builtin_bit_cast(unsigned, are) * 3u ^ __builtin_bit_cast(unsigned, aim) * 5u;
            s5_block<3>(xr0, bfrag, bu, lane, are, aim, hr, hi_, rgx, ux);
#if MK_S5_V2 == 8
            if (rgx) atomicAdd((unsigned*)(F.ws + (650ull << 20)), 1u);
#endif
#if MK_S5_V2 == 7
            if (rgx) atomicAdd((unsigned*)(F.ws + (649ull << 20)), 1u);
            float are2 = are, aim2 = aim; asm volatile("" : "+v"(are2), "+v"(aim2));
            const unsigned abx2 = __builtin_bit_cast(unsigned, are2) * 3u ^ __builtin_bit_cast(unsigned, aim2) * 5u;
            float hp_r = hr, hp_i = hi_; asm volatile("" : "+v"(hp_r), "+v"(hp_i));
            const unsigned hpost = __builtin_bit_cast(unsigned, hp_r) * 3u ^ __builtin_bit_cast(unsigned, hp_i) * 5u;
#endif
#if MK_S5_V2 == 7
            { unsigned scx = 0u;
#pragma unroll 8
              for (int r = 0; r < 32; ++r) scx ^= *(const LAS unsigned*)(bu + r * 272 + lane * 4) * (2u * r + 1u);
              const size_t di = (((size_t)task * 16 + g) * 2 + blk) * 64 + lane;
              ((unsigned*)(F.ws + (650ull << 20)))[di] = abx; ((unsigned*)(F.ws + (654ull << 20)))[di] = ux; ((unsigned*)(F.ws + (658ull << 20)))[di] = h0x; ((unsigned*)(F.ws + (662ull << 20)))[di] = hpost; ((unsigned*)(F.ws + (642ull << 20)))[di] = abx2; if (scx == 0x777u) ((unsigned*)(F.ws + (650ull << 20)))[di] = 1u; }
#endif
            f32x16 y = f32x16{};
#if MK_S5_V2 == 6 || MK_S5_V2 == 7
            unsigned ax = 0u;
#pragma unroll
            for (int ks = 0; ks < 8; ++ks) { const bf16x8 a = *(const LAS bf16x8*)(bu + r32 * 272 + (16 * ks + 8 * hi) * 2); y = __builtin_amdgcn_mfma_f32_32x32x16_bf16(a, cfrag[ks], y, 0, 0, 0);
                const u32x4 w = __builtin_bit_cast(u32x4, a); ax ^= w.x * (8u * ks + 1u) ^ w.y * (8u * ks + 3u) ^ w.z * (8u * ks + 5u) ^ w.w * (8u * ks + 7u); }
            if (MK_S5_V2 != 7) ((unsigned*)(F.ws + (666ull << 20)))[(((size_t)task * 16 + g) * 2 + blk) * 64 + lane] = ax; else if (ax == 0x5151u) ((unsigned*)(F.ws + (650ull << 20)))[0] = 1u;
#else
#pragma unroll
            for (int ks = 0; ks < 8; ++ks) { const bf16x8 a = *(const LAS bf16x8*)(bu + r32 * 272 + (16 * ks + 8 * hi) * 2); y = __builtin_amdgcn_mfma_f32_32x32x16_bf16(a, cfrag[ks], y, 0, 0, 0); }
#endif
            MFMA_PAD(y);
#pragma unroll
            for (int r = 0; r < 16; ++r) { const int pr = att::crow(r, hi); const float xv = bf2f(xraw[r]);
#if MK_S5_V2 == 1
                const float gvv = bflo(*(const LAS unsigned*)(bu + pr * 272 + (r32 & 15) * 4)) + 0.f * (y[r] + dv * xv);
#elif MK_S5_V2 == 2
                const float gvv = y[r];
#elif MK_S5_V2 == 3
                const float gvv = dv * xv;
#else
                const float gvv = gelu_t(y[r] + dv * xv);
#endif
                const float gnb = shx(gvv, 1);
                if (r32 < 16 && (r32 & 1) == 0) *(LAS unsigned*)(ggt + (32 * blk + pr) * S5_GG_ROW + (g * 16 + r32) * 2) = pk2(gvv, gnb); }
            LDS_WAIT(); } }
    LDS_WAIT(); __syncthreads();
#if DBG == 100 && MK_S5_V2 < 6
    { bf16_t* GGD = (bf16_t*)(F.ws + (650ull << 20));
      for (int i = 0; i < 8; ++i) { const int row = wid * 8 + i; const u32x2 v = *(const LAS u32x2*)(ggt + row * S5_GG_ROW + lane * 8); *(u32x2*)(GGD + (t0 + row) * 256 + 4 * lane) = v; } }
#endif
    { f32x16 acc[2]; acc[0] = f32x16{}; acc[1] = f32x16{}; const bf16_t* wr = Wglu + (size_t)(32 * wid + r32) * 256 + 8 * hi;
#pragma unroll 4
      for (int ks = 0; ks < 16; ++ks) { const bf16x8 bw = *(const bf16x8*)(wr + 16 * ks);
#pragma unroll
          for (int mb = 0; mb < 2; ++mb) { const bf16x8 a = *(const LAS bf16x8*)(ggt + (32 * mb + r32) * S5_GG_ROW + (16 * ks + 8 * hi) * 2); acc[mb] = __builtin_amdgcn_mfma_f32_32x32x16_bf16(a, bw, acc[mb], 0, 0, 0); } }
      MFMA_PAD(acc[0]); MFMA_PAD(acc[1]);
      const int n = 32 * wid + r32; const float bg = bglu[n];
#pragma unroll
      for (int mb = 0; mb < 2; ++mb)
#pragma unroll
          for (int r = 0; r < 16; ++r) { const int pos = 32 * mb + att::crow(r, hi); const float gv = bf2f(*(const LAS bf16_t*)(ggt + pos * S5_GG_ROW + n * 2));
              *(LAS float*)(F.lds + (pos * S5_ST_ROW + n) * 4) = gv * sigm(acc[mb][r] + bg); } }
    LDS_WAIT(); __syncthreads();
#pragma unroll
    for (int i = 0; i < 8; ++i) { const int row = wid * 8 + i; const f32x4 v = *(const LAS f32x4*)(F.lds + (row * S5_ST_ROW + 4 * lane) * 4);
#if DBG == 100 && MK_S5_V2 < 6
        { bf16_t* SD = (bf16_t*)(F.ws + (666ull << 20)); u32x2 d; d.x = pk2(v[0], v[1]); d.y = pk2(v[2], v[3]); *(u32x2*)(SD + (t0 + row) * 256 + 4 * lane) = d; }
#endif
        const float rs = rsqrtf(wave_sum((v[0] * v[0] + v[1] * v[1]) + (v[2] * v[2] + v[3] * v[3])) * (1.0f / 256.0f) + EPS) * inv_ra(SA, t0 + row); const f32x4 gg = *(const f32x4*)(gm + 768 + 4 * lane);
        u32x2 o; o.x = pk2(v[0] * rs * gg[0], v[1] * rs * gg[1]); o.y = pk2(v[2] * rs * gg[2], v[3] * rs * gg[3]);
        *(u32x2*)(MIX + (t0 + row) * DM + 768 + 4 * lane) = o; }
    __syncthreads();
}
__device__ __forceinline__ void anorm_row(int t, int lane, bf16_t* MIX, const float* SA, const float* gm) {
    const f32x4 s0 = *(const f32x4*)(SA + (size_t)t * 8), s1 = *(const f32x4*)(SA + (size_t)t * 8 + 4);
    const float ra = rsqrtf((((s0[0] + s0[1]) + (s0[2] + s0[3])) + ((s1[0] + s1[1]) + (s1[2] + s1[3]))) * (1.0f / 512.0f) + EPS);
    u32x4* p = (u32x4*)(MIX + (size_t)t * DM + 8 * lane); const u32x4 w = *p; const f32x4 g0 = *(const f32x4*)(gm + 8 * lane), g1 = *(const f32x4*)(gm + 8 * lane + 4);
    u32x4 o; o.x = pk2(bflo(w.x) * ra * g0[0], bfhi(w.x) * ra * g0[1]); o.y = pk2(bflo(w.y) * ra * g0[2], bfhi(w.y) * ra * g0[3]);
    o.z = pk2(bflo(w.z) * ra * g1[0], bfhi(w.z) * ra * g1[1]); o.w = pk2(bflo(w.w) * ra * g1[2], bfhi(w.w) * ra * g1[3]); *p = o;
}

__device__ __forceinline__ void anorm_rows4(int t0, int dt, int lane, bf16_t* MIX, const float* SA, const float* gm) {
    u32x4 w[4]; float ra[4];
#pragma unroll
    for (int i = 0; i < 4; ++i) { const int t = t0 + i * dt; const f32x4 s0 = *(const f32x4*)(SA + (size_t)t * 8), s1 = *(const f32x4*)(SA + (size_t)t * 8 + 4);
        w[i] = *(const u32x4*)(MIX + (size_t)t * DM + 8 * lane);
        ra[i] = rsqrtf((((s0[0] + s0[1]) + (s0[2] + s0[3])) + ((s1[0] + s1[1]) + (s1[2] + s1[3]))) * (1.0f / 512.0f) + EPS); }
    const f32x4 g0 = *(const f32x4*)(gm + 8 * lane), g1 = *(const f32x4*)(gm + 8 * lane + 4);
#pragma unroll
    for (int i = 0; i < 4; ++i) { const int t = t0 + i * dt; u32x4 o; const float r = ra[i];
        o.x = pk2(bflo(w[i].x) * r * g0[0], bfhi(w[i].x) * r * g0[1]); o.y = pk2(bflo(w[i].y) * r * g0[2], bfhi(w[i].y) * r * g0[3]);
        o.z = pk2(bflo(w[i].z) * r * g1[0], bfhi(w[i].z) * r * g1[1]); o.w = pk2(bflo(w[i].w) * r * g1[2], bfhi(w[i].w) * r * g1[3]);
        *(u32x4*)(MIX + (size_t)t * DM + 8 * lane) = o; }
}

__device__ __forceinline__ void route_block(const Frame& F, int blk, const bf16_t* Hb, const float* SS2, const bf16_t* Wr, const float* brg, const float* bre,
                                            float* RS2, int* CNT, int* ER, float* WGT) {
    const int lane = F.lane, wid = F.wave, tid = F.tid; const int t0 = blk * 128 + wid * 16;
    LAS float* lg = (LAS float*)(F.lds) + wid * (16 * 49);
    LAS int* cnt = (LAS int*)(F.lds + EXTRA_OFF);
    if (tid < 32) cnt[tid] = 0;
    f32x4 acc[3]; acc[0] = acc[1] = acc[2] = (f32x4){0.f, 0.f, 0.f, 0.f};
    const bf16_t* ap = Hb + (size_t)(t0 + (lane & 15)) * DM + 8 * (lane >> 4); const bf16_t* bp = Wr + (size_t)(lane & 15) * DM + 8 * (lane >> 4);
#pragma unroll 4
    for (int ks = 0; ks < 32; ++ks) { const bf16x8 a = *(const bf16x8*)(ap + 32 * ks);
#pragma unroll
        for (int nb = 0; nb < 3; ++nb) { const bf16x8 bw = *(const bf16x8*)(bp + (size_t)nb * 16 * DM + 32 * ks); acc[nb] = __builtin_amdgcn_mfma_f32_16x16x32_bf16(a, bw, acc[nb], 0, 0, 0); } }
    MFMA_PAD(acc[0]); MFMA_PAD(acc[1]); MFMA_PAD(acc[2]);
#pragma unroll
    for (int nb = 0; nb < 3; ++nb)
#pragma unroll
        for (int r = 0; r < 4; ++r) lg[(4 * (lane >> 4) + r) * 49 + 16 * nb + (lane & 15)] = acc[nb][r];
    LDS_WAIT(); __syncthreads();
    if (lane < 16) { const int t = t0 + lane; const float rs = rsqrtf(sum16(SS2 + (size_t)t * 16) * (1.0f / 1024.0f) + EPS); RS2[t] = rs;
        const LAS float* q = lg + lane * 49;
        float gl[4]; int gs = 0;
#pragma unroll
        for (int j = 0; j < 4; ++j) gl[j] = q[j] * rs + brg[j];
        float gmx = gl[0];
#pragma unroll
        for (int j = 1; j < 4; ++j) if (gl[j] > gmx) { gmx = gl[j]; gs = j; }
        float se = 0.f;
#pragma unroll
        for (int j = 0; j < 4; ++j) se += __expf(gl[j] - gmx);
        const float gw = 1.0f / se;
        float el[8];
#pragma unroll
        for (int j = 0; j < 8; ++j) el[j] = q[4 + gs * 8 + j] * rs + bre[gs * 8 + j];
        int i0 = 0; float v0 = el[0];
#pragma unroll
        for (int j = 1; j < 8; ++j) if (el[j] > v0) { v0 = el[j]; i0 = j; }
        int i1 = 0; float v1 = -3.4e38f;
#pragma unroll
        for (int j = 0; j < 8; ++j) if (j != i0 && el[j] > v1) { v1 = el[j]; i1 = j; }
        const float e1 = __expf(v1 - v0); const float w0 = 1.0f / (1.0f + e1), w1 = e1 / (1.0f + e1);
        const int ea = gs * 8 + i0, eb = gs * 8 + i1;
        const int ra = atomicAdd((int*)&cnt[ea], 1), rb = atomicAdd((int*)&cnt[eb], 1);
        ER[t * 2] = (ea << 16) | ra; ER[t * 2 + 1] = (eb << 16) | rb; WGT[t * 2] = w0 * gw; WGT[t * 2 + 1] = w1 * gw; }
    LDS_WAIT(); __syncthreads();
    if (tid < 32) CNT[blk * 32 + tid] = cnt[tid];
    __syncthreads();
}
__device__ __forceinline__ void scatter_block(const Frame& F, int blk, unsigned hb_off, const float* RS2, const int* CNT, const int* ER, const float* WGT,
                                              int* TSTART, int* TOK, float* RW, float* RRS, unsigned* RTO) {
    const int lane = F.lane, wid = F.wave, tid = F.tid;
    LAS int* sm = (LAS int*)(F.lds);
    { const int e = tid & 31, part = tid >> 5; int pa = 0, pb = 0;
      for (int j = 0; j < 16; ++j) { const int b2 = part * 16 + j; const int c = CNT[b2 * 32 + e]; pa += c; pb += (b2 < blk) ? c : 0; }
      sm[part * 32 + e] = pa; sm[512 + part * 32 + e] = pb; }
    LDS_WAIT(); __syncthreads();
    if (tid < 32) { int ta = 0, tb2 = 0; for (int p = 0; p < 16; ++p) { ta += sm[p * 32 + tid]; tb2 += sm[512 + p * 32 + tid]; } sm[1024 + tid] = ta; sm[1088 + tid] = tb2; }
    LDS_WAIT(); __syncthreads();
    if (tid == 0) { int st = 0; for (int e = 0; e < 32; ++e) { sm[1152 + e] = st; st += (sm[1024 + e] + 255) & ~255; } sm[1152 + 32] = st; }
    LDS_WAIT(); __syncthreads();
    if (blk == 0 && tid < 33) TSTART[tid] = sm[1152 + tid] >> 8;
    if (tid < 256) { const int t = blk * 128 + (tid >> 1), k = tid & 1; const int er = ER[t * 2 + k]; const int e = er >> 16, rk = er & 0xffff;
        const int slot = sm[1152 + e] + sm[1088 + e] + rk; st_wt(TOK + slot, t * 2 + k); st_wt(RW + slot, WGT[t * 2 + k]); st_wt(RRS + slot, RS2[t]); RTO[slot] = hb_off + (unsigned)t * 2048u; }
    LDS_WAIT(); __syncthreads();
    if (blk < 32) { const int e = blk; const int p0 = sm[1152 + e] + sm[1024 + e], p1 = sm[1152 + e + 1];
        for (int r = p0 + tid; r < p1; r += NW * 64) { st_wt(TOK + r, -1); st_wt(RW + r, 0.f); st_wt(RRS + r, 0.f); RTO[r] = ZERO_OFF; } }
    __syncthreads();
}
__device__ __forceinline__ void combine_row(int t, int lane, const bf16_t* HbIn, const bf16_t* Y, bf16_t* HbOut) {
    const GAS u32x4* hi = (const GAS u32x4*)(HbIn + (size_t)t * DM) + lane; const GAS u32x4* y0 = (const GAS u32x4*)(Y + (size_t)t * DM) + lane; const GAS u32x4* y1 = (const GAS u32x4*)(Y + ((size_t)T + t) * DM) + lane;
    GAS u32x4* ho = (GAS u32x4*)(HbOut + (size_t)t * DM) + lane;
#pragma unroll
    for (int j = 0; j < 2; ++j) { const u32x4 h = hi[64 * j], a = y0[64 * j], b = y1[64 * j]; u32x4 o;
        o.x = pk2(bflo(h.x) + bflo(a.x) + bflo(b.x), bfhi(h.x) + bfhi(a.x) + bfhi(b.x)); o.y = pk2(bflo(h.y) + bflo(a.y) + bflo(b.y), bfhi(h.y) + bfhi(a.y) + bfhi(b.y));
        o.z = pk2(bflo(h.z) + bflo(a.z) + bflo(b.z), bfhi(h.z) + bfhi(a.z) + bfhi(b.z)); o.w = pk2(bflo(h.w) + bflo(a.w) + bflo(b.w), bfhi(h.w) + bfhi(a.w) + bfhi(b.w));
        ho[64 * j] = o; }
}
constexpr int NPHASE = 12;
__global__ void __launch_bounds__(NW * 64, 2) mk_fwd(Args a) {
    extern __shared__ __attribute__((aligned(16))) unsigned char lds[];
    Frame F; F.lds = (LAS unsigned char*)lds; F.ws = a.ws;
    F.tid = threadIdx.x; F.lane = F.tid & 63; F.wave = __builtin_amdgcn_readfirstlane(F.tid >> 6);
    F.G = gridDim.x; { const int bx = ((int)blockIdx.x + a.shift) % (int)gridDim.x; F.vcu = (F.G % 8 == 0) ? (bx % 8) * (F.G / 8) + bx / 8 : bx; }
    for (int u = F.tid; u < (LDS_BYTES - LDSCTL_OFF) / 4; u += NW * 64) ((LAS unsigned*)(F.lds + LDSCTL_OFF))[u] = 0u;
    __syncthreads();
    unsigned* ctl = (unsigned*)(a.ws + WS_CTL);
    const bool one_launch = (a.ph_hi - a.ph_lo > 1) || (a.l_hi - a.l_lo > 1);
    XcdBarrier bar; bar.bar = ctl + CW_BAR; bar.x = 0; bar.st = nullptr;
    if (one_launch) bar = xcd_barrier_post(ctl + CW_BAR, (volatile LAS unsigned*)(F.lds + LDSCTL_OFF) + 8);
#ifndef MK_REP
#define MK_REP 0
#endif
#define NREP(k) (((MK_REP >> (k)) & 1) ? 2 : 1)
#ifndef MK_TIMING
#define MK_TIMING 0
#endif
#if MK_TIMING
    unsigned long long* tsb = (unsigned long long*)(a.ws + 65536);
    if (blockIdx.x == 0 && threadIdx.x == 0) tsb[255] = __builtin_amdgcn_s_memrealtime();
#define STAMP(l_, ph_) do { if (blockIdx.x == 0 && threadIdx.x == 0) tsb[(l_) * 16 + (ph_)] = __builtin_amdgcn_s_memrealtime(); } while (0)
#else
#define STAMP(l_, ph_) do {} while (0)
#endif
#ifdef MK_DBLSEAM
#define SEAM() do { if (one_launch) { xcd_barrier(bar); xcd_barrier(bar); } } while (0)
#else
#define SEAM() do { if (one_launch) xcd_barrier(bar); } while (0)
#endif
#ifndef MK_PHMASK
#define MK_PHMASK 0xFFFF
#endif
#define FRESH(Fn) Frame Fn = F; { const int t_ = opaque_tid(); Fn.tid = t_; Fn.lane = t_ & 63; Fn.wave = __builtin_amdgcn_readfirstlane(t_ >> 6); }
#define INP(k) (((MK_PHMASK >> (k)) & 1) && (k) >= a.ph_lo && (k) < a.ph_hi)
    unsigned char* ws = a.ws;
    const int gw = F.vcu * NW + F.wave, NGW = F.G * NW;
    const int G = F.G; const int bx = ((int)blockIdx.x + a.shift) % G;
    float* H = a.out;
#define PHASE_PTRS unsigned char* ws = a.ws; asm volatile("" : "+s"(ws)); float* H = a.out; asm volatile("" : "+s"(H)); bf16_t* ZQ = (bf16_t*)(ws + WS_ZQ); bf16_t* ZKV = (bf16_t*)(ws + WS_ZKV); bf16_t* U = (bf16_t*)(ws + WS_U); bf16_t* VS = (bf16_t*)(ws + WS_VS); bf16_t* XS = (bf16_t*)(ws + WS_XS); bf16_t* Q = (bf16_t*)(ws + WS_Q); bf16_t* K = (bf16_t*)(ws + WS_K); bf16_t* V = (bf16_t*)(ws + WS_V); bf16_t* MIX = (bf16_t*)(ws + WS_MIX); bf16_t* XG = (bf16_t*)(ws + WS_XG); bf16_t* HBX = (bf16_t*)(ws + WS_HBX); bf16_t* Y01 = (bf16_t*)(ws + WS_Y01); bf16_t* PL = (bf16_t*)(ws + WS_PL); bf16_t* Pb = (bf16_t*)(ws + WS_PB); float* SS1 = (float*)(ws + WS_SS1); float* SS2 = (float*)(ws + WS_SS2); float* SSQ = (float*)(ws + WS_SSQ); float* SKV = (float*)(ws + WS_SKV); float* SQH = (float*)(ws + WS_SQH); float* SA = (float*)(ws + WS_SA); float* RS2 = (float*)(ws + WS_RS2); float* KR = (float*)(ws + WS_KR); float* E = (float*)(ws + WS_E); float* HS = (float*)(ws + WS_HS); const float* CS = (const float*)(ws + WS_COS); const float* SN = (const float*)(ws + WS_SIN); int* CNT = (int*)(ws + WS_ROUTE + RT_CNT); int* TSTART = (int*)(ws + WS_ROUTE + RT_TSTART); int* ER = (int*)(ws + WS_ROUTE + RT_ER); float* WGT = (float*)(ws + WS_ROUTE + RT_WGT); int* TOK = (int*)(ws + WS_ROUTE + RT_TOK); float* RW = (float*)(ws + WS_ROUTE + RT_W); float* RRS = (float*)(ws + WS_ROUTE + RT_RS);
    if (a.l_lo == 0 && INP(0)) for (int rep_ = 0; rep_ < NREP(0); ++rep_) { FRESH(Fp); p0_prologue(Fp, a); SEAM(); STAMP(0, 0); }

    for (int l = a.l_lo; l < a.l_hi; ++l) {
#define HbCur ((bf16_t*)(ws + ((l & 1) ? WS_HBB : WS_HBA)))
#define HbOth ((bf16_t*)(ws + ((l & 1) ? WS_HBA : WS_HBB)))
#define s5tb ((const unsigned char*)(ws + WS_S5T + (size_t)l * S5T_LAYER))
#define gmix (a.in[24] + (size_t)l * 1024)
        if (INP(1)) for (int rep_ = 0; rep_ < NREP(1); ++rep_) { PHASE_PTRS
            Gemm g{HbCur, (const bf16_t*)(ws + WS_WIN) + (size_t)l * 1536 * 1024, T, 1536, 1024}; pg8::StaticOrder So; So.init(T, 1536, G, bx);
            EpiIn Ei{SS1, ZQ, KR, ZKV, U, VS, XS, SSQ, SKV, a.in[10] + l * 256, a.in[11] + l * 256};
            PHASE_SYNC(); pg8::gemm_phase<EpiIn, pg8::StaticOrder, true, true>(F.lds, g, So, Ei);
            SEAM();
            STAMP(l, 1);
        }
        if (INP(2)) for (int rep_ = 0; rep_ < NREP(2); ++rep_) { PHASE_PTRS
#ifndef MK_SUB
#define MK_SUB 0xF
#endif
            if (MK_SUB & 1) { Gemm g{ZQ, (const bf16_t*)(ws + WS_WUQ) + (size_t)l * 1024 * 384, T, 1024, 384}; pg8::StaticOrder So; So.init(T, 1024, G, bx);
              EpiQ Eq{SSQ, Q, SQH}; PHASE_SYNC(); pg8::gemm_phase<EpiQ, pg8::StaticOrder, true, true>(F.lds, g, So, Eq); }
            if (MK_SUB & 2) { Gemm g{ZKV, (const bf16_t*)(ws + WS_WUKV) + (size_t)l * 1024 * 256, T, 1024, 256}; pg8::StaticOrder So; So.init(T, 1024, G, bx);
              EpiKV Ek{SKV, KR, a.in[9] + l * 96, CS, SN, K, V}; PHASE_SYNC(); pg8::gemm_phase<EpiKV, pg8::StaticOrder, true, true>(F.lds, g, So, Ek); }
            if (MK_SUB & 4) for (int task = bx; task < T / 64; task += G) { PHASE_SYNC(); FRESH(Fp); s5_pass1(Fp, task, XS, s5tb, E); }
            SEAM();
            STAMP(l, 2);
        }
        if (INP(3)) for (int rep_ = 0; rep_ < NREP(3); ++rep_) { PHASE_PTRS
            if (bx < 32) { PHASE_SYNC(); FRESH(Fp); s5_carry_seg(Fp, bx, s5tb, E, HS); }
            __syncthreads();
            bool generic;
            { const int ln = opaque_tid() & 63; const float* gq = a.in[8] + l * 96; const float* gk = a.in[9] + l * 96;
              float mq = fmaxf(fabsf(gq[ln]), ln < 32 ? fabsf(gq[64 + ln]) : 0.f), mk = fmaxf(fabsf(gk[ln]), ln < 32 ? fabsf(gk[64 + ln]) : 0.f);
#pragma unroll
              for (int o_ = 1; o_ < 64; o_ <<= 1) { mq = fmaxf(mq, shx(mq, o_)); mk = fmaxf(mk, shx(mk, o_)); }
              const float bound = 96.0f * mq * mk * att::C2; generic = __builtin_amdgcn_readfirstlane((int)(!(bound < 64.0f))) != 0; }
            for (int v = F.vcu; v < 256; v += G) { const int bh = v >> 4, s = v & 15;
#pragma unroll 1
                for (int i = 0; i < 4; ++i) { const int qb = (i == 0) ? 63 - s : (i == 1) ? 32 + s : (i == 2) ? 31 - s : s;
                    PHASE_SYNC(); if (generic) att::attn_unit(bh >> 3, bh & 7, qb, Q, SQH, a.in[8] + l * 96, CS, SN, K, V, MIX, SA, (char*)lds);
                    else att::attn_unit3(bh >> 3, bh & 7, qb, Q, SQH, a.in[8] + l * 96, CS, SN, K, V, MIX, SA, (char*)lds); } }
            SEAM();
            STAMP(l, 3);
        }
        if (INP(4)) { PHASE_PTRS
            for (int rep_ = 0; rep_ < NREP(4); ++rep_) {
            if (MK_SUB & 1) for (int task = bx; task < T / 64; task += G) { PHASE_SYNC(); FRESH(Fp); s5_pass3(Fp, task, XS, s5tb, HS, (const bf16_t*)(ws + WS_WGLU) + (size_t)l * 65536, a.in[23] + l * 256, gmix, MIX, SA); }
            if (MK_SUB & 2) for (int ci = bx; ci < T / 128; ci += G) { PHASE_SYNC(); FRESH(Fp); gmlp_unit(Fp, ci, U, VS, (const bf16_t*)(ws + WS_WSG) + (size_t)l * 65536, a.in[13] + l * 512, gmix, MIX, SA); }
            if (rep_ + 1 < NREP(4)) SEAM(); }
            SEAM();
            STAMP(l, 4);
        }
        if (INP(5)) { PHASE_PTRS
            Gemm g{MIX, (const bf16_t*)(ws + WS_WOUT) + (size_t)l * 1024 * 1024, T, 1024, 1024}; pg8::StaticOrder So; So.init(T, 1024, G, bx);
            EpiOut Eo{HbCur, HbOth, SS2, SA}; PHASE_SYNC(); pg8::gemm_phase<EpiOut, pg8::StaticOrder, true, true>(F.lds, g, So, Eo);
            SEAM();
            STAMP(l, 5);
        }
        if (INP(6)) for (int rep_ = 0; rep_ < NREP(6); ++rep_) { PHASE_PTRS
            for (int blk = bx; blk < 256; blk += G) { PHASE_SYNC(); FRESH(Fp); route_block(Fp, blk, HbOth, SS2, (const bf16_t*)(ws + WS_WR) + (size_t)l * 48 * 1024, a.in[28] + l * 4, a.in[30] + l * 32, RS2, CNT, ER, WGT); }
            SEAM();
            STAMP(l, 6);
        }
        if (INP(7)) for (int rep_ = 0; rep_ < NREP(7); ++rep_) { PHASE_PTRS
            for (int blk = bx; blk < 256; blk += G) { PHASE_SYNC(); FRESH(Fp); scatter_block(Fp, blk, (unsigned)((l & 1) ? WS_HBA : WS_HBB), RS2, CNT, ER, WGT, TSTART, TOK, RW, RRS, (unsigned*)(ws + WS_ROUTE + RT_RTO)); }
            SEAM();
            STAMP(l, 7);
        }
        if (INP(8)) for (int rep_ = 0; rep_ < NREP(8); ++rep_) { PHASE_PTRS
            const bool ovl = a.pad != 0; const int par = ovl ? (l & 1) : 0;
            Gemm g{(const bf16_t*)ws, (const bf16_t*)(ws + (par ? WS_W13B : WS_W13)), NPMAX, 32 * 512, 1024}; MoeOrder<2> Mo; Mo.init(TSTART, G, F.vcu);
            EpiM1 Em{RRS, HBX}; PHASE_SYNC(); pg8::gemm_phase_g<EpiM1, MoeOrder<2>, true, true>(F.lds, g, Mo, Em, (const unsigned*)(ws + WS_ROUTE + RT_RTO));
            if (ovl && l + 1 < NL) { const int nt = Mo.total, r = nt % G; const int L = r ? G - r : G, j = r ? F.vcu - r : F.vcu;
                if (j >= 0) { FRESH(Fp); conv_moe_layer(Fp, j * NW + Fp.wave, L * NW, a, l + 1, (l + 1) & 1); } }
            SEAM();
            STAMP(l, 8);
        }
        if (INP(9)) for (int rep_ = 0; rep_ < NREP(9); ++rep_) { PHASE_PTRS
            const bool ovl = a.pad != 0; const int par = ovl ? (l & 1) : 0;
            Gemm g{HBX, (const bf16_t*)(ws + (par ? WS_W2TB : WS_W2T)), NPMAX, 32 * 1024, 256}; MoeOrder<4> Mo; Mo.init(TSTART, G, F.vcu);
            EpiM2 Em{TOK, RW, Y01}; PHASE_SYNC(); pg8::gemm_phase<EpiM2, MoeOrder<4>, true, true>(F.lds, g, Mo, Em);
            if (ovl) { const int nt = Mo.total, r = nt % G; const int L = r ? G - r : G, j = r ? F.vcu - r : F.vcu;
                if (j >= 0) { FRESH(Fp); conv_p_layer(Fp, j * NW + Fp.wave, L * NW, a, l); } }
            SEAM();
            STAMP(l, 9);
        }
        if (INP(10)) { PHASE_PTRS
            FRESH(Fp); const int gwp = Fp.vcu * NW + Fp.wave;
            for (int t = gwp; t < T; t += NGW) combine_row(t, Fp.lane, HbOth, Y01, HbCur);
            if (a.pad == 0) { conv_p_layer(Fp, gwp, NGW, a, l);
                if (l + 1 < NL) conv_moe_layer(Fp, gwp, NGW, a, l + 1); }
            SEAM();
            STAMP(l, 10);
        }
        if (INP(11)) { PHASE_PTRS
            if (MK_SUB & 1) { Gemm g{Pb, (const bf16_t*)(ws + WS_WPLE) + (size_t)l * 1024 * 256, T, 1024, 256}; pg8::StaticOrder So; So.init(T, 1024, G, bx);
              EpiPl Ep{PL}; PHASE_SYNC(); pg8::gemm_phase<EpiPl, pg8::StaticOrder, true, true>(F.lds, g, So, Ep); }
            if (MK_SUB & 2) { Gemm g{HbCur, (const bf16_t*)(ws + WS_WPG) + (size_t)l * 1024 * 1024, T, 1024, 1024}; pg8::StaticOrder So; So.init(T, 1024, G, bx);
              EpiGate Eg{HbCur, PL, a.in[35] + l * 1024, HbOth, SS1, (l + 1 == NL) ? H : nullptr}; PHASE_SYNC(); pg8::gemm_phase<EpiGate, pg8::StaticOrder, true, true>(F.lds, g, So, Eg); }
            if (l + 1 < a.l_hi) SEAM();
            STAMP(l, 11);
        }
    }
#undef SEAM
#undef INP
}
}
#if DBG && DBG != 100
namespace dbg {
constexpr int NT = 1024;
constexpr size_t WS_ORACLE = 640ull << 20;
__global__ void k_cmp(const void* f, int isbf, size_t f_rs, size_t f_off, const float* r, size_t r_rs, size_t r_off, int rows, int cols, int* res) {
    const int row = blockIdx.x * (blockDim.x >> 6) + (threadIdx.x >> 6), lane = threadIdx.x & 63;
    if (row >= rows) return;
    float sd = 0.f, sr = 0.f;
    for (int c = lane; c < cols; c += 64) {
        const float rv = r[(size_t)row * r_rs + r_off + c];
        float fv;
        if (isbf) { const unsigned short b = ((const unsigned short*)f)[(size_t)row * f_rs + f_off + c]; fv = __builtin_bit_cast(float, (unsigned)b << 16); }
        else fv = ((const float*)f)[(size_t)row * f_rs + f_off + c];
        const float d = fv - rv; sd += d * d; sr += rv * rv;
    }
    sd = nv::wsum(sd); sr = nv::wsum(sr);
    if (lane == 0) { const float rel = sqrtf(sd / fmaxf(sr, 1e-30f)); const int bad = (rel <= 0.05f) ? 0 : 1; atomicAdd(res, bad); atomicAdd(res + 1, 1); }
}
__global__ void k_cmpw(const unsigned short* Wt, const float* w_in, const float* ln1, int* res) {
    const int n = blockIdx.x * (blockDim.x >> 6) + (threadIdx.x >> 6), lane = threadIdx.x & 63;
    if (n >= 64) return;
    float sd = 0.f, sr = 0.f;
    for (int k = lane; k < 1024; k += 64) { const float rv = w_in[(size_t)k * 1440 + n] * ln1[k]; const float fv = __builtin_bit_cast(float, (unsigned)Wt[(size_t)n * 1024 + k] << 16); const float d = fv - rv; sd += d * d; sr += rv * rv; }
    sd = nv::wsum(sd); sr = nv::wsum(sr);
    if (lane == 0) { const float rel = sqrtf(sd / fmaxf(sr, 1e-30f)); atomicAdd(res, (rel <= 0.05f) ? 0 : 1); atomicAdd(res + 1, 1); }
}
__global__ void k_encode(const int* res, int ncodes, const float* x, float* out, size_t n) {
    int code = 0;
    for (int c = 1; c < ncodes; ++c) { const int bad = res[2 * c], tot = res[2 * c + 1]; if (tot > 0 && bad * 20 > tot) { code = c; break; } }
    if (code == 0) return;
    int mask = 0;
    for (int j = 0; j < 6 && code + j < ncodes; ++j) { const int bad = res[2 * (code + j)], tot = res[2 * (code + j) + 1]; if (tot > 0 && bad * 20 > tot) mask |= 1 << j; }
    const float sc = 1.0f + 10.0f * (float)code;
    for (size_t i = (size_t)blockIdx.x * blockDim.x + threadIdx.x; i < n; i += (size_t)gridDim.x * blockDim.x) out[i] = (i == 0) ? 1000.0f * (float)mask : x[i] * sc;
}
static void cmp(hipStream_t st, int* res, int code, const void* f, int isbf, size_t f_rs, size_t f_off, const float* r, size_t r_rs, size_t r_off, int cols) {
    hipLaunchKernelGGL(k_cmp, dim3((NT + 3) / 4), dim3(256), 0, st, f, isbf, f_rs, f_off, r, r_rs, r_off, NT, cols, res + 2 * code);
}
}
#endif


#if DBG == 100
namespace dh {
constexpr int NREP = 12, NBUF = 32;
__global__ void k_hash(const unsigned* p, size_t rows, size_t rs, size_t c0, size_t c1, unsigned long long* out) {
    unsigned long long acc = 0ull; const size_t w = c1 - c0, n = rows * w;
    for (size_t i = (size_t)blockIdx.x * blockDim.x + threadIdx.x; i < n; i += (size_t)gridDim.x * blockDim.x) { const size_t r = i / w, c = c0 + i % w; acc += (unsigned long long)p[r * rs + c] * (2ull * i + 1ull); }
    for (int o = 32; o >= 1; o >>= 1) acc += __shfl_xor(acc, o);
    if ((threadIdx.x & 63) == 0) atomicAdd(out, acc);
}
__global__ void __launch_bounds__(512) k_scrub(unsigned pat, unsigned* sink) {
    extern __shared__ unsigned sl[];
    for (int i = threadIdx.x; i < 163840 / 4 - 64; i += 512) sl[i] = pat + (unsigned)i * 0u;
    __syncthreads();
    if (sl[threadIdx.x] == 0x12345u) sink[0] = 1u;
}
__global__ void k_nancnt(const unsigned short* p, size_t rows, size_t rs, size_t c0, size_t c1, unsigned* out) {
    unsigned c = 0; const size_t w = c1 - c0, n = rows * w;
    for (size_t i = (size_t)blockIdx.x * blockDim.x + threadIdx.x; i < n; i += (size_t)gridDim.x * blockDim.x) { const unsigned short v = p[(i / w) * rs + c0 + i % w]; c += ((v & 0x7F80u) == 0x7F80u && (v & 0x7Fu)) ? 1u : 0u; }
    if (c) atomicAdd(out, c);
}
__global__ void k_nanenc(const unsigned* cnt, const float* x, float* out, size_t n) {
    const int code = cnt[0] ? 1 : (cnt[1] ? 2 : (cnt[2] ? 3 : 0));
    const float sc = 1.0f + (float)code;
    for (size_t i = (size_t)blockIdx.x * blockDim.x + threadIdx.x; i < n; i += (size_t)gridDim.x * blockDim.x) out[i] = x[i] * sc;
}
__global__ void k_encode(const unsigned long long* tab, int nbuf, const float* x, float* out, size_t n) {
    int code = 0, mask = 0;
    for (int b = 1; b <= nbuf; ++b) { bool diff = false; for (int r = 1; r < NREP; ++r) diff |= tab[b * 16 + r] != tab[b * 16];
        if (diff && code == 0) code = b; }
    int code2 = 0;
    for (int b = 1; b <= nbuf; ++b) { bool diff = false; for (int r = 0; r < NREP; ++r) { const int base = (r & 1) ? 1 : ((r & 2) ? 2 : 0); diff |= tab[b * 16 + r] != tab[b * 16 + base]; }
        if (diff && code2 == 0) code2 = b; }
    const float sc = 1.0f + (float)code, sc2 = 1.0f + (float)code2;
    for (size_t i = (size_t)blockIdx.x * blockDim.x + threadIdx.x; i < n; i += (size_t)gridDim.x * blockDim.x) out[i] = x[i] * ((i < n / 2) ? sc : sc2);
}
__global__ void k_diff(const unsigned* D, size_t stride, size_t n, int nrep, unsigned* res) {
    for (size_t i = (size_t)blockIdx.x * blockDim.x + threadIdx.x; i < n; i += (size_t)gridDim.x * blockDim.x) { const unsigned ref = D[(size_t)(nrep - 1) * stride + i];
        for (int r = 0; r < nrep - 1; ++r) { const bool d = D[(size_t)r * stride + i] != ref; if (d) { atomicAdd(&res[0], 1u); atomicAdd(&res[1 + r], 1u); } } }
}
__global__ void k_diffenc(const unsigned* res, const unsigned long long* tab, int nbuf, const float* x, float* out, size_t n) {
    const unsigned cd = res[0]; int code = 0;
    for (int b = 1; b <= nbuf; ++b) { bool diff = false; for (int r = 1; r < NREP; ++r) diff |= tab[b * 16 + r] != tab[b * 16]; if (diff && code == 0) code = b; }
    int nd = 0; for (int r = 0; r < NREP - 1; ++r) nd += res[1 + r] ? 1 : 0;
#ifndef MK_ENC_ND
#define MK_ENC_ND 0
#endif
    const float sc = 1.0f + (float)code + 0.04f * (MK_ENC_ND ? (float)nd : (cd ? (float)(32 - __clz(cd)) : 0.0f));
    for (size_t i = (size_t)blockIdx.x * blockDim.x + threadIdx.x; i < n; i += (size_t)gridDim.x * blockDim.x) out[i] = x[i] * sc;
}
__global__ void k_cntenc(const unsigned* cnt, const float* x, float* out, size_t n) {
    const unsigned c = cnt[0]; const float sc = 1.0f + (c ? (float)(32 - __clz(c)) : 0.0f);
    for (size_t i = (size_t)blockIdx.x * blockDim.x + threadIdx.x; i < n; i += (size_t)gridDim.x * blockDim.x) out[i] = x[i] * sc;
}
}
#endif

#if MK_TIMING
__global__ void k_tsenc(const unsigned long long* tsb, unsigned maskA, unsigned maskB, const float* x, float* out, size_t n) {
    float dA = 0.f, dB = 0.f;
    for (int l = 0; l < 4; ++l) for (int ph = (l == 0 ? 0 : 1); ph < 12; ++ph) {
        unsigned long long prev = (ph == 0) ? tsb[255] : ((ph == 1 && l > 0) ? tsb[(l - 1) * 16 + 11] : tsb[l * 16 + ph - 1]);
        const float d = (float)(tsb[l * 16 + ph] - prev) * 0.01f;
        if ((maskA >> ph) & 1) dA += d; if ((maskB >> ph) & 1) dB += d; }
    const float sA = 1.0f + rintf(logf(fmaxf(dA, 1.0f)) * (1.0f / 0.0392207f)), sB = 1.0f + rintf(logf(fmaxf(dB, 1.0f)) * (1.0f / 0.0392207f));
    for (size_t i = (size_t)blockIdx.x * blockDim.x + threadIdx.x; i < n; i += (size_t)gridDim.x * blockDim.x) out[i] = x[i] * ((i < n / 2) ? sA : sB);
}
#endif
extern "C" void kernel_launch(void* const* d_in, const int* in_sizes, int n_in, void* d_out, int out_size, void* d_ws, size_t ws_size, hipStream_t stream) {
    using namespace mk;
    static int grid = 0;
    if (grid == 0) {
        size_t need = WS_END;
#if DBG && DBG != 100
        need = dbg::WS_ORACLE + (size_t)dbg::NT * 4096 + nv::bufs_bytes_noalias(dbg::NT);
#endif
        if (n_in != 37 || out_size != T * DM || ws_size < need) { fprintf(stderr, "kernel_launch: n_in %d out %d ws %zu (need %zu): nothing launched\n", n_in, out_size, ws_size, need); grid = -1; return; }
        int dev = 0, cus = 0, per_cu = 0;
        if (hipGetDevice(&dev) != hipSuccess || hipDeviceGetAttribute(&cus, hipDeviceAttributeMultiprocessorCount, dev) != hipSuccess) { grid = -1; return; }
        if (hipFuncSetAttribute((const void*)mk_fwd, hipFuncAttributeMaxDynamicSharedMemorySize, LDS_BYTES) != hipSuccess) { fprintf(stderr, "kernel_launch: hipFuncSetAttribute failed\n"); grid = -1; return; }
        if (hipOccupancyMaxActiveBlocksPerMultiprocessor(&per_cu, (const void*)mk_fwd, NW * 64, LDS_BYTES) != hipSuccess || per_cu < 1) fprintf(stderr, "kernel_launch: occupancy query says %d\n", per_cu);
        (void)hipGetLastError();
        grid = cus;
    }
    if (grid < 0) return;
    (void)hipMemsetAsync((char*)d_ws + WS_CTL, 0, CTL_ZERO_BYTES, stream);
    Args a{};
    for (int i = 0; i < 37; ++i) a.in[i] = (const float*)d_in[i];
    a.out = (float*)d_out; a.ws = (unsigned char*)d_ws;
#if DBG == 100
    {
        unsigned char* ws = (unsigned char*)d_ws;
        unsigned long long* tab = (unsigned long long*)(ws + (640ull << 20));
        (void)hipMemsetAsync(tab, 0, 64 * 16 * 8, stream);
        struct HB { size_t off; size_t rows, rs, c0, c1; bool out; };
        const size_t TT = T;
        const HB list[] = { {0, 0, 0, 0, 0, false},
            {WS_XS, TT, 128, 0, 128, false}, {WS_HS, 512 * 16, 128, 0, 128, false},
#if MK_S5_V2 == 7
            {(666ull << 20), 512 * 16, 128, 0, 64, false}, {(666ull << 20), 512 * 16, 128, 64, 128, false}, {(650ull << 20), 512 * 32, 64, 0, 64, false},
            {(654ull << 20), 512 * 16, 128, 0, 64, false}, {(658ull << 20), 512 * 16, 128, 0, 64, false}, {(642ull << 20), 512 * 16, 128, 0, 64, false}, {(662ull << 20), 512 * 16, 128, 0, 64, false},
            {(654ull << 20), 512 * 16, 128, 64, 128, false}, {(658ull << 20), 512 * 16, 128, 64, 128, false}, {(642ull << 20), 512 * 16, 128, 64, 128, false}, {(662ull << 20), 512 * 16, 128, 64, 128, false}, {WS_MIX, TT, 512, 384, 512, false} };
#elif MK_S5_V2 == 6
            {(650ull << 20), 512 * 16, 64, 0, 64, false}, {(666ull << 20), 512 * 32, 64, 0, 64, false}, {WS_MIX, TT, 512, 384, 512, false} };
#else
            {(650ull << 20), TT, 128, 0, 128, false}, {(666ull << 20), TT, 128, 0, 128, false}, {WS_MIX, TT, 512, 384, 512, false} };
#endif
        const int nbuf = (int)(sizeof(list) / sizeof(list[0])) - 1;
        const size_t M = 1ull << 20;
        (void)hipMemsetAsync(ws + (650ull << 20), 0, 256, stream); (void)hipMemsetAsync(ws + (649ull << 20), 0, 256, stream);
        for (int rep = 0; rep < dh::NREP; ++rep) {
            (void)hipMemsetAsync(ws + WS_CTL, 0, CTL_ZERO_BYTES, stream);
#if MK_S5_V2 == 7
            (void)hipMemsetAsync(ws + M, 0xAA, 537 * M, stream);
#else
            (void)hipMemsetAsync(ws + M, 0xAA, 633 * M, stream);
#endif
            (void)hipMemsetAsync(d_out, 0xAA, (size_t)T * DM * 4, stream);
            a.l_lo = 0; a.l_hi = 1; a.ph_lo = 0; a.ph_hi = 6; a.shift = (rep & 1) ? 37 : ((rep & 2) ? 101 : 0);
#ifdef MK_SPLIT
            for (int ph = 0; ph < 6; ++ph) { a.ph_lo = ph; a.ph_hi = ph + 1; hipLaunchKernelGGL(mk_fwd, dim3(grid), dim3(NW * 64), LDS_BYTES, stream, a); }
#else
            hipLaunchKernelGGL(mk_fwd, dim3(grid), dim3(NW * 64), LDS_BYTES, stream, a);
#endif
            for (int b = 1; b <= nbuf; ++b) { const HB& h = list[b];
                const unsigned* p = h.out ? (const unsigned*)d_out : (const unsigned*)(ws + h.off);
                hipLaunchKernelGGL(dh::k_hash, dim3(1024), dim3(256), 0, stream, p, h.rows, h.rs, h.c0, h.c1, tab + b * 16 + rep); }
#if MK_S5_V2 == 7
            (void)hipMemcpyAsync(ws + (538ull << 20) + (size_t)rep * 4 * M, ws + (658ull << 20), 4 * M, hipMemcpyDeviceToDevice, stream);
#endif
        }
#if MK_S5_V2 == 7
        (void)hipMemsetAsync(ws + (650ull << 20), 0, 256, stream);
        hipLaunchKernelGGL(dh::k_diff, dim3(1024), dim3(256), 0, stream, (const unsigned*)(ws + (538ull << 20)), (size_t)(4 * M / 4), (size_t)(4 * M / 4), dh::NREP, (unsigned*)(ws + (650ull << 20)));
        hipLaunchKernelGGL(dh::k_diffenc, dim3(1024), dim3(256), 0, stream, (const unsigned*)(ws + (650ull << 20)), tab, nbuf, (const float*)d_in[0], (float*)d_out, (size_t)T * DM);
#elif MK_S5_V2 == 8
        hipLaunchKernelGGL(dh::k_cntenc, dim3(1024), dim3(256), 0, stream, (const unsigned*)(ws + (650ull << 20)), (const float*)d_in[0], (float*)d_out, (size_t)T * DM);
#else
        hipLaunchKernelGGL(dh::k_encode, dim3(1024), dim3(256), 0, stream, tab, nbuf, (const float*)d_in[0], (float*)d_out, (size_t)T * DM);
#endif
        return;
    }
#endif
#if !DBG
#ifdef MK_PROBE_WS
    if (ws_size < WS_END2) return;
#endif
    a.l_lo = 0; a.l_hi = NL; a.ph_lo = 0; a.ph_hi = NPHASE; a.pad = (ws_size >= WS_END2) ? 1 : 0;
#ifdef MK_PROBE_NOOVL
    a.pad = 0;
#endif
    hipLaunchKernelGGL(mk_fwd, dim3(grid), dim3(NW * 64), LDS_BYTES, stream, a);
#if MK_TIMING
    hipLaunchKernelGGL(k_tsenc, dim3(1024), dim3(256), 0, stream, (const unsigned long long*)((unsigned char*)d_ws + 65536), (unsigned)MK_TS_A, (unsigned)MK_TS_B, (const float*)d_in[0], (float*)d_out, (size_t)T * DM);
#endif
#elif DBG != 100
    using dbg::NT;
    unsigned char* ws = (unsigned char*)d_ws;
    int* res = (int*)(ws + 32768);
    float* Hn = (float*)(ws + dbg::WS_ORACLE);
    nv::Bufs Bn = nv::carve_noalias(Hn, (char*)ws + dbg::WS_ORACLE + (size_t)NT * 4096, NT);
    (void)hipMemcpyAsync(Hn, d_in[0], (size_t)NT * 4096, hipMemcpyDeviceToDevice, stream);
    a.l_lo = 0; a.l_hi = 1; a.ph_lo = 0; a.ph_hi = 1;
    hipLaunchKernelGGL(mk_fwd, dim3(grid), dim3(NW * 64), LDS_BYTES, stream, a);
    dbg::cmp(stream, res, 1, d_out, 0, 1024, 0, (const float*)d_in[0], 1024, 0, 1024);
    dbg::cmp(stream, res, 2, ws + WS_HBA, 1, 1024, 0, (const float*)d_in[0], 1024, 0, 1024);
    hipLaunchKernelGGL(dbg::k_cmpw, dim3(16), dim3(256), 0, stream, (const unsigned short*)(ws + WS_WIN), (const float*)d_in[3], (const float*)d_in[2], res + 2 * 3);
    const int DBG_LAYERS = DBG;
    for (int l = 0; l < NL; ++l) {
        if (l < DBG_LAYERS) nv::layer(stream, d_in, l, Bn, 1, NT);
        for (int ph = 1; ph < NPHASE; ++ph) {
            a.l_lo = l; a.l_hi = l + 1; a.ph_lo = ph; a.ph_hi = ph + 1;
            hipLaunchKernelGGL(mk_fwd, dim3(grid), dim3(NW * 64), LDS_BYTES, stream, a);
            if (l >= DBG_LAYERS) continue;
            const int cb = l * 20 + 3;
            if (ph == 1) {
                dbg::cmp(stream, res, cb + 1, ws + WS_ZQ, 1, 384, 0, Bn.Z, 1440, 0, 384);
                dbg::cmp(stream, res, cb + 2, ws + WS_ZKV, 1, 256, 0, Bn.Z, 1440, 384, 256);
                dbg::cmp(stream, res, cb + 3, ws + WS_KR, 0, 32, 0, Bn.Z, 1440, 640, 32);
                dbg::cmp(stream, res, cb + 4, ws + WS_U, 1, 256, 0, Bn.U, 256, 0, 256);
                dbg::cmp(stream, res, cb + 5, ws + WS_VS, 1, 256, 0, Bn.VS, 256, 0, 256);
                dbg::cmp(stream, res, cb + 6, ws + WS_XS, 1, 256, 0, Bn.Z, 1440, 1184, 256);
            } else if (ph == 2) {
                for (int h = 0; h < 8; ++h) { dbg::cmp(stream, res, cb + 7, ws + WS_K, 1, 96, (size_t)h * S * 96, Bn.K, 768, h * 96, 96);
                    dbg::cmp(stream, res, cb + 8, ws + WS_V, 1, 64, (size_t)h * S * 64, Bn.KV, 1024, h * 128 + 64, 64); }
            } else if (ph == 3) {
                dbg::cmp(stream, res, cb + 9, ws + WS_MIX, 1, 1024, 0, Bn.A, 512, 0, 512);
            } else if (ph == 4) {
                dbg::cmp(stream, res, cb + 10, ws + WS_MIX, 1, 1024, 0, Bn.SNAP_MIX, 1024, 0, 512);
                dbg::cmp(stream, res, cb + 11, ws + WS_MIX, 1, 1024, 512, Bn.SNAP_MIX, 1024, 512, 256);
                dbg::cmp(stream, res, cb + 12, ws + WS_MIX, 1, 1024, 768, Bn.SNAP_MIX, 1024, 768, 256);
            } else if (ph == 5) {
                dbg::cmp(stream, res, cb + 13, d_out, 0, 1024, 0, Bn.SNAP_HMID, 1024, 0, 1024);
            } else if (ph == 10) {
                dbg::cmp(stream, res, cb + 14, d_out, 0, 1024, 0, Bn.SNAP_HMOE, 1024, 0, 1024);
            } else if (ph == 11) {
                dbg::cmp(stream, res, cb + 15, d_out, 0, 1024, 0, Hn, 1024, 0, 1024);
            }
        }
    }
    hipLaunchKernelGGL(dbg::k_encode, dim3(1024), dim3(256), 0, stream, res, 64, (const float*)d_in[0], (float*)d_out, (size_t)T * DM);
#endif
}
```

```cpp
#define DBG 0
#define MK_ATT_PRIO 1
#ifndef DBG
#define DBG 0
#endif
#ifndef MK_STRONG_BAR
#define MK_STRONG_BAR 0
#endif
#ifndef MK_BAR_SCOPE
#define MK_BAR_SCOPE "agent"
#endif
#ifndef MK_S5_ZERO
#define MK_S5_ZERO 4
#endif
#ifndef MK_S5_SCRUB
#define MK_S5_SCRUB 0
#endif
#ifndef MK_S5_V1
#define MK_S5_V1 0
#endif
#ifndef MK_S5_V2
#define MK_S5_V2 0
#endif
#ifndef MK_BAR_EARLY_REL
#define MK_BAR_EARLY_REL 0
#endif
#ifndef MK_ATT_PRIO
#define MK_ATT_PRIO 1
#endif
#ifndef MK_S5_SCALAR
#define MK_S5_SCALAR 1
#endif
#ifndef MK_ACQ_SCOPE
#define MK_ACQ_SCOPE "agent"
#endif
#include <hip/hip_runtime.h>
#include <hip/hip_bf16.h>
#include <cstdio>
#include <cstdint>
#include <cmath>
#define LAS __attribute__((address_space(3)))
__device__ __forceinline__ int opaque_tid() { int t = (int)threadIdx.x; asm volatile("" : "+v"(t)); return t; }
namespace pg8 {
#define PG8_LAS __attribute__((address_space(3)))
typedef unsigned short bf16_t;
typedef short bf16x8 __attribute__((ext_vector_type(8)));
typedef float f32x4 __attribute__((ext_vector_type(4)));
typedef unsigned u32x4 __attribute__((ext_vector_type(4)));
constexpr int BM = 256, BK = 64, HALF = 128, HTB = HALF * BK * 2  , STAGE_BYTES = 8 * HTB, NXCD = 8, WGM = 8;

__host__ __device__ __forceinline__ int lds_byte(int r, int c) { const int st = (r >> 4) * 2 + (c >> 5), rr = r & 15, cc = c & 31, ob = rr * 64 + cc * 2; return st * 1024 + (ob ^ (((ob >> 9) & 1) << 5)); }
__host__ __device__ __forceinline__ void stage_rc(int b, int& R, int& C) { const int st = b / 1024, sb = b % 1024, swz = sb ^ (((sb >> 9) & 1) << 5); R = (st >> 1) * 16 + swz / 64; C = (st & 1) * 32 + (swz % 64) / 2; }
__host__ __device__ __forceinline__ int perm32(int rho) { const int n = rho >> 4, i = rho & 15; return 8 * (i >> 2) + 4 * n + (i & 3); }

struct Unit { int pm, pn; };
struct Gemm { const bf16_t* A; const bf16_t* Bt; int M, N, K; };

struct StaticOrder {
    int nM, nN, nwg, G, c;
    __host__ __device__ void init(int M, int N, int G_, int c_) { nM = M / BM; nN = N / BM; nwg = nM * nN; G = G_; c = c_; }
    __host__ __device__ bool next(int i, Unit& u) const {
        const long L = (long)i * G + c; if (L >= nwg) return false;
        int wgid = (int)L; { const int q = nwg / NXCD, r = nwg % NXCD, xcd = wgid % NXCD, off = wgid / NXCD; wgid = (xcd < r ? xcd * (q + 1) : r * (q + 1) + (xcd - r) * q) + off; }
        const int nig = WGM * nN, gid = wgid / nig, fm = gid * WGM, gsz = (nM - fm) < WGM ? (nM - fm) : WGM;
        u.pm = fm + ((wgid % nig) % gsz); u.pn = (wgid % nig) / gsz; return true;
    }
    __device__ __forceinline__ void a_ready(const Unit&) const {}
    __device__ __forceinline__ void done(const Unit&) const {}
};

__device__ __forceinline__ unsigned cvt_pk_bf16(float lo, float hi) { unsigned r; asm volatile("v_cvt_pk_bf16_f32 %0, %1, %2" : "=v"(r) : "v"(lo), "v"(hi)); return r; }
typedef float f32x2 __attribute__((ext_vector_type(2)));
template <class Epi, class Sched, bool ALIGN_EPI = false, bool SP2 = false>
__device__ __forceinline__ void gemm_phase(PG8_LAS unsigned char* lds, const Gemm g, const Sched& S, const Epi& E) {
    const int tid = opaque_tid(), wid = __builtin_amdgcn_readfirstlane(tid >> 6), lane = tid & 63, wr = wid >> 2, wc = wid & 3, fr = lane & 15, fq = lane >> 4;
    const int K = g.K, nt = K / BK;
    unsigned voffA[2], voffB[2];
#pragma unroll
    for (int i = 0; i < 2; ++i) { int R, C; stage_rc(tid * 16 + i * 8192, R, C); const int Rb = Epi::PERM ? ((R & ~31) + perm32(R & 31)) : R;
        voffA[i] = (unsigned)(R * K + C) * 2u; voffB[i] = (unsigned)(Rb * K + C) * 2u; }
    const size_t kstep = (size_t)(BK * 2);
    const size_t hstep = (size_t)HALF * K * 2;
    const size_t tstep = 2 * hstep;
    const unsigned ldsw = (unsigned)wid * 1024u;
    const int aoff = lds_byte(wr * 64 + fr, fq * 8), boff = lds_byte(wc * 32 + fr, fq * 8);
#define PG8_SA(b, h) (((b) * 2 + (h)) * HTB)
#define PG8_SB(b, h) ((4 + (b) * 2 + (h)) * HTB)
#define PG8_STAGE(bufoff, gbase, voff) do { _Pragma("unroll") for (int _i = 0; _i < 2; ++_i) \
        __builtin_amdgcn_global_load_lds((const unsigned*)((const char*)(gbase) + (voff)[_i]), (PG8_LAS unsigned*)(lds + (bufoff) + ldsw + _i * 8192), 16, 0, 0); } while (0)
#define PG8_LDA(dst, b, h) do { _Pragma("unroll") for (int m = 0; m < 4; ++m) _Pragma("unroll") for (int k = 0; k < 2; ++k) dst[m][k] = *(const PG8_LAS bf16x8*)(lds + PG8_SA(b, h) + aoff + m * 2048 + k * 1024); } while (0)
#define PG8_LDB(dst, b, h) do { _Pragma("unroll") for (int n = 0; n < 2; ++n) _Pragma("unroll") for (int k = 0; k < 2; ++k) dst[n][k] = *(const PG8_LAS bf16x8*)(lds + PG8_SB(b, h) + boff + n * 2048 + k * 1024); } while (0)
#define PG8_MMA(ai, bj, At, Bt) do { __builtin_amdgcn_s_setprio(1); _Pragma("unroll") for (int m = 0; m < 4; ++m) _Pragma("unroll") for (int n = 0; n < 2; ++n) _Pragma("unroll") for (int k = 0; k < 2; ++k) \
        acc[ai][bj][m][n] = __builtin_amdgcn_mfma_f32_16x16x32_bf16(Bt[n][k], At[m][k], acc[ai][bj][m][n], 0, 0, 0); __builtin_amdgcn_s_setprio(0); } while (0)
#define PG8_WAIT_V(n) asm volatile("s_waitcnt vmcnt(" #n ")" ::: "memory")
#define PG8_WAIT_L(n) asm volatile("s_waitcnt lgkmcnt(" #n ")" ::: "memory")
#define PG8_BAR __builtin_amdgcn_s_barrier()
#define PG8_SCHED __builtin_amdgcn_sched_barrier(0)
    Unit cur, nxt; int ui = 0;
    if (!S.next(0, cur)) return;
    f32x4 acc[2][2][4][2];
#pragma unroll
    for (int a = 0; a < 2; ++a)
#pragma unroll
        for (int b = 0; b < 2; ++b)
#pragma unroll
            for (int m = 0; m < 4; ++m)
#pragma unroll
                for (int n = 0; n < 2; ++n) acc[a][b][m][n] = (f32x4){0.f, 0.f, 0.f, 0.f};
    bf16x8 At[4][2], B0[2][2], B1[2][2];
    const char* cA = (const char*)g.A + (size_t)cur.pm * tstep; const char* cB = (const char*)g.Bt + (size_t)cur.pn * tstep;
    S.a_ready(cur);
    if constexpr (SP2) {
        PG8_STAGE(PG8_SB(0, 0), cB, voffB); PG8_STAGE(PG8_SB(0, 1), cB + hstep, voffB); PG8_STAGE(PG8_SA(0, 0), cA, voffA); PG8_STAGE(PG8_SA(0, 1), cA + hstep, voffA);
        if (wr == 1) PG8_BAR;
        PG8_WAIT_V(2); PG8_BAR;
        PG8_STAGE(PG8_SB(1, 0), cB + kstep, voffB); PG8_STAGE(PG8_SA(1, 0), cA + kstep, voffA); PG8_STAGE(PG8_SB(1, 1), cB + hstep + kstep, voffB);
        PG8_WAIT_V(6); PG8_BAR;
    } else {
        PG8_STAGE(PG8_SB(0, 0), cB, voffB); PG8_STAGE(PG8_SA(0, 0), cA, voffA); PG8_STAGE(PG8_SB(0, 1), cB + hstep, voffB); PG8_STAGE(PG8_SA(0, 1), cA + hstep, voffA);
        if (wr == 1) PG8_BAR;
        PG8_WAIT_V(4); PG8_BAR;
        PG8_STAGE(PG8_SB(1, 0), cB + kstep, voffB); PG8_STAGE(PG8_SA(1, 0), cA + kstep, voffA); PG8_STAGE(PG8_SB(1, 1), cB + hstep + kstep, voffB);
        PG8_WAIT_V(6); PG8_BAR;
    }
    for (;;) {
        const bool has_next = S.next(ui + 1, nxt);
        const char* nA = has_next ? (const char*)g.A + (size_t)nxt.pm * tstep : cA; const char* nB = has_next ? (const char*)g.Bt + (size_t)nxt.pn * tstep : cB;
        _Pragma("nounroll") for (int t = 0; t < nt; t += 2) {
            const bool last = (t == nt - 2);
            const char* a1 = cA + (size_t)(t + 1) * kstep;
            const char* a2 = last ? nA : cA + (size_t)(t + 2) * kstep; const char* b2 = last ? nB : cB + (size_t)(t + 2) * kstep;
            const char* a3 = a2 + kstep; const char* b3 = b2 + kstep;
            if (last && has_next) S.a_ready(nxt);
            if constexpr (SP2) {
            PG8_LDB(B0, 0, 0); PG8_LDB(B1, 0, 1); PG8_SCHED; PG8_LDA(At, 0, 0); PG8_STAGE(PG8_SA(1, 1), a1 + hstep, voffA);
            PG8_WAIT_V(8); PG8_WAIT_L(0); PG8_BAR; PG8_MMA(0, 0, At, B0); PG8_MMA(0, 1, At, B1); PG8_BAR; PG8_SCHED;
            PG8_LDA(At, 0, 1); PG8_STAGE(PG8_SB(0, 0), b2, voffB); PG8_STAGE(PG8_SB(0, 1), b2 + hstep, voffB); PG8_STAGE(PG8_SA(0, 0), a2, voffA);
            PG8_WAIT_V(8); PG8_WAIT_L(0); PG8_BAR; PG8_MMA(1, 0, At, B0); PG8_MMA(1, 1, At, B1); PG8_BAR; PG8_SCHED;
            PG8_LDB(B0, 1, 0); PG8_LDB(B1, 1, 1); PG8_SCHED; PG8_LDA(At, 1, 0); PG8_STAGE(PG8_SA(0, 1), a2 + hstep, voffA);
            PG8_WAIT_V(8); PG8_WAIT_L(0); PG8_BAR; PG8_MMA(0, 0, At, B0); PG8_MMA(0, 1, At, B1); PG8_BAR; PG8_SCHED;
            PG8_LDA(At, 1, 1); PG8_STAGE(PG8_SB(1, 0), b3, voffB); PG8_STAGE(PG8_SB(1, 1), b3 + hstep, voffB); PG8_STAGE(PG8_SA(1, 0), a3, voffA);
            PG8_WAIT_V(8); PG8_WAIT_L(0); PG8_BAR; PG8_MMA(1, 0, At, B0); PG8_MMA(1, 1, At, B1); PG8_BAR; PG8_SCHED;
            } else {
            PG8_LDB(B0, 0, 0); PG8_SCHED; PG8_LDA(At, 0, 0); PG8_STAGE(PG8_SA(1, 1), a1 + hstep, voffA);
            PG8_WAIT_L(8); PG8_BAR; PG8_WAIT_L(0); PG8_MMA(0, 0, At, B0); PG8_BAR; PG8_SCHED;
            PG8_LDB(B1, 0, 1); PG8_STAGE(PG8_SB(0, 0), b2, voffB);
            PG8_BAR; PG8_WAIT_L(0); PG8_MMA(0, 1, At, B1); PG8_BAR;
            PG8_LDA(At, 0, 1); PG8_STAGE(PG8_SA(0, 0), a2, voffA);
            PG8_BAR; PG8_WAIT_L(0); PG8_MMA(1, 0, At, B0); PG8_BAR; PG8_SCHED;
            PG8_STAGE(PG8_SB(0, 1), b2 + hstep, voffB);
            PG8_WAIT_V(6); PG8_BAR; PG8_MMA(1, 1, At, B1); PG8_BAR;
            PG8_LDB(B0, 1, 0); PG8_SCHED; PG8_LDA(At, 1, 0); PG8_STAGE(PG8_SA(0, 1), a2 + hstep, voffA);
            PG8_WAIT_L(8); PG8_BAR; PG8_WAIT_L(0); PG8_MMA(0, 0, At, B0); PG8_BAR; PG8_SCHED;
            PG8_LDB(B1, 1, 1); PG8_STAGE(PG8_SB(1, 0), b3, voffB);
            PG8_BAR; PG8_WAIT_L(0); PG8_MMA(0, 1, At, B1); PG8_BAR;
            PG8_LDA(At, 1, 1); PG8_STAGE(PG8_SA(1, 0), a3, voffA);
            PG8_BAR; PG8_WAIT_L(0); PG8_MMA(1, 0, At, B0); PG8_BAR; PG8_SCHED;
            PG8_STAGE(PG8_SB(1, 1), b3 + hstep, voffB);
            PG8_WAIT_V(6); PG8_BAR; PG8_MMA(1, 1, At, B1); PG8_BAR;
            }
        }
        if constexpr (ALIGN_EPI) { if (wr == 0) PG8_BAR; }
        if constexpr (!Epi::AFTER_DRAIN) { E(acc, cur, wr, wc, fr, fq); S.done(cur); }
        if (!has_next) break;
#pragma unroll
        for (int a = 0; a < 2; ++a)
#pragma unroll
            for (int b = 0; b < 2; ++b)
#pragma unroll
                for (int m = 0; m < 4; ++m)
#pragma unroll
                    for (int n = 0; n < 2; ++n) acc[a][b][m][n] = (f32x4){0.f, 0.f, 0.f, 0.f};
        cur = nxt; cA = nA; cB = nB; ++ui;
        if constexpr (ALIGN_EPI) { if (wr == 1) PG8_BAR; }
    }
    PG8_WAIT_V(0);
    if constexpr (!ALIGN_EPI) { if (wr == 0) PG8_BAR; }
    PG8_BAR;
    if constexpr (Epi::AFTER_DRAIN) { E.fused(acc, cur, wr, wc, fr, fq, lds, wid, lane); S.done(cur); }
#undef PG8_SA
#undef PG8_SB
#undef PG8_STAGE
#undef PG8_LDA
#undef PG8_LDB
#undef PG8_MMA
#undef PG8_WAIT_V
#undef PG8_WAIT_L
#undef PG8_BAR
#undef PG8_SCHED
}
template <class Epi, class Sched, bool ALIGN_EPI = false, bool SP2 = false>
__device__ __forceinline__ void gemm_phase_g(PG8_LAS unsigned char* lds, const Gemm g, const Sched& S, const Epi& E, const unsigned* RTO) {
    const int tid = opaque_tid(), wid = __builtin_amdgcn_readfirstlane(tid >> 6), lane = tid & 63, wr = wid >> 2, wc = wid & 3, fr = lane & 15, fq = lane >> 4;
    const int K = g.K, nt = K / BK;
    unsigned voffA[2], voffB[2]; int RA[2]; unsigned CA2[2]; unsigned vA[2][2], nvA[2][2];
#define PG8_GVA(dst, pm_) do { _Pragma("unroll") for (int h_ = 0; h_ < 2; ++h_) _Pragma("unroll") for (int i_ = 0; i_ < 2; ++i_) dst[h_][i_] = RTO[(pm_) * 256 + h_ * 128 + RA[i_]] + CA2[i_]; } while (0)
#pragma unroll
    for (int i = 0; i < 2; ++i) { int R, C; stage_rc(tid * 16 + i * 8192, R, C); const int Rb = Epi::PERM ? ((R & ~31) + perm32(R & 31)) : R;
        voffA[i] = (unsigned)(R * K + C) * 2u; voffB[i] = (unsigned)(Rb * K + C) * 2u; RA[i] = R; CA2[i] = (unsigned)C * 2u; }
    const size_t kstep = (size_t)(BK * 2);
    const size_t hstep = (size_t)HALF * K * 2;
    const size_t tstep = 2 * hstep;
    const unsigned ldsw = (unsigned)wid * 1024u;
    const int aoff = lds_byte(wr * 64 + fr, fq * 8), boff = lds_byte(wc * 32 + fr, fq * 8);
#define PG8_SA(b, h) (((b) * 2 + (h)) * HTB)
#define PG8_SB(b, h) ((4 + (b) * 2 + (h)) * HTB)
#define PG8_STAGE(bufoff, gbase, voff) do { _Pragma("unroll") for (int _i = 0; _i < 2; ++_i) \
        __builtin_amdgcn_global_load_lds((const unsigned*)((const char*)(gbase) + (voff)[_i]), (PG8_LAS unsigned*)(lds + (bufoff) + ldsw + _i * 8192), 16, 0, 0); } while (0)
#define PG8_LDA(dst, b, h) do { _Pragma("unroll") for (int m = 0; m < 4; ++m) _Pragma("unroll") for (int k = 0; k < 2; ++k) dst[m][k] = *(const PG8_LAS bf16x8*)(lds + PG8_SA(b, h) + aoff + m * 2048 + k * 1024); } while (0)
#define PG8_LDB(dst, b, h) do { _Pragma("unroll") for (int n = 0; n < 2; ++n) _Pragma("unroll") for (int k = 0; k < 2; ++k) dst[n][k] = *(const PG8_LAS bf16x8*)(lds + PG8_SB(b, h) + boff + n * 2048 + k * 1024); } while (0)
#define PG8_MMA(ai, bj, At, Bt) do { __builtin_amdgcn_s_setprio(1); _Pragma("unroll") for (int m = 0; m < 4; ++m) _Pragma("unroll") for (int n = 0; n < 2; ++n) _Pragma("unroll") for (int k = 0; k < 2; ++k) \
        acc[ai][bj][m][n] = __builtin_amdgcn_mfma_f32_16x16x32_bf16(Bt[n][k], At[m][k], acc[ai][bj][m][n], 0, 0, 0); __builtin_amdgcn_s_setprio(0); } while (0)
#define PG8_WAIT_V(n) asm volatile("s_waitcnt vmcnt(" #n ")" ::: "memory")
#define PG8_WAIT_L(n) asm volatile("s_waitcnt lgkmcnt(" #n ")" ::: "memory")
#define PG8_BAR __builtin_amdgcn_s_barrier()
#define PG8_SCHED __builtin_amdgcn_sched_barrier(0)
    Unit cur, nxt; int ui = 0;
    if (!S.next(0, cur)) return;
    f32x4 acc[2][2][4][2];
#pragma unroll
    for (int a = 0; a < 2; ++a)
#pragma unroll
        for (int b = 0; b < 2; ++b)
#pragma unroll
            for (int m = 0; m < 4; ++m)
#pragma unroll
                for (int n = 0; n < 2; ++n) acc[a][b][m][n] = (f32x4){0.f, 0.f, 0.f, 0.f};
    bf16x8 At[4][2], B0[2][2], B1[2][2];
    const char* const gA = (const char*)g.A; const char* cA = gA; const char* cB = (const char*)g.Bt + (size_t)cur.pn * tstep;
    PG8_GVA(vA, cur.pm);
    S.a_ready(cur);
    if constexpr (SP2) {
        PG8_STAGE(PG8_SB(0, 0), cB, voffB); PG8_STAGE(PG8_SB(0, 1), cB + hstep, voffB); PG8_STAGE(PG8_SA(0, 0), gA, vA[0]); PG8_STAGE(PG8_SA(0, 1), gA, vA[1]);
        if (wr == 1) PG8_BAR;
        PG8_WAIT_V(2); PG8_BAR;
        PG8_STAGE(PG8_SB(1, 0), cB + kstep, voffB); PG8_STAGE(PG8_SA(1, 0), gA + kstep, vA[0]); PG8_STAGE(PG8_SB(1, 1), cB + hstep + kstep, voffB);
        PG8_WAIT_V(6); PG8_BAR;
    } else {
        PG8_STAGE(PG8_SB(0, 0), cB, voffB); PG8_STAGE(PG8_SA(0, 0), gA, vA[0]); PG8_STAGE(PG8_SB(0, 1), cB + hstep, voffB); PG8_STAGE(PG8_SA(0, 1), gA, vA[1]);
        if (wr == 1) PG8_BAR;
        PG8_WAIT_V(4); PG8_BAR;
        PG8_STAGE(PG8_SB(1, 0), cB + kstep, voffB); PG8_STAGE(PG8_SA(1, 0), gA + kstep, vA[0]); PG8_STAGE(PG8_SB(1, 1), cB + hstep + kstep, voffB);
        PG8_WAIT_V(6); PG8_BAR;
    }
    for (;;) {
        const bool has_next = S.next(ui + 1, nxt);
        const char* nA = gA; const char* nB = has_next ? (const char*)g.Bt + (size_t)nxt.pn * tstep : cB;
        if (has_next) { PG8_GVA(nvA, nxt.pm); } else { nvA[0][0] = vA[0][0]; nvA[0][1] = vA[0][1]; nvA[1][0] = vA[1][0]; nvA[1][1] = vA[1][1]; }
        _Pragma("nounroll") for (int t = 0; t < nt; t += 2) {
            const bool last = (t == nt - 2);
            const char* a1 = gA + (size_t)(t + 1) * kstep;
            const unsigned xA0[2] = {last ? nvA[0][0] : vA[0][0], last ? nvA[0][1] : vA[0][1]}, xA1[2] = {last ? nvA[1][0] : vA[1][0], last ? nvA[1][1] : vA[1][1]};
            const char* a2 = last ? gA : gA + (size_t)(t + 2) * kstep; const char* b2 = last ? nB : cB + (size_t)(t + 2) * kstep;
            const char* a3 = a2 + kstep; const char* b3 = b2 + kstep;
            if (last && has_next) S.a_ready(nxt);
            if constexpr (SP2) {
            PG8_LDB(B0, 0, 0); PG8_LDB(B1, 0, 1); PG8_SCHED; PG8_LDA(At, 0, 0); PG8_STAGE(PG8_SA(1, 1), a1, vA[1]);
            PG8_WAIT_V(8); PG8_WAIT_L(0); PG8_BAR; PG8_MMA(0, 0, At, B0); PG8_MMA(0, 1, At, B1); PG8_BAR; PG8_SCHED;
            PG8_LDA(At, 0, 1); PG8_STAGE(PG8_SB(0, 0), b2, voffB); PG8_STAGE(PG8_SB(0, 1), b2 + hstep, voffB); PG8_STAGE(PG8_SA(0, 0), a2, xA0);
            PG8_WAIT_V(8); PG8_WAIT_L(0); PG8_BAR; PG8_MMA(1, 0, At, B0); PG8_MMA(1, 1, At, B1); PG8_BAR; PG8_SCHED;
            PG8_LDB(B0, 1, 0); PG8_LDB(B1, 1, 1); PG8_SCHED; PG8_LDA(At, 1, 0); PG8_STAGE(PG8_SA(0, 1), a2, xA1);
            PG8_WAIT_V(8); PG8_WAIT_L(0); PG8_BAR; PG8_MMA(0, 0, At, B0); PG8_MMA(0, 1, At, B1); PG8_BAR; PG8_SCHED;
            PG8_LDA(At, 1, 1); PG8_STAGE(PG8_SB(1, 0), b3, voffB); PG8_STAGE(PG8_SB(1, 1), b3 + hstep, voffB); PG8_STAGE(PG8_SA(1, 0), a3, xA0);
            PG8_WAIT_V(8); PG8_WAIT_L(0); PG8_BAR; PG8_MMA(1, 0, At, B0); PG8_MMA(1, 1, At, B1); PG8_BAR; PG8_SCHED;
            } else {
            PG8_LDB(B0, 0, 0); PG8_SCHED; PG8_LDA(At, 0, 0); PG8_STAGE(PG8_SA(1, 1), a1, vA[1]);
            PG8_WAIT_L(8); PG8_BAR; PG8_WAIT_L(0); PG8_MMA(0, 0, At, B0); PG8_BAR; PG8_SCHED;
            PG8_LDB(B1, 0, 1); PG8_STAGE(PG8_SB(0, 0), b2, voffB);
            PG8_BAR; PG8_WAIT_L(0); PG8_MMA(0, 1, At, B1); PG8_BAR;
            PG8_LDA(At, 0, 1); PG8_STAGE(PG8_SA(0, 0), a2, xA0);
            PG8_BAR; PG8_WAIT_L(0); PG8_MMA(1, 0, At, B0); PG8_BAR; PG8_SCHED;
            PG8_STAGE(PG8_SB(0, 1), b2 + hstep, voffB);
            PG8_WAIT_V(6); PG8_BAR; PG8_MMA(1, 1, At, B1); PG8_BAR;
            PG8_LDB(B0, 1, 0); PG8_SCHED; PG8_LDA(At, 1, 0); PG8_STAGE(PG8_SA(0, 1), a2, xA1);
            PG8_WAIT_L(8); PG8_BAR; PG8_WAIT_L(0); PG8_MMA(0, 0, At, B0); PG8_BAR; PG8_SCHED;
            PG8_LDB(B1, 1, 1); PG8_STAGE(PG8_SB(1, 0), b3, voffB);
            PG8_BAR; PG8_WAIT_L(0); PG8_MMA(0, 1, At, B1); PG8_BAR;
            PG8_LDA(At, 1, 1); PG8_STAGE(PG8_SA(1, 0), a3, xA0);
            PG8_BAR; PG8_WAIT_L(0); PG8_MMA(1, 0, At, B0); PG8_BAR; PG8_SCHED;
            PG8_STAGE(PG8_SB(1, 1), b3 + hstep, voffB);
            PG8_WAIT_V(6); PG8_BAR; PG8_MMA(1, 1, At, B1); PG8_BAR;
            }
        }
        if constexpr (ALIGN_EPI) { if (wr == 0) PG8_BAR; }
        if constexpr (!Epi::AFTER_DRAIN) { E(acc, cur, wr, wc, fr, fq); S.done(cur); }
        if (!has_next) break;
#pragma unroll
        for (int a = 0; a < 2; ++a)
#pragma unroll
            for (int b = 0; b < 2; ++b)
#pragma unroll
                for (int m = 0; m < 4; ++m)
#pragma unroll
                    for (int n = 0; n < 2; ++n) acc[a][b][m][n] = (f32x4){0.f, 0.f, 0.f, 0.f};
        cur = nxt; cA = nA; cB = nB; ++ui; vA[0][0] = nvA[0][0]; vA[0][1] = nvA[0][1]; vA[1][0] = nvA[1][0]; vA[1][1] = nvA[1][1];
        if constexpr (ALIGN_EPI) { if (wr == 1) PG8_BAR; }
    }
    PG8_WAIT_V(0);
    if constexpr (!ALIGN_EPI) { if (wr == 0) PG8_BAR; }
    PG8_BAR;
    if constexpr (Epi::AFTER_DRAIN) { E.fused(acc, cur, wr, wc, fr, fq, lds, wid, lane); S.done(cur); }
#undef PG8_SA
#undef PG8_SB
#undef PG8_STAGE
#undef PG8_LDA
#undef PG8_LDB
#undef PG8_MMA
#undef PG8_WAIT_V
#undef PG8_WAIT_L
#undef PG8_BAR
#undef PG8_SCHED
#undef PG8_GVA
}
}
#define XB_TMO      128
#define XB_XCNT(j)  (256  + 64 * (j))
#define XB_XSUB(j)  (1280 + 64 * (j))
#define XB_XGEN(j)  (2304 + 64 * (j))
#define XB_TOP      3328
#define XB_TOPGEN   3392
#define XCD_BAR_WORDS 3456
#define XB_SPIN_CAP (1u << 18)

__device__ __forceinline__ unsigned xb_ld(unsigned* p)              { return __hip_atomic_load(p, __ATOMIC_RELAXED, __HIP_MEMORY_SCOPE_AGENT); }
__device__ __forceinline__ unsigned xb_add(unsigned* p, unsigned v) { return __hip_atomic_fetch_add(p, v, __ATOMIC_RELAXED, __HIP_MEMORY_SCOPE_AGENT); }
__device__ __forceinline__ unsigned xb_xcc_id() { return (unsigned)__builtin_amdgcn_s_getreg((3 << 11) | 20) & 0xFu; }
#define XB_SPIN(cond, bar) do { unsigned _sp = 0; while (cond) { __builtin_amdgcn_s_sleep(1); \
    if ((++_sp & 255u) == 0u) { if (xb_ld(&(bar)[XB_TMO])) break; if (_sp > XB_SPIN_CAP) { atomicAdd(&(bar)[XB_TMO], 1u); break; } } } } while (0)

struct XcdBarrier {
    unsigned* bar; unsigned x;
    volatile LAS unsigned* st;
};

__device__ __forceinline__ XcdBarrier xcd_barrier_post(unsigned* bar, volatile LAS unsigned* st) {
    XcdBarrier b; b.bar = bar; b.x = xb_xcc_id(); b.st = st;
    if (threadIdx.x == 0) (void)xb_add(&bar[XB_XCNT(b.x)], 1u);
    return b;
}
__device__ __forceinline__ void xcd_barrier_complete(unsigned* bar, unsigned x, unsigned& nloc, unsigned& nx) {
    const unsigned G = gridDim.x * gridDim.y * gridDim.z;
    unsigned sum, cnt, mine, sp = 0u;
    for (;;) {
        sum = 0u; cnt = 0u; mine = 0u;
#pragma unroll
        for (unsigned j = 0; j < 16; ++j) { const unsigned c = xb_ld(&bar[XB_XCNT(j)]); sum += c; cnt += (c > 0u) ? 1u : 0u; mine = (j == x) ? c : mine; }
        if (sum == G) break;
        __builtin_amdgcn_s_sleep(1);
        if ((++sp & 255u) == 0u) { if (xb_ld(&bar[XB_TMO])) break; if (sp > XB_SPIN_CAP) { atomicAdd(&bar[XB_TMO], 1u); break; } }
    }
    nloc = mine > 0u ? mine : 1u; nx = cnt > 0u ? cnt : 1u;
}

__device__ __forceinline__ void xcd_barrier(const XcdBarrier& b) {
#if MK_STRONG_BAR
    __builtin_amdgcn_fence(__ATOMIC_RELEASE, MK_BAR_SCOPE);
#endif
    asm volatile("s_waitcnt vmcnt(0)" ::: "memory");
    __syncthreads();
    if (threadIdx.x == 0) {
        unsigned* bar = b.bar;
        __builtin_amdgcn_s_waitcnt(0);
        unsigned nloc = b.st[0], nx = b.st[1];
        if (nloc == 0u) { xcd_barrier_complete(bar, b.x, nloc, nx); b.st[0] = nloc; b.st[1] = nx; }
#if MK_STRONG_BAR
        __builtin_amdgcn_fence(__ATOMIC_RELEASE, MK_BAR_SCOPE);
        asm volatile("s_waitcnt vmcnt(0)" ::: "memory");
#endif
        const unsigned old = xb_add(&bar[XB_XSUB(b.x)], 1u);
        const unsigned gen = old / nloc;
        if (old + 1u == (gen + 1u) * nloc) {
            __builtin_amdgcn_fence(__ATOMIC_RELEASE, MK_BAR_SCOPE);
            asm volatile("s_waitcnt vmcnt(0)" ::: "memory");
            const unsigned og = xb_add(&bar[XB_TOP], 1u);
            const unsigned tg = og / nx;
            if (og + 1u == (tg + 1u) * nx) xb_add(&bar[XB_TOPGEN], 1u);
            else XB_SPIN(xb_ld(&bar[XB_TOPGEN]) == tg, bar);
#if MK_BAR_EARLY_REL
            xb_add(&bar[XB_XGEN(b.x)], 1u);
            __builtin_amdgcn_fence(__ATOMIC_ACQUIRE, MK_ACQ_SCOPE);
#else
            __builtin_amdgcn_fence(__ATOMIC_ACQUIRE, MK_ACQ_SCOPE);
            xb_add(&bar[XB_XGEN(b.x)], 1u);
#endif
            asm volatile("s_waitcnt vmcnt(0)" ::: "memory");
        } else {
            XB_SPIN(xb_ld(&bar[XB_XGEN(b.x)]) == gen, bar);
            __builtin_amdgcn_fence(__ATOMIC_ACQUIRE, MK_ACQ_SCOPE);
            asm volatile("s_waitcnt vmcnt(0)" ::: "memory");
        }
    }
    __syncthreads();
}
namespace mk {
using pg8::bf16_t; using pg8::bf16x8; using pg8::f32x4; using pg8::u32x4; using pg8::Unit; using pg8::Gemm; using pg8::cvt_pk_bf16;
typedef float f32x16 __attribute__((ext_vector_type(16)));
typedef float f32x2v __attribute__((ext_vector_type(2)));
typedef short s16x4 __attribute__((ext_vector_type(4)));
typedef unsigned u32x2 __attribute__((ext_vector_type(2)));
constexpr int T = 32768, S = 16384, NBATCH = 2, DM = 1024, NL = 4, NW = 8;
constexpr int NPMAX = 73728;
constexpr float EPS = 1e-6f;
constexpr size_t MiB = 1u << 20;
constexpr size_t WS_CTL = 0, CTL_ZERO_BYTES = 1 * MiB;
constexpr size_t WS_COS = 1 * MiB, WS_SIN = 2 * MiB, WS_S5T = 3 * MiB, WS_WSG = 4 * MiB, WS_WR = 5 * MiB, WS_WGLU = 6 * MiB;
constexpr size_t WS_WIN = 8 * MiB, WS_WUQ = 20 * MiB, WS_WUKV = 23 * MiB, WS_WOUT = 25 * MiB, WS_WPG = 33 * MiB, WS_WPLE = 41 * MiB, WS_W13 = 43 * MiB, WS_W2T = 75 * MiB;
constexpr size_t WS_SS1 = 91 * MiB, WS_SS2 = 93 * MiB, WS_SSQ = 95 * MiB, WS_SKV = 96 * MiB, WS_SQH = 97 * MiB, WS_SA = 101 * MiB, WS_RS2 = 102 * MiB, WS_KR = 103 * MiB;
constexpr size_t WS_E = 107 * MiB, WS_HS = 111 * MiB, WS_ROUTE = 115 * MiB;
constexpr size_t WS_HBA = 118 * MiB, WS_HBB = 182 * MiB, WS_PB = 246 * MiB;
constexpr size_t WS_ZQ = 262 * MiB, WS_ZKV = 286 * MiB, WS_U = 302 * MiB, WS_VS = 318 * MiB, WS_XS = 334 * MiB, WS_Q = 350 * MiB, WS_K = 398 * MiB, WS_V = 446 * MiB, WS_MIX = 478 * MiB;
constexpr size_t WS_XG = 262 * MiB, WS_HBX = 406 * MiB, WS_Y01 = 442 * MiB, WS_PL = 570 * MiB, WS_END = 634 * MiB;
constexpr size_t WS_W13B = 634 * MiB, WS_W2TB = 666 * MiB, WS_END2 = 682 * MiB;
constexpr size_t RT_CNT = 0, RT_TSTART = 64 << 10, RT_ER = 128 << 10, RT_WGT = 512 << 10, RT_TOK = 1 * MiB, RT_W = 1 * MiB + (512 << 10), RT_RS = 2 * MiB, RT_RTO = 2 * MiB + (512 << 10);
constexpr unsigned ZERO_OFF = 512u << 10;
constexpr size_t S5T_LAYER = 160 << 10, S5T_AB = 0, S5T_BBT = 16 << 10, S5T_CMT = 80 << 10, S5T_D = 144 << 10;
constexpr int CW_BAR = 4096;
constexpr int RING_BYTES = 131072, EXTRA_OFF = 131072, EXTRA_BYTES = 8192, LDSCTL_OFF = EXTRA_OFF + EXTRA_BYTES, LDS_BYTES = 147456;

#define GAS __attribute__((address_space(1)))
#define LAS __attribute__((address_space(3)))
#define MFMA_PAD(x) asm volatile("s_nop 15\n\ts_nop 7" : "+v"(x))
#define PHASE_SYNC() do { asm volatile("s_waitcnt vmcnt(0) lgkmcnt(0)" ::: "memory"); __syncthreads(); } while (0)
#define LDS_WAIT() asm volatile("s_waitcnt lgkmcnt(0)" ::: "memory")
#define VM_WAIT() asm volatile("s_waitcnt vmcnt(0)" ::: "memory")
__device__ __forceinline__ unsigned f2bf(float f) { unsigned u = __builtin_bit_cast(unsigned, f); return (u + 0x7fffu + ((u >> 16) & 1u)) >> 16; }
typedef float f32x2_t __attribute__((ext_vector_type(2))); typedef __bf16 bf16x2_t __attribute__((ext_vector_type(2)));
__device__ __forceinline__ unsigned pk2(float lo, float hi) { f32x2_t v = {lo, hi}; bf16x2_t b = __builtin_convertvector(v, bf16x2_t); return __builtin_bit_cast(unsigned, b); }
__device__ __forceinline__ float bf2f(unsigned short b) { return __builtin_bit_cast(float, (unsigned)b << 16); }
__device__ __forceinline__ float bflo(unsigned w) { return __builtin_bit_cast(float, w << 16); }
__device__ __forceinline__ float bfhi(unsigned w) { return __builtin_bit_cast(float, w & 0xffff0000u); }
__device__ __forceinline__ float shx(float v, int o) {
    const int l = opaque_tid() & 63; return __builtin_bit_cast(float, __builtin_amdgcn_ds_bpermute((l ^ o) << 2, __builtin_bit_cast(int, v))); }
__device__ __forceinline__ float wave_sum(float v) {
    const int l = opaque_tid() & 63;
#pragma unroll
    for (int o = 1; o < 64; o <<= 1) v += __builtin_bit_cast(float, __builtin_amdgcn_ds_bpermute((l ^ o) << 2, __builtin_bit_cast(int, v)));
    return v;
}
__device__ __forceinline__ float fq_sum(float v) { v += shx(v, 16); v += shx(v, 32); return v; }
__device__ __forceinline__ float gelu_t(float x) {
    const float u2 = 1.5957691216057308f * (x + 0.044715f * x * x * x);
    return x * __builtin_amdgcn_rcpf(1.0f + __builtin_amdgcn_exp2f(-1.4426950408889634f * u2));
}
__device__ __forceinline__ float sigm(float x) { return __builtin_amdgcn_rcpf(1.0f + __builtin_amdgcn_exp2f(-1.4426950408889634f * x)); }

__device__ __forceinline__ void st_wt(float* p, float v) { *p = v; }
__device__ __forceinline__ void st_wt(int* p, int v) { *p = v; }

struct Args { const float* in[37]; float* out; unsigned char* ws; int l_lo, l_hi, ph_lo, ph_hi, shift, pad; };

struct Frame {
    LAS unsigned char* lds;
    unsigned char* ws;
    int tid, lane, wave, G, vcu;
};

__device__ __forceinline__ void conv_item(const float* src, int ldsrc, int srccol0, const float* gain, bf16_t* dst, int K, int dstrow0, int k0, LAS float* scr, int lane, int gain_kmax = 1 << 30) {
    const int c = lane & 7;
    if (srccol0 < 0) {
#pragma unroll
        for (int j = 0; j < 4; ++j) { const int n = (lane >> 3) + 8 * j; *(GAS u32x4*)(dst + (size_t)(dstrow0 + n) * K + k0 + 8 * c) = (u32x4){0u, 0u, 0u, 0u}; }
        return;
    }
    { f32x4 v[8]; const int rr = lane >> 3, c4 = 4 * (lane & 7);
#pragma unroll
      for (int i = 0; i < 8; ++i) v[i] = *(const GAS f32x4*)(src + (size_t)(k0 + 8 * i + rr) * ldsrc + srccol0 + c4);
      f32x4 g0 = (f32x4){1.f, 1.f, 1.f, 1.f}, g1 = g0;
      if (gain && k0 < gain_kmax) { g0 = *(const GAS f32x4*)(gain + k0 + 8 * c); g1 = *(const GAS f32x4*)(gain + k0 + 8 * c + 4); }
#pragma unroll
      for (int i = 0; i < 8; ++i) { LAS float* d = scr + (8 * i + rr) * 33 + c4; d[0] = v[i][0]; d[1] = v[i][1]; d[2] = v[i][2]; d[3] = v[i][3]; }
      LDS_WAIT(); asm volatile("" ::: "memory");
#pragma unroll
      for (int j = 0; j < 4; ++j) { const int n = (lane >> 3) + 8 * j; const LAS float* sp = scr + (8 * c) * 33 + n;
          u32x4 o; o.x = pk2(sp[0 * 33] * g0[0], sp[1 * 33] * g0[1]); o.y = pk2(sp[2 * 33] * g0[2], sp[3 * 33] * g0[3]); o.z = pk2(sp[4 * 33] * g1[0], sp[5 * 33] * g1[1]); o.w = pk2(sp[6 * 33] * g1[2], sp[7 * 33] * g1[3]);
          *(GAS u32x4*)(dst + (size_t)(dstrow0 + n) * K + k0 + 8 * c) = o; }
      LDS_WAIT(); asm volatile("" ::: "memory"); }
}
template <class ColMap>
__device__ __forceinline__ void conv_matrix(const Frame& F, int gw, int NGW, const float* src, int ldsrc, const float* gain, bf16_t* dst, int K, int N, ColMap cm, int gain_kmax = 1 << 30) {
    LAS float* scr = (LAS float*)(F.lds + F.wave * 16384);
    const int nblk = N / 32, nitems = (K / 64) * nblk;
    for (int it = gw; it < nitems; it += NGW) { const int kb = it / nblk, nb = it % nblk; conv_item(src, ldsrc, cm(nb), gain, dst, K, 32 * nb, 64 * kb, scr, F.lane, gain_kmax); }
}
struct CmIdent { __device__ int operator()(int nb) const { return 32 * nb; } };
struct CmWin {
    __device__ int operator()(int nb) const {
        const int n = 32 * nb;
        if (n < 384) return n;
        if (n < 416) return 640;
        if (n < 512) return -1;
        if (n < 768) return 384 + (n - 512);
        if (n < 1024) return 672 + (n - 768);
        if (n < 1280) { const int p = n - 1024, bj = p >> 7, wc = (p >> 5) & 3; return 928 + 64 * wc + 32 * bj; }
        return 1184 + (n - 1280);
    }
};
struct CmUq { __device__ int operator()(int nb) const { const int h = nb >> 2, j = nb & 3; return j < 3 ? h * 96 + 32 * j : -1; } };
struct CmUkv {
    __device__ int operator()(int nb) const { const int tile = nb >> 3, bj = (nb >> 2) & 1, wc = nb & 3; const int h = 2 * tile + (wc >> 1); return h * 128 + (wc & 1) * 64 + 32 * bj; }
};
struct CmW13 { const int dummy; };

__device__ __forceinline__ void conv_moe_layer(const Frame& F, int gw, int NGW, const Args& a, int l, int par = 0) {
    LAS float* scr = (LAS float*)(F.lds + F.wave * 16384);
    const float* w1 = a.in[31] + (size_t)l * 32 * 1024 * 256; const float* w3 = a.in[32] + (size_t)l * 32 * 1024 * 256; const float* w2 = a.in[33] + (size_t)l * 32 * 256 * 1024;
    const float* ln2 = a.in[26] + (size_t)l * 1024;
    bf16_t* W13 = (bf16_t*)(F.ws + (par ? WS_W13B : WS_W13)); bf16_t* W2T = (bf16_t*)(F.ws + (par ? WS_W2TB : WS_W2T));
    for (int it = gw; it < 32 * 256; it += NGW) { const int e = it >> 8, r = it & 255, kb = r >> 4, nb = r & 15;
        const int n = 32 * nb, pnl = n >> 8, bj = (n >> 7) & 1, j = n & 127; const float* src = (bj ? w3 : w1) + (size_t)e * 1024 * 256;
        conv_item(src, 256, 128 * pnl + j, ln2, W13 + (size_t)e * 512 * 1024, 1024, n, 64 * kb, scr, F.lane); }
    for (int it = gw; it < 32 * 128; it += NGW) { const int e = it >> 7, r = it & 127, kb = r >> 5, nb = r & 31;
        conv_item(w2 + (size_t)e * 256 * 1024, 1024, 32 * nb, nullptr, W2T + (size_t)e * 1024 * 256, 256, 32 * nb, 64 * kb, scr, F.lane); }
}
__device__ __forceinline__ void conv_p_layer(const Frame& F, int gw, int NGW, const Args& a, int l) {
    const float* p = a.in[1] + (size_t)l * T * 256; bf16_t* Pb = (bf16_t*)(F.ws + WS_PB);
    for (int m = gw; m < T; m += NGW) { const f32x4 v = *(const GAS f32x4*)(p + (size_t)m * 256 + 4 * F.lane);
        u32x2 o; o.x = pk2(v.x, v.y); o.y = pk2(v.z, v.w); *(GAS u32x2*)(Pb + (size_t)m * 256 + 4 * F.lane) = o; }
}

__device__ __forceinline__ void p0_prologue(const Frame& F, const Args& a) {
    const int gw = F.vcu * NW + F.wave, NGW = F.G * NW;
    const int gt = gw * 64 + F.lane, NGT = NGW * 64;
#ifndef MK_PRO_REP
#define MK_PRO_REP 0
#endif
#define PREP(k) (((MK_PRO_REP >> (k)) & 1) ? 2 : 1)
    for (int l = 0; l < NL; ++l) {
        for (int r_ = 0; r_ < PREP(0); ++r_) {
        conv_matrix(F, gw, NGW, a.in[3] + (size_t)l * 1024 * 1440, 1440, a.in[2] + l * 1024, (bf16_t*)(F.ws + WS_WIN) + (size_t)l * 1536 * 1024, 1024, 1536, CmWin());
        conv_matrix(F, gw, NGW, a.in[6] + (size_t)l * 384 * 768, 768, a.in[4] + l * 384, (bf16_t*)(F.ws + WS_WUQ) + (size_t)l * 1024 * 384, 384, 1024, CmUq());
        conv_matrix(F, gw, NGW, a.in[7] + (size_t)l * 256 * 1024, 1024, a.in[5] + l * 256, (bf16_t*)(F.ws + WS_WUKV) + (size_t)l * 1024 * 256, 256, 1024, CmUkv());
        conv_matrix(F, gw, NGW, a.in[25] + (size_t)l * 1024 * 1024, 1024, a.in[24] + (size_t)l * 1024, (bf16_t*)(F.ws + WS_WOUT) + (size_t)l * 1024 * 1024, 1024, 1024, CmIdent(), 512);
        conv_matrix(F, gw, NGW, a.in[34] + (size_t)l * 1024 * 1024, 1024, nullptr, (bf16_t*)(F.ws + WS_WPG) + (size_t)l * 1024 * 1024, 1024, 1024, CmIdent());
        conv_matrix(F, gw, NGW, a.in[36] + (size_t)l * 256 * 1024, 1024, nullptr, (bf16_t*)(F.ws + WS_WPLE) + (size_t)l * 1024 * 256, 256, 1024, CmIdent());
        conv_matrix(F, gw, NGW, a.in[22] + (size_t)l * 256 * 256, 256, nullptr, (bf16_t*)(F.ws + WS_WGLU) + (size_t)l * 256 * 256, 256, 256, CmIdent());
        }
        for (int r_ = 0; r_ < PREP(1); ++r_) {
        { bf16_t* Wr = (bf16_t*)(F.ws + WS_WR) + (size_t)l * 48 * 1024; const float* wrg = a.in[27] + (size_t)l * 4096; const float* wre = a.in[29] + (size_t)l * 32768; const float* ln2 = a.in[26] + l * 1024;
          for (int i = gt; i < 48 * 1024; i += NGT) { const int n = i >> 10, k = i & 1023; float v = 0.f; if (n < 4) v = wrg[k * 4 + n]; else if (n < 36) v = wre[k * 32 + (n - 4)]; Wr[i] = (bf16_t)f2bf(v * ln2[k]); } }
        { bf16_t* Wsg = (bf16_t*)(F.ws + WS_WSG) + (size_t)l * 4 * 128 * 128; const float* w = a.in[12] + (size_t)l * 4 * 128 * 128;
          for (int i = gt; i < 4 * 128 * 128; i += NGT) { const int p = i & 15, sb = (i & 127) & ~15, t = (i >> 7) & 127; const int q = p & 7, kp = (q & 3) + 8 * (q >> 2) + 4 * (p >> 3); const int s = sb + kp;
              const float v = (s <= t) ? w[(i & ~127) + s] : 0.f; Wsg[i] = (bf16_t)f2bf(v); } }
        { unsigned char* tb = F.ws + WS_S5T + (size_t)l * S5T_LAYER; float* ab = (float*)(tb + S5T_AB); bf16_t* BBt = (bf16_t*)(tb + S5T_BBT); bf16_t* Cmt = (bf16_t*)(tb + S5T_CMT); float* dd = (float*)(tb + S5T_D);
          const float* lre = a.in[14] + l * 1024; const float* lim = a.in[15] + l * 1024; const float* ldt = a.in[16] + l * 1024;
          const float* bre = a.in[17] + (size_t)l * 16384; const float* bim = a.in[18] + (size_t)l * 16384; const float* cre = a.in[19] + (size_t)l * 16384; const float* cim = a.in[20] + (size_t)l * 16384;
          for (int i = gt; i < 16 * 128 * 16; i += NGT) {
              const int c = i & 15, np = (i >> 4) & 127, g = i >> 11, n = np & 63, gn = g * 64 + n;
              const float lr = fminf(lre[gn], -1e-4f), li = lim[gn], dt = expf(ldt[gn]); const float mag = expf(lr * dt); float sn, cs; sincosf(li * dt, &sn, &cs);
              const float are = mag * cs, aim = mag * sn, den = lr * lr + li * li, nr = are - 1.0f, ni = aim; const float fr = (nr * lr + ni * li) / den, fi = (ni * lr - nr * li) / den;
              const float br = bre[(size_t)gn * 16 + c], bi = bim[(size_t)gn * 16 + c];
              const float v = (np < 64) ? (fr * br - fi * bi) : (fr * bi + fi * br);
              BBt[i] = (bf16_t)f2bf(v);
              if (c == 0 && np < 64) { ab[gn] = are; ab[1024 + gn] = aim; const float m64 = expf(64.0f * lr * dt); float s64, c64; sincosf(64.0f * li * dt, &s64, &c64); ab[2048 + gn] = m64 * c64; ab[3072 + gn] = m64 * s64; } }
          for (int i = gt; i < 16 * 16 * 128; i += NGT) {
              const int np = i & 127, c = (i >> 7) & 15, g = i >> 11, n = np >> 1; const size_t ci = ((size_t)g * 16 + c) * 64 + n;
              Cmt[i] = (bf16_t)f2bf((np & 1) ? -cim[ci] : cre[ci]); }
          for (int i = gt; i < 256; i += NGT) dd[i] = a.in[21][l * 256 + i]; }
        }
    }
    for (int r_ = 0; r_ < PREP(1); ++r_) { float* CS = (float*)(F.ws + WS_COS); float* SN = (float*)(F.ws + WS_SIN);
      for (int i = gt; i < S * 16; i += NGT) { const int s = i >> 4, j = i & 15; const float inv = 1.0f / powf(10000.0f, (float)(2 * j) / 32.0f); const float ang = (float)s * inv; float sn, cs; sincosf(ang, &sn, &cs); CS[i] = cs; SN[i] = sn; } }
    for (int r_ = 0; r_ < PREP(2); ++r_) { const float* x = a.in[0]; bf16_t* Hb = (bf16_t*)(F.ws + WS_HBA); float* SS1 = (float*)(F.ws + WS_SS1);
      for (int m = gw; m < T; m += NGW) { const GAS f32x4* xr = (const GAS f32x4*)(x + (size_t)m * DM) + F.lane; f32x4 v[4]; float s = 0.f;
#pragma unroll
          for (int j = 0; j < 4; ++j) { v[j] = xr[64 * j]; s += (v[j].x * v[j].x + v[j].y * v[j].y) + (v[j].z * v[j].z + v[j].w * v[j].w); }
          s = wave_sum(s);
          GAS u32x2* o8 = (GAS u32x2*)(Hb + (size_t)m * DM) + F.lane;
#pragma unroll
          for (int j = 0; j < 4; ++j) { u32x2 o; o.x = pk2(v[j].x, v[j].y); o.y = pk2(v[j].z, v[j].w); o8[64 * j] = o; }
          if (F.lane < 16) SS1[(size_t)m * 16 + F.lane] = (F.lane == 0) ? s : 0.f; } }
    for (int r_ = 0; r_ < PREP(3); ++r_) conv_moe_layer(F, gw, NGW, a, 0);
    if (a.pad == 0) for (int r_ = 0; r_ < PREP(4); ++r_) conv_p_layer(F, gw, NGW, a, 0);
}

#define EPI_ROW(u, ai, m) ((u).pm * 256 + (ai) * 128 + wr * 64 + (m) * 16 + fr)
__device__ __forceinline__ u32x4 pack8(const f32x4 v0, const f32x4 v1) { u32x4 w; w.x = pk2(v0[0], v0[1]); w.y = pk2(v0[2], v0[3]); w.z = pk2(v1[0], v1[1]); w.w = pk2(v1[2], v1[3]); return w; }
__device__ __forceinline__ float sq8(const f32x4 a, const f32x4 b) { return (a[0] * a[0] + a[1] * a[1]) + (a[2] * a[2] + a[3] * a[3]) + (b[0] * b[0] + b[1] * b[1]) + (b[2] * b[2] + b[3] * b[3]); }
__device__ __forceinline__ float sum16(const float* p) { const f32x4 a = *(const f32x4*)p, b = *(const f32x4*)(p + 4), c = *(const f32x4*)(p + 8), d = *(const f32x4*)(p + 12);
    return ((a[0] + a[1]) + (a[2] + a[3])) + ((b[0] + b[1]) + (b[2] + b[3])) + ((c[0] + c[1]) + (c[2] + c[3])) + ((d[0] + d[1]) + (d[2] + d[3])); }

struct EpiIn {
    static constexpr bool PERM = true, AFTER_DRAIN = false;
    const float* SS1; bf16_t* ZQ; float* KR; bf16_t* ZKV; bf16_t* U; bf16_t* VS; bf16_t* XS; float* SSQ; float* SKV; const float* lng; const float* lnb;
    __device__ __forceinline__ void operator()(const f32x4 (&acc)[2][2][4][2], const Unit& u, int wr, int wc, int fr, int fq) const {
        const int pn = u.pn;
        float rsv[2][4];
#pragma unroll
        for (int ai = 0; ai < 2; ++ai)
#pragma unroll
            for (int m = 0; m < 4; ++m) { const f32x4 p = *(const f32x4*)(SS1 + (size_t)EPI_ROW(u, ai, m) * 16 + 4 * fq); rsv[ai][m] = (p[0] + p[1]) + (p[2] + p[3]); }
#pragma unroll
        for (int ai = 0; ai < 2; ++ai)
#pragma unroll
            for (int m = 0; m < 4; ++m) rsv[ai][m] = rsqrtf(fq_sum(rsv[ai][m]) * (1.0f / 1024.0f) + EPS);
#pragma unroll
        for (int ai = 0; ai < 2; ++ai)
#pragma unroll
            for (int m = 0; m < 4; ++m) {
                const int row = EPI_ROW(u, ai, m);
                const float rs = rsv[ai][m];
                f32x4 v[2][2];
#pragma unroll
                for (int bj = 0; bj < 2; ++bj) { v[bj][0] = acc[ai][bj][m][0] * rs; v[bj][1] = acc[ai][bj][m][1] * rs; }
                const int c8 = 32 * wc + 8 * fq;
                if (pn == 0) {
#pragma unroll
                    for (int bj = 0; bj < 2; ++bj) *(u32x4*)(ZQ + (size_t)row * 384 + 128 * bj + c8) = pack8(v[bj][0], v[bj][1]);
                    const float s = fq_sum(sq8(v[0][0], v[0][1]) + sq8(v[1][0], v[1][1]));
                    if (fq == 0) st_wt(SSQ + (size_t)row * 8 + wc, s);
                } else if (pn == 1) {
                    *(u32x4*)(ZQ + (size_t)row * 384 + 256 + c8) = pack8(v[0][0], v[0][1]);
                    const float s = fq_sum(sq8(v[0][0], v[0][1]));
                    if (fq == 0) st_wt(SSQ + (size_t)row * 8 + 4 + wc, s);
                    if (wc == 0) { *(f32x4*)(KR + (size_t)row * 32 + 8 * fq) = v[1][0]; *(f32x4*)(KR + (size_t)row * 32 + 8 * fq + 4) = v[1][1]; }
                } else if (pn == 2) {
#pragma unroll
                    for (int bj = 0; bj < 2; ++bj) *(u32x4*)(ZKV + (size_t)row * 256 + 128 * bj + c8) = pack8(v[bj][0], v[bj][1]);
                    const float s = fq_sum(sq8(v[0][0], v[0][1]) + sq8(v[1][0], v[1][1]));
                    if (fq == 0) SKV[(size_t)row * 4 + wc] = s;
                } else if (pn == 3) {
#pragma unroll
                    for (int bj = 0; bj < 2; ++bj) { f32x4 g0, g1;
#pragma unroll
                        for (int e = 0; e < 4; ++e) { g0[e] = gelu_t(v[bj][0][e]); g1[e] = gelu_t(v[bj][1][e]); }
                        *(u32x4*)(U + (size_t)row * 256 + 128 * bj + c8) = pack8(g0, g1); }
                } else if (pn == 4) {
                    f32x4 g[2][2]; float s = 0.f;
#pragma unroll
                    for (int bj = 0; bj < 2; ++bj)
#pragma unroll
                        for (int n = 0; n < 2; ++n)
#pragma unroll
                            for (int e = 0; e < 4; ++e) { g[bj][n][e] = gelu_t(v[bj][n][e]); s += g[bj][n][e]; }
                    const float mu = fq_sum(s) * (1.0f / 64.0f); float q = 0.f;
#pragma unroll
                    for (int bj = 0; bj < 2; ++bj)
#pragma unroll
                        for (int n = 0; n < 2; ++n)
#pragma unroll
                            for (int e = 0; e < 4; ++e) { g[bj][n][e] -= mu; q += g[bj][n][e] * g[bj][n][e]; }
                    const float rstd = rsqrtf(fq_sum(q) * (1.0f / 64.0f) + EPS);
#pragma unroll
                    for (int bj = 0; bj < 2; ++bj) { const int lc = 64 * wc + 32 * bj + 8 * fq;
                        const f32x4 ga = *(const f32x4*)(lng + lc), gb = *(const f32x4*)(lng + lc + 4), ba = *(const f32x4*)(lnb + lc), bb = *(const f32x4*)(lnb + lc + 4);
                        *(u32x4*)(VS + (size_t)row * 256 + lc) = pack8(g[bj][0] * rstd * ga + ba, g[bj][1] * rstd * gb + bb); }
                } else {
#pragma unroll
                    for (int bj = 0; bj < 2; ++bj) *(u32x4*)(XS + (size_t)row * 256 + 128 * bj + c8) = pack8(v[bj][0], v[bj][1]);
                }
                asm volatile("" ::: "memory");
            }
    }
};
struct EpiQ {
    static constexpr bool PERM = true, AFTER_DRAIN = false;
    const float* SSQ; bf16_t* Q; float* SQH;
    __device__ __forceinline__ void operator()(const f32x4 (&acc)[2][2][4][2], const Unit& u, int wr, int wc, int fr, int fq) const {
        float rqv[2][4];
#pragma unroll
        for (int ai = 0; ai < 2; ++ai)
#pragma unroll
            for (int m = 0; m < 4; ++m) { const f32x2_t p = *(const f32x2_t*)(SSQ + (size_t)EPI_ROW(u, ai, m) * 8 + 2 * fq); rqv[ai][m] = p[0] + p[1]; }
#pragma unroll
        for (int ai = 0; ai < 2; ++ai)
#pragma unroll
            for (int m = 0; m < 4; ++m) rqv[ai][m] = rsqrtf(fq_sum(rqv[ai][m]) * (1.0f / 384.0f) + EPS);
#pragma unroll
        for (int ai = 0; ai < 2; ++ai)
#pragma unroll
            for (int m = 0; m < 4; ++m) {
                const int row = EPI_ROW(u, ai, m); const int b = row / S, s = row % S;
                const float rq = rqv[ai][m];
#pragma unroll
                for (int bj = 0; bj < 2; ++bj) { const int h = 2 * u.pn + bj; const f32x4 v0 = acc[ai][bj][m][0] * rq, v1 = acc[ai][bj][m][1] * rq;
                    if (wc < 3) *(u32x4*)(Q + ((size_t)(b * 8 + h) * S + s) * 96 + 32 * wc + 8 * fq) = pack8(v0, v1);
                    const float ss = fq_sum(sq8(v0, v1));
                    if (fq == 0) st_wt(SQH + (size_t)row * 32 + h * 4 + wc, ss); }
                asm volatile("" ::: "memory");
            }
    }
};
struct EpiKV {
    static constexpr bool PERM = true, AFTER_DRAIN = false;
    const float* SKV; const float* KR; const float* gkh; const float* CS; const float* SN; bf16_t* K; bf16_t* V;
    __device__ __forceinline__ void operator()(const f32x4 (&acc)[2][2][4][2], const Unit& u, int wr, int wc, int fr, int fq) const {
        const int h = 2 * u.pn + (wc >> 1);
#pragma unroll
        for (int ai = 0; ai < 2; ++ai)
#pragma unroll
            for (int m = 0; m < 4; ++m) {
                const int row = EPI_ROW(u, ai, m); const int b = row / S, s = row % S;
                const f32x4 a = *(const f32x4*)(SKV + (size_t)row * 4);
                const float rkv = rsqrtf(((a[0] + a[1]) + (a[2] + a[3])) * (1.0f / 256.0f) + EPS);
                f32x4 v[2][2];
#pragma unroll
                for (int bj = 0; bj < 2; ++bj) { v[bj][0] = acc[ai][bj][m][0] * rkv; v[bj][1] = acc[ai][bj][m][1] * rkv; }
                const size_t hrow = (size_t)(b * 8 + h) * S + s;
                if (wc & 1) {
#pragma unroll
                    for (int bj = 0; bj < 2; ++bj) *(u32x4*)(V + hrow * 64 + 32 * bj + 8 * fq) = pack8(v[bj][0], v[bj][1]);
                } else {
                    const f32x4 k0 = *(const f32x4*)(KR + (size_t)row * 32 + 8 * fq), k1 = *(const f32x4*)(KR + (size_t)row * 32 + 8 * fq + 4);
                    const float ss = fq_sum(sq8(v[0][0], v[0][1]) + sq8(v[1][0], v[1][1]) + sq8(k0, k1));
                    const float rk = rsqrtf(ss * (1.0f / 96.0f) + EPS);
#pragma unroll
                    for (int bj = 0; bj < 2; ++bj) { const int e0 = 32 * bj + 8 * fq; const f32x4 ga = *(const f32x4*)(gkh + e0), gb = *(const f32x4*)(gkh + e0 + 4);
                        *(u32x4*)(K + hrow * 96 + e0) = pack8(v[bj][0] * rk * ga, v[bj][1] * rk * gb); }
                    const f32x4 ga = *(const f32x4*)(gkh + 64 + 8 * fq), gb = *(const f32x4*)(gkh + 64 + 8 * fq + 4);
                    const f32x4 y0 = k0 * rk * ga, y1 = k1 * rk * gb; f32x4 p0, p1;
#pragma unroll
                    for (int e = 0; e < 4; ++e) { p0[e] = shx(y0[e], 32); p1[e] = shx(y1[e], 32); }
                    const int j0 = (8 * fq) & 15;
                    const f32x4 c0 = *(const f32x4*)(CS + (size_t)s * 16 + j0), c1 = *(const f32x4*)(CS + (size_t)s * 16 + j0 + 4), s0 = *(const f32x4*)(SN + (size_t)s * 16 + j0), s1 = *(const f32x4*)(SN + (size_t)s * 16 + j0 + 4);
                    f32x4 o0, o1;
                    if (fq < 2) { o0 = y0 * c0 - p0 * s0; o1 = y1 * c1 - p1 * s1; } else { o0 = p0 * s0 + y0 * c0; o1 = p1 * s1 + y1 * c1; }
                    *(u32x4*)(K + hrow * 96 + 64 + 8 * fq) = pack8(o0, o1);
                }
                asm volatile("" ::: "memory");
            }
    }
};
__device__ __forceinline__ void unpack8(const u32x4 w, f32x4& a, f32x4& b) { a[0] = bflo(w.x); a[1] = bfhi(w.x); a[2] = bflo(w.y); a[3] = bfhi(w.y); b[0] = bflo(w.z); b[1] = bfhi(w.z); b[2] = bflo(w.w); b[3] = bfhi(w.w); }
struct EpiOut {
    static constexpr bool PERM = true, AFTER_DRAIN = false;
    const bf16_t* Hin; bf16_t* Hout; float* SS; const float* SA;
    __device__ __forceinline__ void operator()(const f32x4 (&acc)[2][2][4][2], const Unit& u, int wr, int wc, int fr, int fq) const {
        float rav[2][4];
#pragma unroll
        for (int ai = 0; ai < 2; ++ai)
#pragma unroll
            for (int m = 0; m < 4; ++m) { const f32x2_t p = *(const f32x2_t*)(SA + (size_t)EPI_ROW(u, ai, m) * 8 + 2 * fq); rav[ai][m] = p[0] + p[1]; }
#pragma unroll
        for (int ai = 0; ai < 2; ++ai)
#pragma unroll
            for (int m = 0; m < 4; ++m) rav[ai][m] = rsqrtf(fq_sum(rav[ai][m]) * (1.0f / 512.0f) + EPS);
#pragma unroll
        for (int ai = 0; ai < 2; ++ai)
#pragma unroll
            for (int m = 0; m < 4; ++m) { const int row = EPI_ROW(u, ai, m); float ss = 0.f; const float ra = rav[ai][m];
#pragma unroll
                for (int bj = 0; bj < 2; ++bj) { const size_t off = (size_t)row * DM + u.pn * 256 + 128 * bj + 32 * wc + 8 * fq;
                    f32x4 h0, h1; unpack8(*(const u32x4*)(Hin + off), h0, h1); h0 = h0 + acc[ai][bj][m][0] * ra; h1 = h1 + acc[ai][bj][m][1] * ra;
                    *(u32x4*)(Hout + off) = pack8(h0, h1); ss += sq8(h0, h1); }
                ss = fq_sum(ss); if (fq == 0) st_wt(SS + (size_t)row * 16 + u.pn * 4 + wc, ss); asm volatile("" ::: "memory"); }
    }
};
struct EpiM1 {
    static constexpr bool PERM = true, AFTER_DRAIN = false;
    const float* RS; bf16_t* HBX;
    __device__ __forceinline__ void operator()(const f32x4 (&acc)[2][2][4][2], const Unit& u, int wr, int wc, int fr, int fq) const {
        const int ct = u.pn & 1;
        float rsv[2][4];
#pragma unroll
        for (int ai = 0; ai < 2; ++ai)
#pragma unroll
            for (int m = 0; m < 4; ++m) rsv[ai][m] = RS[EPI_ROW(u, ai, m)];
#pragma unroll
        for (int ai = 0; ai < 2; ++ai)
#pragma unroll
            for (int m = 0; m < 4; ++m) { const int row = EPI_ROW(u, ai, m); const float rs = rsv[ai][m]; f32x4 o[2];
#pragma unroll
                for (int n = 0; n < 2; ++n)
#pragma unroll
                    for (int e = 0; e < 4; ++e) { const float a1 = acc[ai][0][m][n][e] * rs, a3 = acc[ai][1][m][n][e] * rs; o[n][e] = a1 * sigm(a1) * a3; }
                *(u32x4*)(HBX + (size_t)row * 256 + 128 * ct + 32 * wc + 8 * fq) = pack8(o[0], o[1]); asm volatile("" ::: "memory"); }
    }
};
struct EpiM2 {
    static constexpr bool PERM = true, AFTER_DRAIN = false;
    const int* TOK; const float* W; bf16_t* Y;
    __device__ __forceinline__ void operator()(const f32x4 (&acc)[2][2][4][2], const Unit& u, int wr, int wc, int fr, int fq) const {
        const int ct = u.pn & 3;
        int tkv[2][4]; float wv[2][4];
#pragma unroll
        for (int ai = 0; ai < 2; ++ai)
#pragma unroll
            for (int m = 0; m < 4; ++m) { const int row = EPI_ROW(u, ai, m); tkv[ai][m] = TOK[row]; wv[ai][m] = W[row]; }
#pragma unroll
        for (int ai = 0; ai < 2; ++ai)
#pragma unroll
            for (int m = 0; m < 4; ++m) { const int tk = tkv[ai][m]; const float w = wv[ai][m];
                if (tk >= 0) { bf16_t* yr = Y + ((size_t)(tk & 1) * T + (tk >> 1)) * DM + 256 * ct + 32 * wc + 8 * fq;
#pragma unroll
                    for (int bj = 0; bj < 2; ++bj) *(u32x4*)(yr + 128 * bj) = pack8(acc[ai][bj][m][0] * w, acc[ai][bj][m][1] * w); } }
        asm volatile("" ::: "memory");
    }
};
struct EpiPl {
    static constexpr bool PERM = true, AFTER_DRAIN = false;
    bf16_t* PL;
    __device__ __forceinline__ void operator()(const f32x4 (&acc)[2][2][4][2], const Unit& u, int wr, int wc, int fr, int fq) const {
#pragma unroll
        for (int ai = 0; ai < 2; ++ai)
#pragma unroll
            for (int m = 0; m < 4; ++m) { const int row = EPI_ROW(u, ai, m);
#pragma unroll
                for (int bj = 0; bj < 2; ++bj) *(u32x4*)(PL + (size_t)row * DM + u.pn * 256 + 128 * bj + 32 * wc + 8 * fq) = pack8(acc[ai][bj][m][0], acc[ai][bj][m][1]); asm volatile("" ::: "memory"); }
    }
};
struct EpiGate {
    static constexpr bool PERM = true, AFTER_DRAIN = false;
    const bf16_t* Hin; const bf16_t* PL; const float* bpg; bf16_t* Hout; float* SS; float* OutF;
    __device__ __forceinline__ void operator()(const f32x4 (&acc)[2][2][4][2], const Unit& u, int wr, int wc, int fr, int fq) const {
#pragma unroll
        for (int ai = 0; ai < 2; ++ai)
#pragma unroll
            for (int m = 0; m < 4; ++m) { const int row = EPI_ROW(u, ai, m); float ss = 0.f;
#pragma unroll
                for (int bj = 0; bj < 2; ++bj) { const int col = u.pn * 256 + 128 * bj + 32 * wc + 8 * fq; const size_t off = (size_t)row * DM + col;
                    const u32x4 pl = *(const u32x4*)(PL + off); const f32x4 b0 = *(const f32x4*)(bpg + col), b1 = *(const f32x4*)(bpg + col + 4);
                    f32x4 h0, h1; unpack8(*(const u32x4*)(Hin + off), h0, h1);
                    const f32x4 a0 = acc[ai][bj][m][0] + b0, a1 = acc[ai][bj][m][1] + b1;
                    h0[0] += sigm(a0[0]) * bflo(pl.x); h0[1] += sigm(a0[1]) * bfhi(pl.x); h0[2] += sigm(a0[2]) * bflo(pl.y); h0[3] += sigm(a0[3]) * bfhi(pl.y);
                    h1[0] += sigm(a1[0]) * bflo(pl.z); h1[1] += sigm(a1[1]) * bfhi(pl.z); h1[2] += sigm(a1[2]) * bflo(pl.w); h1[3] += sigm(a1[3]) * bfhi(pl.w);
                    if (OutF) { *(f32x4*)(OutF + off) = h0; *(f32x4*)(OutF + off + 4) = h1; }
                    else { *(u32x4*)(Hout + off) = pack8(h0, h1); ss += sq8(h0, h1); } }
                if (!OutF) { ss = fq_sum(ss); if (fq == 0) st_wt(SS + (size_t)row * 16 + u.pn * 4 + wc, ss); } asm volatile("" ::: "memory"); }
    }
};
template <int NCT>
struct MoeOrder {
    const int* TS; int G, c, total;
    __device__ __forceinline__ void init(const int* ts, int G_, int c_) { TS = ts; G = G_; c = c_; total = __builtin_amdgcn_readfirstlane(ts[32]) * NCT; }
    __device__ __forceinline__ bool next(int i, Unit& u) const {
        const int L = i * G + c; if (L >= total) return false;
        const int rt = L / NCT, ct = L % NCT; int e = 0;
        for (int j = 1; j < 32; ++j) e += (__builtin_amdgcn_readfirstlane(TS[j]) <= rt) ? 1 : 0;
        u.pm = rt; u.pn = e * NCT + ct; return true;
    }
    __device__ __forceinline__ void a_ready(const Unit&) const {}
    __device__ __forceinline__ void done(const Unit&) const {}
};
namespace att {
constexpr int KSLOT = 12288, VSLOT = 8192, NSLOT = 3;
constexpr int L_K = 0, L_V = NSLOT * KSLOT, L_WS = L_V + NSLOT * VSLOT, L_OST = L_WS + NW * 64 * 4, L_END = L_OST + NW * 4096;
static_assert(L_END <= RING_BYTES, "attention LDS");
constexpr float C2 = 0.10206207261596577f * 1.4426950408889634f;
__device__ __forceinline__ int crow(int r, int hi) { return (r & 3) + 8 * (r >> 2) + 4 * hi; }
__device__ __forceinline__ void glds16(const void* gsrc, unsigned lds_dst) { unsigned keep;
    asm volatile("s_mov_b32 %0, m0\n\ts_mov_b32 m0, %2\n\ts_nop 0\n\tglobal_load_lds_dwordx4 %1, off\n\ts_mov_b32 m0, %0" : "=&s"(keep) : "v"(gsrc), "s"(lds_dst) : "memory"); }
#define ATT_WAIT_BAR(N) asm volatile("s_waitcnt vmcnt(" #N ") lgkmcnt(0)\n\ts_barrier" ::: "memory")
__device__ __forceinline__ float rowmax32(const f32x16& p0, const f32x16& p1) {
    float a = fmaxf(fmaxf(p0[0], p0[1]), fmaxf(p1[0], p1[1]));
#pragma unroll
    for (int r = 2; r < 16; r += 2) a = fmaxf(a, fmaxf(fmaxf(p0[r], p0[r + 1]), fmaxf(p1[r], p1[r + 1])));
    auto rr = __builtin_amdgcn_permlane32_swap(__float_as_uint(a), __float_as_uint(a), false, false);
    return fmaxf(__uint_as_float(rr[0]), __uint_as_float(rr[1]));
}
__device__ __forceinline__ void pv(f32x16* o, int vb, bf16x8 pa0, bf16x8 pa1, bf16x8 pa2, bf16x8 pa3) {
#pragma unroll
    for (int d0 = 0; d0 < 2; ++d0) { s16x4 lo[4], hi[4];
#pragma unroll
        for (int ks = 0; ks < 4; ++ks) {
            asm volatile("ds_read_b64_tr_b16 %0,%1 offset:%c2" : "=&v"(lo[ks]) : "v"(vb), "i"(d0 * 4096 + ks * 1024) : "memory");
            asm volatile("ds_read_b64_tr_b16 %0,%1 offset:%c2" : "=&v"(hi[ks]) : "v"(vb), "i"(d0 * 4096 + ks * 1024 + 512) : "memory"); }
        asm volatile("s_waitcnt lgkmcnt(0)" ::: "memory"); __builtin_amdgcn_sched_barrier(0);
#define PK(k) (bf16x8){lo[k][0], lo[k][1], lo[k][2], lo[k][3], hi[k][0], hi[k][1], hi[k][2], hi[k][3]}
        o[d0] = __builtin_amdgcn_mfma_f32_32x32x16_bf16(pa0, PK(0), o[d0], 0, 0, 0);
        o[d0] = __builtin_amdgcn_mfma_f32_32x32x16_bf16(pa1, PK(1), o[d0], 0, 0, 0);
        o[d0] = __builtin_amdgcn_mfma_f32_32x32x16_bf16(pa2, PK(2), o[d0], 0, 0, 0);
        o[d0] = __builtin_amdgcn_mfma_f32_32x32x16_bf16(pa3, PK(3), o[d0], 0, 0, 0);
#undef PK
    }
}
__device__ __forceinline__ void attn_unit(int b, int h, int qb, const bf16_t* Q, const float* SQH, const float* gqh, const float* CS, const float* SN,
                                          const bf16_t* __restrict__ K, const bf16_t* __restrict__ V, bf16_t* MIX, float* SA, char* shm) {
    const int tid = opaque_tid(), lane = tid & 63, r32 = lane & 31, hi = lane >> 5; const int wid = __builtin_amdgcn_readfirstlane(tid >> 6);
    const int q0 = qb * 256; const size_t hbase = (size_t)(b * 8 + h) * S;
    const bf16_t* Kh = K + hbase * 96; const bf16_t* Vh = V + hbase * 64;
    const unsigned lds0 = (unsigned)(uintptr_t)shm;
    LAS float* wsf = (LAS float*)((LAS char*)shm + L_WS) + wid * 64;
    const bf16_t* ksrc0 = Kh + (size_t)lane * 96 + wid * 8; const bf16_t* ksrc1 = Kh + (size_t)lane * 96 + (8 + (wid & 3)) * 8;
    const bf16_t* vsrc = Vh + (size_t)(16 * (wid & 3) + (lane >> 2)) * 64 + (wid >> 2) * 32 + (lane & 3) * 8;
    const unsigned kdst0 = lds0 + L_K + wid * 1024, kdst1 = lds0 + L_K + (8 + (wid & 3)) * 1024, vdst = lds0 + L_V + wid * 1024;
#define ATT_DMA(t, sl) do { glds16(ksrc0 + (size_t)(t) * 64 * 96, (unsigned)__builtin_amdgcn_readfirstlane(kdst0 + (sl) * KSLOT)); \
        glds16(ksrc1 + (size_t)(t) * 64 * 96, (unsigned)__builtin_amdgcn_readfirstlane(kdst1 + (sl) * KSLOT)); \
        glds16(vsrc + (size_t)(t) * 64 * 64, (unsigned)__builtin_amdgcn_readfirstlane(vdst + (sl) * VSLOT)); } while (0)
    const int NT = (q0 + 256) / 64;
    ATT_DMA(0, 0); ATT_DMA(1, 1);
    const int qrow = q0 + wid * 32 + r32; const int trow = b * S + qrow;
    bf16x8 qr[6];
    { const f32x4 sp = *(const f32x4*)(SQH + (size_t)trow * 32 + h * 4);
      const float rq = rsqrtf(((sp[0] + sp[1]) + (sp[2] + sp[3])) * (1.0f / 96.0f) + EPS) * C2;
      const bf16_t* qp = Q + (hbase + qrow) * 96 + hi * 8;
      float qf[6][8];
#pragma unroll
      for (int d0 = 0; d0 < 6; ++d0) { const u32x4 w = *(const u32x4*)(qp + d0 * 16); const f32x4 g0 = *(const f32x4*)(gqh + d0 * 16 + hi * 8), g1 = *(const f32x4*)(gqh + d0 * 16 + hi * 8 + 4);
          qf[d0][0] = bflo(w.x) * rq * g0[0]; qf[d0][1] = bfhi(w.x) * rq * g0[1]; qf[d0][2] = bflo(w.y) * rq * g0[2]; qf[d0][3] = bfhi(w.y) * rq * g0[3];
          qf[d0][4] = bflo(w.z) * rq * g1[0]; qf[d0][5] = bfhi(w.z) * rq * g1[1]; qf[d0][6] = bflo(w.w) * rq * g1[2]; qf[d0][7] = bfhi(w.w) * rq * g1[3]; }
      const f32x4 c0 = *(const f32x4*)(CS + (size_t)qrow * 16 + 8 * hi), c1 = *(const f32x4*)(CS + (size_t)qrow * 16 + 8 * hi + 4), s0 = *(const f32x4*)(SN + (size_t)qrow * 16 + 8 * hi), s1 = *(const f32x4*)(SN + (size_t)qrow * 16 + 8 * hi + 4);
#pragma unroll
      for (int e = 0; e < 8; ++e) { const float c = e < 4 ? c0[e & 3] : c1[e & 3], sn = e < 4 ? s0[e & 3] : s1[e & 3]; const float x1 = qf[4][e], x2 = qf[5][e]; qf[4][e] = x1 * c - x2 * sn; qf[5][e] = x1 * sn + x2 * c; }
#pragma unroll
      for (int d0 = 0; d0 < 6; ++d0) { u32x4 w; w.x = pk2(qf[d0][0], qf[d0][1]); w.y = pk2(qf[d0][2], qf[d0][3]); w.z = pk2(qf[d0][4], qf[d0][5]); w.w = pk2(qf[d0][6], qf[d0][7]); qr[d0] = __builtin_bit_cast(bf16x8, w); } }
    float mrun = 0.f, l_reg = 0.f; f32x16 o[2]; o[0] = f32x16{}; o[1] = f32x16{};
    const int qrel = wid * 32 + r32;
    const int vb0 = (int)(lds0 + L_V) + ((lane >> 4) & 1) * 32 + (lane & 3) * 8 + (4 * hi + ((lane & 15) >> 2)) * 64;
    int slot = 0;
    for (int t = 0; t < NT; ++t) {
        if (t + 1 < NT) { ATT_WAIT_BAR(3); } else { ATT_WAIT_BAR(0); }
        if (t + 2 < NT) { const int s2 = (slot + 2 >= NSLOT) ? slot + 2 - NSLOT : slot + 2; ATT_DMA(t + 2, s2); }
        const int jb = t - (NT - 4);
        if (!(jb >= 0 && 64 * jb > wid * 32 + 31)) {
            const LAS char* kb = (const LAS char*)shm + L_K + slot * KSLOT + hi * 1024 + r32 * 16;
            f32x16 p0 = f32x16{}, p1 = f32x16{};
#pragma unroll
            for (int d0 = 0; d0 < 6; ++d0) { const bf16x8 b0 = *(const LAS bf16x8*)(kb + d0 * 2048), b1 = *(const LAS bf16x8*)(kb + d0 * 2048 + 512);
                p0 = __builtin_amdgcn_mfma_f32_32x32x16_bf16(b0, qr[d0], p0, 0, 0, 0); p1 = __builtin_amdgcn_mfma_f32_32x32x16_bf16(b1, qr[d0], p1, 0, 0, 0); }
            if (jb >= 0) { const int kb0 = 64 * jb + 4 * hi;
#pragma unroll
                for (int r = 0; r < 16; ++r) { const int kv = kb0 + (r & 3) + 8 * (r >> 2); if (kv > qrel) p0[r] = -INFINITY; if (kv + 32 > qrel) p1[r] = -INFINITY; } }
            const float rm = rowmax32(p0, p1);
            if (t == 0) { mrun = rm; }
            else if (__any(rm > mrun + 8.0f)) { const float mn = fmaxf(mrun, rm); const float f = __builtin_amdgcn_exp2f(mrun - mn); l_reg *= f; mrun = mn; if (hi == 0) wsf[r32] = f; LDS_WAIT();
#pragma unroll
                for (int d_ = 0; d_ < 2; ++d_)
#pragma unroll
                    for (int r = 0; r < 16; ++r) o[d_][r] *= wsf[crow(r, hi)]; }
            float sacc = 0.f;
#pragma unroll
            for (int r = 0; r < 16; ++r) { p0[r] = __builtin_amdgcn_exp2f(p0[r] - mrun); p1[r] = __builtin_amdgcn_exp2f(p1[r] - mrun); sacc += p0[r] + p1[r]; }
            l_reg += sacc;
            u32x4 pw0, pw1, pw2, pw3;
            pw0 = (u32x4){pk2(p0[0], p0[1]), pk2(p0[2], p0[3]), pk2(p0[4], p0[5]), pk2(p0[6], p0[7])}; pw1 = (u32x4){pk2(p0[8], p0[9]), pk2(p0[10], p0[11]), pk2(p0[12], p0[13]), pk2(p0[14], p0[15])};
            pw2 = (u32x4){pk2(p1[0], p1[1]), pk2(p1[2], p1[3]), pk2(p1[4], p1[5]), pk2(p1[6], p1[7])}; pw3 = (u32x4){pk2(p1[8], p1[9]), pk2(p1[10], p1[11]), pk2(p1[12], p1[13]), pk2(p1[14], p1[15])};
            pv(o, vb0 + slot * VSLOT, __builtin_bit_cast(bf16x8, pw0), __builtin_bit_cast(bf16x8, pw1), __builtin_bit_cast(bf16x8, pw2), __builtin_bit_cast(bf16x8, pw3));
        }
        slot = (slot + 1 >= NSLOT) ? 0 : slot + 1;
    }
    { auto rr = __builtin_amdgcn_permlane32_swap(__float_as_uint(l_reg), __float_as_uint(l_reg), false, false); l_reg = __uint_as_float(rr[0]) + __uint_as_float(rr[1]); }
    if (hi == 0) wsf[32 + r32] = l_reg; LDS_WAIT();
    float rli[16];
#pragma unroll
    for (int r = 0; r < 16; ++r) rli[r] = __builtin_amdgcn_rcpf(wsf[32 + crow(r, hi)]);
    { LAS bf16_t* stg = (LAS bf16_t*)((LAS char*)shm + L_OST) + wid * 2048;
#pragma unroll
      for (int r = 0; r < 16; ++r) { const int orow = crow(r, hi);
#pragma unroll
          for (int d0 = 0; d0 < 2; ++d0) stg[orow * 64 + d0 * 32 + r32] = (bf16_t)f2bf(o[d0][r] * rli[r]); }
      LDS_WAIT();
#pragma unroll
      for (int i = 0; i < 4; ++i) { const int row = i * 8 + (lane >> 3), ch = lane & 7; const u32x4 v = *(const LAS u32x4*)(stg + row * 64 + ch * 8);
          const size_t tr = (size_t)b * S + q0 + wid * 32 + row;
          *(u32x4*)(MIX + tr * DM + h * 64 + ch * 8) = v;
          float ss = bflo(v.x) * bflo(v.x) + bfhi(v.x) * bfhi(v.x) + bflo(v.y) * bflo(v.y) + bfhi(v.y) * bfhi(v.y) + bflo(v.z) * bflo(v.z) + bfhi(v.z) * bfhi(v.z) + bflo(v.w) * bflo(v.w) + bfhi(v.w) * bfhi(v.w);
          ss += shx(ss, 1); ss += shx(ss, 2); ss += shx(ss, 4);
          if (ch == 0) st_wt(SA + tr * 8 + h, ss); } }
    asm volatile("s_waitcnt lgkmcnt(0)\n\ts_barrier" ::: "memory");
#undef ATT_DMA
}

#define A3_SB() __builtin_amdgcn_sched_barrier(0)
#define A3_PIN(x) asm volatile("" : "+v"(x))
#define A3_EX(v) __builtin_amdgcn_exp2f(v)
__device__ __forceinline__ void attn_unit3(int b, int h, int qb, const bf16_t* Q, const float* SQH, const float* gqh, const float* CS, const float* SN,
                                           const bf16_t* __restrict__ K, const bf16_t* __restrict__ V, bf16_t* MIX, float* SA, char* shm) {
    const int tid = opaque_tid(), lane = tid & 63, r32 = lane & 31, hi = lane >> 5; const int wid = __builtin_amdgcn_readfirstlane(tid >> 6);
    const int q0 = qb * 256; const size_t hbase = (size_t)(b * 8 + h) * S;
    const bf16_t* Kh = K + hbase * 96; const bf16_t* Vh = V + hbase * 64;
    const unsigned lds0 = (unsigned)(uintptr_t)shm;
    LAS float* wsf = (LAS float*)((LAS char*)shm + L_WS) + wid * 64;
    const bf16_t* ksrc0 = Kh + (size_t)lane * 96 + wid * 8; const bf16_t* ksrc1 = Kh + (size_t)lane * 96 + (8 + (wid & 3)) * 8;
    const bf16_t* vsrc = Vh + (size_t)(16 * (wid & 3) + (lane >> 2)) * 64 + (wid >> 2) * 32 + (lane & 3) * 8;
    const unsigned kdst0 = lds0 + L_K + wid * 1024, kdst1 = lds0 + L_K + (8 + (wid & 3)) * 1024, vdst = lds0 + L_V + wid * 1024;
#define A3_DMAK(t, sl) do { glds16(ksrc0 + (size_t)(t) * 64 * 96, (unsigned)__builtin_amdgcn_readfirstlane(kdst0 + (sl) * KSLOT)); \
        glds16(ksrc1 + (size_t)(t) * 64 * 96, (unsigned)__builtin_amdgcn_readfirstlane(kdst1 + (sl) * KSLOT)); } while (0)
#define A3_DMAV(t, sl) glds16(vsrc + (size_t)(t) * 64 * 64, (unsigned)__builtin_amdgcn_readfirstlane(vdst + (sl) * VSLOT))
    const int NT = (q0 + 256) / 64;
    A3_DMAK(0, 0); A3_DMAK(1, 1); A3_DMAK(2, 2); A3_DMAV(0, 0); A3_DMAV(1, 1);
    const int qrow = q0 + wid * 32 + r32; const int trow = b * S + qrow;
    bf16x8 qr[6];
    { const f32x4 sp = *(const f32x4*)(SQH + (size_t)trow * 32 + h * 4);
      const float rq = rsqrtf(((sp[0] + sp[1]) + (sp[2] + sp[3])) * (1.0f / 96.0f) + EPS) * C2;
      const bf16_t* qp = Q + (hbase + qrow) * 96 + hi * 8;
      float qf[6][8];
#pragma unroll
      for (int d0 = 0; d0 < 6; ++d0) { const u32x4 w = *(const u32x4*)(qp + d0 * 16); const f32x4 g0 = *(const f32x4*)(gqh + d0 * 16 + hi * 8), g1 = *(const f32x4*)(gqh + d0 * 16 + hi * 8 + 4);
          qf[d0][0] = bflo(w.x) * rq * g0[0]; qf[d0][1] = bfhi(w.x) * rq * g0[1]; qf[d0][2] = bflo(w.y) * rq * g0[2]; qf[d0][3] = bfhi(w.y) * rq * g0[3];
          qf[d0][4] = bflo(w.z) * rq * g1[0]; qf[d0][5] = bfhi(w.z) * rq * g1[1]; qf[d0][6] = bflo(w.w) * rq * g1[2]; qf[d0][7] = bfhi(w.w) * rq * g1[3]; }
      const f32x4 c0 = *(const f32x4*)(CS + (size_t)qrow * 16 + 8 * hi), c1 = *(const f32x4*)(CS + (size_t)qrow * 16 + 8 * hi + 4), s0 = *(const f32x4*)(SN + (size_t)qrow * 16 + 8 * hi), s1 = *(const f32x4*)(SN + (size_t)qrow * 16 + 8 * hi + 4);
#pragma unroll
      for (int e = 0; e < 8; ++e) { const float c = e < 4 ? c0[e & 3] : c1[e & 3], sn = e < 4 ? s0[e & 3] : s1[e & 3]; const float x1 = qf[4][e], x2 = qf[5][e]; qf[4][e] = x1 * c - x2 * sn; qf[5][e] = x1 * sn + x2 * c; }
#pragma unroll
      for (int d0 = 0; d0 < 6; ++d0) { u32x4 w; w.x = pk2(qf[d0][0], qf[d0][1]); w.y = pk2(qf[d0][2], qf[d0][3]); w.z = pk2(qf[d0][4], qf[d0][5]); w.w = pk2(qf[d0][6], qf[d0][7]); qr[d0] = __builtin_bit_cast(bf16x8, w); } }
    float l_reg = 0.f; f32x16 o[2]; o[0] = f32x16{}; o[1] = f32x16{};
    const int qrel = wid * 32 + r32;
    const int vb0 = (int)(lds0 + L_V) + ((lane >> 4) & 1) * 32 + (lane & 3) * 8 + (4 * hi + ((lane & 15) >> 2)) * 64;
    const LAS char* kbase = (const LAS char*)shm + L_K + hi * 1024 + r32 * 16;
#define A3_MASK(C0_, C1_, tt) do { const int jb_ = (tt) - (NT - 4); if (jb_ >= 0) { const int kb0_ = 64 * jb_ + 4 * hi; \
        _Pragma("unroll") for (int r = 0; r < 16; ++r) { const int kv_ = kb0_ + (r & 3) + 8 * (r >> 2); if (kv_ > qrel) C0_[r] = -INFINITY; if (kv_ + 32 > qrel) C1_[r] = -INFINITY; } } } while (0)
#define A3_KLOAD(j, kb_) do { kf[2 * (j)] = *(const LAS bf16x8*)((kb_) + (j) * 2048); kf[2 * (j) + 1] = *(const LAS bf16x8*)((kb_) + (j) * 2048 + 512); } while (0)
    f32x16 P0, P1; bf16x8 kf[12];
    asm volatile("s_waitcnt vmcnt(0) lgkmcnt(0)\n\ts_barrier" ::: "memory");
    { P0 = f32x16{}; P1 = f32x16{};
#pragma unroll
      for (int d0 = 0; d0 < 6; ++d0) { const bf16x8 b0 = *(const LAS bf16x8*)(kbase + d0 * 2048), b1 = *(const LAS bf16x8*)(kbase + d0 * 2048 + 512);
          P0 = __builtin_amdgcn_mfma_f32_32x32x16_bf16(b0, qr[d0], P0, 0, 0, 0); P1 = __builtin_amdgcn_mfma_f32_32x32x16_bf16(b1, qr[d0], P1, 0, 0, 0); }
      A3_MASK(P0, P1, 0);
      const LAS char* kb1 = kbase + KSLOT;
#pragma unroll
      for (int j = 0; j < 6; ++j) A3_KLOAD(j, kb1); }
    asm volatile("s_waitcnt lgkmcnt(0)\n\ts_barrier" ::: "memory");
    A3_DMAK(3, 0);
    int ks = 2, vs = 0;
#define A3_GA0(MF, X, e0) do { MF; X[e0] = A3_EX(X[e0]); X[(e0) + 1] = A3_EX(X[(e0) + 1]); A3_PIN(X); A3_SB(); } while (0)
#define A3_GA(MF, X, e0, Y, f0) do { MF; X[e0] = A3_EX(X[e0]); X[(e0) + 1] = A3_EX(X[(e0) + 1]); sacc += Y[f0] + Y[(f0) + 1]; A3_PIN(X); A3_PIN(sacc); A3_SB(); } while (0)
#define A3_VRD(i) do { asm volatile("ds_read_b64_tr_b16 %0,%1 offset:%c2" : "=&v"(vl[i]) : "v"(vb), "i"(((i) & 1) * 4096 + ((i) >> 1) * 1024) : "memory"); \
                        asm volatile("ds_read_b64_tr_b16 %0,%1 offset:%c2" : "=&v"(vh[i]) : "v"(vb), "i"(((i) & 1) * 4096 + ((i) >> 1) * 1024 + 512) : "memory"); } while (0)
#define A3_VF(i) (bf16x8){vl[i][0], vl[i][1], vl[i][2], vl[i][3], vh[i][0], vh[i][1], vh[i][2], vh[i][3]}
#define A3_LW(n) asm volatile("s_waitcnt lgkmcnt(" #n ")" ::: "memory")
#define A3_STEP(PA0, PA1, CA0, CA1, tt) do { \
        if ((tt) + 3 < NT) { asm volatile("s_waitcnt vmcnt(3) lgkmcnt(0)\n\ts_barrier" ::: "memory"); } \
        else if ((tt) + 1 < NT) { asm volatile("s_waitcnt vmcnt(1) lgkmcnt(0)\n\ts_barrier" ::: "memory"); } \
        else { asm volatile("s_waitcnt vmcnt(0) lgkmcnt(0)\n\ts_barrier" ::: "memory"); } \
        const int ks4 = (ks + 2 >= 3) ? ks - 1 : ks + 2; \
        const int vs2 = (vs + 2 >= 3) ? vs - 1 : vs + 2; \
        if ((tt) + 2 < NT) A3_DMAV((tt) + 2, vs2); \
        const bool has_next = ((tt) + 1 < NT); \
        CA0 = f32x16{}; CA1 = f32x16{}; \
        u32x4 pw0, pw1, pw2, pw3; float sacc = 0.f; \
        const int vb = vb0 + vs * VSLOT; s16x4 vl[8], vh[8]; \
        { \
            A3_SB(); A3_VRD(0); A3_VRD(1); A3_VRD(2); A3_SB(); \
            A3_GA0(CA0 = __builtin_amdgcn_mfma_f32_32x32x16_bf16(kf[0], qr[0], CA0, 0, 0, 0), PA0, 0); \
            A3_GA(CA1 = __builtin_amdgcn_mfma_f32_32x32x16_bf16(kf[1], qr[0], CA1, 0, 0, 0), PA0, 2, PA0, 0); \
            A3_GA(CA0 = __builtin_amdgcn_mfma_f32_32x32x16_bf16(kf[2], qr[1], CA0, 0, 0, 0), PA0, 4, PA0, 2); \
            A3_GA(CA1 = __builtin_amdgcn_mfma_f32_32x32x16_bf16(kf[3], qr[1], CA1, 0, 0, 0), PA0, 6, PA0, 4); \
            A3_GA(CA0 = __builtin_amdgcn_mfma_f32_32x32x16_bf16(kf[4], qr[2], CA0, 0, 0, 0), PA0, 8, PA0, 6); \
            pw0 = (u32x4){pk2(PA0[0], PA0[1]), pk2(PA0[2], PA0[3]), pk2(PA0[4], PA0[5]), pk2(PA0[6], PA0[7])}; A3_PIN(pw0); \
            A3_GA(CA1 = __builtin_amdgcn_mfma_f32_32x32x16_bf16(kf[5], qr[2], CA1, 0, 0, 0), PA0, 10, PA0, 8); \
            A3_GA(CA0 = __builtin_amdgcn_mfma_f32_32x32x16_bf16(kf[6], qr[3], CA0, 0, 0, 0), PA0, 12, PA0, 10); \
            A3_GA(CA1 = __builtin_amdgcn_mfma_f32_32x32x16_bf16(kf[7], qr[3], CA1, 0, 0, 0), PA0, 14, PA0, 12); \
            A3_GA(CA0 = __builtin_amdgcn_mfma_f32_32x32x16_bf16(kf[8], qr[4], CA0, 0, 0, 0), PA1, 0, PA0, 14); \
            pw1 = (u32x4){pk2(PA0[8], PA0[9]), pk2(PA0[10], PA0[11]), pk2(PA0[12], PA0[13]), pk2(PA0[14], PA0[15])}; A3_PIN(pw1); \
            A3_GA(CA1 = __builtin_amdgcn_mfma_f32_32x32x16_bf16(kf[9], qr[4], CA1, 0, 0, 0), PA1, 2, PA1, 0); \
            A3_GA(CA0 = __builtin_amdgcn_mfma_f32_32x32x16_bf16(kf[10], qr[5], CA0, 0, 0, 0), PA1, 4, PA1, 2); \
            A3_GA(CA1 = __builtin_amdgcn_mfma_f32_32x32x16_bf16(kf[11], qr[5], CA1, 0, 0, 0), PA1, 6, PA1, 4); \
        } \
        { const LAS char* kb2 = kbase + ks * KSLOT; \
          A3_SB(); A3_LW(4); A3_SB(); \
          o[0] = __builtin_amdgcn_mfma_f32_32x32x16_bf16(__builtin_bit_cast(bf16x8, pw0), A3_VF(0), o[0], 0, 0, 0); \
          PA1[8] = A3_EX(PA1[8]); PA1[9] = A3_EX(PA1[9]); sacc += PA1[6] + PA1[7]; A3_PIN(PA1); A3_PIN(sacc); A3_SB(); \
          A3_VRD(3); A3_SB(); A3_LW(4); A3_SB(); \
          o[1] = __builtin_amdgcn_mfma_f32_32x32x16_bf16(__builtin_bit_cast(bf16x8, pw0), A3_VF(1), o[1], 0, 0, 0); \
          PA1[10] = A3_EX(PA1[10]); PA1[11] = A3_EX(PA1[11]); sacc += PA1[8] + PA1[9]; A3_PIN(PA1); A3_PIN(sacc); \
          pw2 = (u32x4){pk2(PA1[0], PA1[1]), pk2(PA1[2], PA1[3]), pk2(PA1[4], PA1[5]), pk2(PA1[6], PA1[7])}; A3_PIN(pw2); A3_SB(); \
          A3_VRD(4); A3_SB(); A3_LW(4); A3_SB(); \
          o[0] = __builtin_amdgcn_mfma_f32_32x32x16_bf16(__builtin_bit_cast(bf16x8, pw1), A3_VF(2), o[0], 0, 0, 0); \
          PA1[12] = A3_EX(PA1[12]); PA1[13] = A3_EX(PA1[13]); sacc += PA1[10] + PA1[11]; A3_PIN(PA1); A3_PIN(sacc); A3_SB(); \
          A3_VRD(5); A3_SB(); A3_LW(4); A3_SB(); \
          o[1] = __builtin_amdgcn_mfma_f32_32x32x16_bf16(__builtin_bit_cast(bf16x8, pw1), A3_VF(3), o[1], 0, 0, 0); \
          PA1[14] = A3_EX(PA1[14]); PA1[15] = A3_EX(PA1[15]); sacc += PA1[12] + PA1[13]; A3_PIN(PA1); A3_PIN(sacc); A3_SB(); \
          A3_VRD(6); A3_SB(); A3_LW(4); A3_SB(); \
          o[0] = __builtin_amdgcn_mfma_f32_32x32x16_bf16(__builtin_bit_cast(bf16x8, pw2), A3_VF(4), o[0], 0, 0, 0); \
          sacc += PA1[14] + PA1[15]; A3_PIN(sacc); \
          pw3 = (u32x4){pk2(PA1[8], PA1[9]), pk2(PA1[10], PA1[11]), pk2(PA1[12], PA1[13]), pk2(PA1[14], PA1[15])}; A3_PIN(pw3); A3_SB(); \
          A3_VRD(7); A3_SB(); A3_LW(4); A3_SB(); \
          o[1] = __builtin_amdgcn_mfma_f32_32x32x16_bf16(__builtin_bit_cast(bf16x8, pw2), A3_VF(5), o[1], 0, 0, 0); A3_SB(); \
          A3_KLOAD(0, kb2); A3_KLOAD(1, kb2); A3_KLOAD(2, kb2); A3_SB(); \
          A3_LW(8); A3_SB(); \
          o[0] = __builtin_amdgcn_mfma_f32_32x32x16_bf16(__builtin_bit_cast(bf16x8, pw3), A3_VF(6), o[0], 0, 0, 0); A3_SB(); \
          if ((tt) + 4 < NT) { A3_DMAK((tt) + 4, ks4); } A3_SB(); \
          A3_KLOAD(3, kb2); A3_KLOAD(4, kb2); A3_KLOAD(5, kb2); A3_SB(); \
          A3_LW(12); A3_SB(); \
          o[1] = __builtin_amdgcn_mfma_f32_32x32x16_bf16(__builtin_bit_cast(bf16x8, pw3), A3_VF(7), o[1], 0, 0, 0); A3_SB(); \
        } \
        l_reg += sacc; \
        if (has_next) { A3_MASK(CA0, CA1, (tt) + 1); } \
        ks = (ks + 1 >= 3) ? 0 : ks + 1; vs = (vs + 1 >= 3) ? 0 : vs + 1; \
    } while (0)
    f32x16 C0, C1;
#if MK_ATT_PRIO
    if (wid >= 4) __builtin_amdgcn_s_setprio(1);
#endif
#pragma unroll 1
    for (int t = 0; t < NT; t += 2) { A3_STEP(P0, P1, C0, C1, t); A3_STEP(C0, C1, P0, P1, t + 1); }
#if MK_ATT_PRIO
    __builtin_amdgcn_s_setprio(0);
#endif
#undef A3_STEP
#undef A3_GA
#undef A3_GA0
#undef A3_VRD
#undef A3_VF
#undef A3_LW
    { auto rr = __builtin_amdgcn_permlane32_swap(__float_as_uint(l_reg), __float_as_uint(l_reg), false, false); l_reg = __uint_as_float(rr[0]) + __uint_as_float(rr[1]); }
    if (hi == 0) wsf[32 + r32] = l_reg; LDS_WAIT();
    float rli[16];
#pragma unroll
    for (int r = 0; r < 16; ++r) rli[r] = __builtin_amdgcn_rcpf(wsf[32 + crow(r, hi)]);
    { LAS bf16_t* stg = (LAS bf16_t*)((LAS char*)shm + L_OST) + wid * 2048;
#pragma unroll
      for (int r = 0; r < 16; ++r) { const int orow = crow(r, hi);
#pragma unroll
          for (int d0 = 0; d0 < 2; ++d0) stg[orow * 64 + d0 * 32 + r32] = (bf16_t)f2bf(o[d0][r] * rli[r]); }
      LDS_WAIT();
#pragma unroll
      for (int i = 0; i < 4; ++i) { const int row = i * 8 + (lane >> 3), ch = lane & 7; const u32x4 v = *(const LAS u32x4*)(stg + row * 64 + ch * 8);
          const size_t tr = (size_t)b * S + q0 + wid * 32 + row;
          *(u32x4*)(MIX + tr * DM + h * 64 + ch * 8) = v;
          float ss = bflo(v.x) * bflo(v.x) + bfhi(v.x) * bfhi(v.x) + bflo(v.y) * bflo(v.y) + bfhi(v.y) * bfhi(v.y) + bflo(v.z) * bflo(v.z) + bfhi(v.z) * bfhi(v.z) + bflo(v.w) * bflo(v.w) + bfhi(v.w) * bfhi(v.w);
          ss += shx(ss, 1); ss += shx(ss, 2); ss += shx(ss, 4);
          if (ch == 0) st_wt(SA + tr * 8 + h, ss); } }
    asm volatile("s_waitcnt lgkmcnt(0)\n\ts_barrier" ::: "memory");
#undef A3_DMAK
#undef A3_DMAV
#undef A3_MASK
#undef A3_KLOAD
}
}

__device__ __forceinline__ float inv_ra(const float* SA, size_t t) { const f32x4 s0 = *(const f32x4*)(SA + t * 8), s1 = *(const f32x4*)(SA + t * 8 + 4);
    return sqrtf((((s0[0] + s0[1]) + (s0[2] + s0[3])) + ((s1[0] + s1[1]) + (s1[2] + s1[3]))) * (1.0f / 512.0f) + EPS); }
__device__ __forceinline__ void gmlp_unit(const Frame& F, int ci, const bf16_t* U, const bf16_t* VS, const bf16_t* Wsg, const float* sgb, const float* gm, bf16_t* MIX, const float* SA) {
    LAS unsigned char* lds = F.lds; const int tid = F.tid, lane = F.lane, wid = F.wave, r32 = lane & 31, hi = lane >> 5;
    const size_t t0 = (size_t)ci * 128;
#pragma unroll
    for (int j = 0; j < 8; ++j) { const int g = j >> 1, sh = j & 1;
        const u32x4 v = *(const u32x4*)(VS + (t0 + 64 * sh + 16 * (wid & 3) + (lane >> 2)) * 256 + g * 64 + (wid >> 2) * 32 + (lane & 3) * 8);
        *(LAS u32x4*)(lds + j * 8192 + wid * 1024 + lane * 16) = v; }
#pragma unroll
    for (int i = 0; i < 8; ++i) { const int piece = wid + 8 * i; const u32x4 v = *(const u32x4*)(U + t0 * 256 + (size_t)piece * 512 + lane * 8); *(LAS u32x4*)(lds + 65536 + piece * 1024 + lane * 16) = v; }
    LDS_WAIT(); __syncthreads();
    const int g = wid >> 1, th = wid & 1;
    f32x16 acc[2][2];
#pragma unroll
    for (int mb = 0; mb < 2; ++mb) { acc[mb][0] = f32x16{}; acc[mb][1] = f32x16{}; }
    const int vbl = ((lane >> 4) & 1) * 32 + (lane & 3) * 8 + (4 * hi + ((lane & 15) >> 2)) * 64;
    const unsigned ldsb = (unsigned)(uintptr_t)(char*)lds;
#pragma unroll
    for (int mb = 0; mb < 2; ++mb) { const int tb = 64 * th + 32 * mb; const int nks = (tb + 32) / 16;
        const bf16_t* wrow = Wsg + ((size_t)g * 128 + tb + r32) * 128 + 8 * hi;
        bf16x8 af[8];
#pragma unroll
        for (int ks = 0; ks < 8; ++ks) if (ks < nks) af[ks] = *(const bf16x8*)(wrow + 16 * ks);
#pragma unroll
        for (int ks = 0; ks < 8; ++ks) if (ks < nks) { const bf16x8 a = af[ks];
            const int vb = (int)ldsb + (g * 2 + (ks >> 2)) * 8192 + (ks & 3) * 1024 + vbl;
            s16x4 lo0, hi0, lo1, hi1;
            asm volatile("ds_read_b64_tr_b16 %0,%1" : "=&v"(lo0) : "v"(vb) : "memory");
            asm volatile("ds_read_b64_tr_b16 %0,%1 offset:512" : "=&v"(hi0) : "v"(vb) : "memory");
            asm volatile("ds_read_b64_tr_b16 %0,%1 offset:4096" : "=&v"(lo1) : "v"(vb) : "memory");
            asm volatile("ds_read_b64_tr_b16 %0,%1 offset:4608" : "=&v"(hi1) : "v"(vb) : "memory");
            asm volatile("s_waitcnt lgkmcnt(0)" ::: "memory"); __builtin_amdgcn_sched_barrier(0);
            acc[mb][0] = __builtin_amdgcn_mfma_f32_32x32x16_bf16(a, (bf16x8){lo0[0], lo0[1], lo0[2], lo0[3], hi0[0], hi0[1], hi0[2], hi0[3]}, acc[mb][0], 0, 0, 0);
            acc[mb][1] = __builtin_amdgcn_mfma_f32_32x32x16_bf16(a, (bf16x8){lo1[0], lo1[1], lo1[2], lo1[3], hi1[0], hi1[1], hi1[2], hi1[3]}, acc[mb][1], 0, 0, 0); } }
    MFMA_PAD(acc[0][0]); MFMA_PAD(acc[0][1]); MFMA_PAD(acc[1][0]); MFMA_PAD(acc[1][1]);
    __syncthreads();
#pragma unroll
    for (int mb = 0; mb < 2; ++mb)
#pragma unroll
        for (int r = 0; r < 16; ++r) { const int t = 64 * th + 32 * mb + att::crow(r, hi); const float bias = sgb[g * 128 + t];
#pragma unroll
            for (int d0 = 0; d0 < 2; ++d0) { const int c = g * 64 + 32 * d0 + r32; const float u = bf2f(*(const LAS bf16_t*)(lds + 65536 + t * 512 + c * 2));
                *(LAS bf16_t*)(lds + t * 512 + c * 2) = (bf16_t)f2bf(u * (acc[mb][d0][r] + bias)); } }
    LDS_WAIT(); __syncthreads();
#pragma unroll 4
    for (int i = 0; i < 16; ++i) { const int row = wid * 16 + i; const u32x2 w = *(const LAS u32x2*)(lds + row * 512 + lane * 8);
        const float a0 = bflo(w.x), a1 = bfhi(w.x), a2 = bflo(w.y), a3 = bfhi(w.y);
        const float rg = rsqrtf(wave_sum((a0 * a0 + a1 * a1) + (a2 * a2 + a3 * a3)) * (1.0f / 256.0f) + EPS) * inv_ra(SA, t0 + row); const f32x4 gg = *(const f32x4*)(gm + 512 + 4 * lane);
        u32x2 o; o.x = pk2(a0 * rg * gg[0], a1 * rg * gg[1]); o.y = pk2(a2 * rg * gg[2], a3 * rg * gg[3]);
        *(u32x2*)(MIX + (t0 + row) * DM + 512 + 4 * lane) = o; }
    __syncthreads();
}

constexpr int S5_BU = 8704  , S5_GG = 8 * S5_BU  , S5_GG_ROW = 528, S5_ST_ROW = 260;
template <int MODE>
__device__ __forceinline__ void s5_block(const bf16_t* XSrow0  , const bf16x8 (&bfrag)[4], LAS unsigned char* bu, int lane, float are, float aim, float& hr, float& hi_, unsigned& g_rgx, unsigned& g_ux) {
    const int r32 = lane & 31, hi = lane >> 5;
    const bf16x8 a = *(const bf16x8*)(XSrow0 + (size_t)r32 * 256 + 8 * hi);
#pragma unroll
    for (int hb = 0; hb < 2; ++hb) {
        f32x16 cr = __builtin_amdgcn_mfma_f32_32x32x16_bf16(a, bfrag[hb], f32x16{}, 0, 0, 0);
        f32x16 ci = __builtin_amdgcn_mfma_f32_32x32x16_bf16(a, bfrag[2 + hb], f32x16{}, 0, 0, 0);
        MFMA_PAD(cr); MFMA_PAD(ci);
#pragma unroll
        for (int r = 0; r < 16; ++r) *(LAS unsigned*)(bu + att::crow(r, hi) * 272 + (32 * hb + r32) * 4) = pk2(cr[r], ci[r]); }
    LDS_WAIT();
#if MK_S5_V2 == 8 || MK_S5_V2 == 7
    float ar_ = hr, ai_ = hi_;
    if (MODE == 3) {
#pragma unroll 8
        for (int r = 0; r < 32; ++r) { const unsigned w = *(const LAS unsigned*)(bu + r * 272 + lane * 4); const float ur = bflo(w), ui = bfhi(w);
            const float nr = are * ar_ - aim * ai_ + ur, ni = are * ai_ + aim * ar_ + ui; ar_ = nr; ai_ = ni; }
        asm volatile("" : "+v"(ar_), "+v"(ai_));
    }
#endif
#pragma unroll 8
    for (int r = 0; r < 32; ++r) { const unsigned w = *(const LAS unsigned*)(bu + r * 272 + lane * 4); const float ur = bflo(w), ui = bfhi(w);
#if MK_S5_V2 == 7
        if (MODE == 3) g_ux ^= w * (2u * r + 1u);
#endif
#if MK_S5_SCALAR
        float nr = are * hr - aim * hi_ + ur; float hi2 = hi_; asm volatile("" : "+v"(nr), "+v"(hi2));
        const float ni = are * hi2 + aim * hr + ui; hr = nr; hi_ = ni;
#else
        const float nr = are * hr - aim * hi_ + ur, ni = are * hi_ + aim * hr + ui; hr = nr; hi_ = ni;
#endif
        if (MODE == 3) { const unsigned pw = pk2(nr, ni); *(LAS unsigned*)(bu + r * 272 + lane * 4) = pw;

        } }
#if MK_S5_V2 == 7
    if (MODE == 3) g_rgx = (__builtin_bit_cast(unsigned, ar_) != __builtin_bit_cast(unsigned, hr) || __builtin_bit_cast(unsigned, ai_) != __builtin_bit_cast(unsigned, hi_)) ? 0x12345u : 0u;
#endif
#if MK_S5_V2 == 8
    if (MODE == 3) g_rgx |= (__builtin_bit_cast(unsigned, ar_) != __builtin_bit_cast(unsigned, hr) || __builtin_bit_cast(unsigned, ai_) != __builtin_bit_cast(unsigned, hi_)) ? 1u : 0u;
#endif
    LDS_WAIT();
}
__device__ __forceinline__ void s5_pass1(const Frame& F, int task, const bf16_t* XS, const unsigned char* tb, float* E) {
    const int lane = F.lane, wid = F.wave, r32 = lane & 31, hi = lane >> 5;
    const float* ab = (const float*)(tb + S5T_AB); const bf16_t* BBt = (const bf16_t*)(tb + S5T_BBT);
    const size_t t0 = (size_t)task * 64;
    LAS unsigned char* bu = F.lds + wid * S5_BU;
    for (int gi = 0; gi < 2; ++gi) { const int g = 2 * wid + gi; const float are = ab[g * 64 + lane], aim = ab[1024 + g * 64 + lane];
        bf16x8 bfrag[4];
#pragma unroll
        for (int nb = 0; nb < 4; ++nb) bfrag[nb] = *(const bf16x8*)(BBt + ((size_t)g * 128 + 32 * nb + r32) * 16 + 8 * hi);
        float hr = 0.f, hi_ = 0.f;
        for (int blk = 0; blk < 2; ++blk) { unsigned dum_ = 0u, dum2_ = 0u; s5_block<1>(XS + (t0 + 32 * blk) * 256 + g * 16, bfrag, bu, lane, are, aim, hr, hi_, dum_, dum2_); }
        E[((size_t)task * 16 + g) * 128 + lane] = hr; E[((size_t)task * 16 + g) * 128 + 64 + lane] = hi_; }
}
__device__ __forceinline__ void s5_carry(int idx, const unsigned char* tb, const float* __restrict__ E, float* __restrict__ Hs) {
    const float* ab = (const float*)(tb + S5T_AB); const int n = idx & 63, g = (idx >> 6) & 15, b = idx >> 10;
    const float are = ab[2048 + g * 64 + n], aim = ab[3072 + g * 64 + n]; float hr = 0.f, hi_ = 0.f;
    const size_t o0 = ((size_t)(b * 256) * 16 + g) * 128 + n;
#pragma unroll 1
    for (int jb = 0; jb < 256; jb += 16) { float er[16], ei[16];
#pragma unroll
        for (int k = 0; k < 16; ++k) { const size_t o = o0 + (size_t)(jb + k) * 2048; er[k] = E[o]; ei[k] = E[o + 64]; }
#pragma unroll
        for (int k = 0; k < 16; ++k) { const size_t o = o0 + (size_t)(jb + k) * 2048; Hs[o] = hr; Hs[o + 64] = hi_;
            const float nr = are * hr - aim * hi_ + er[k], ni = are * hi_ + aim * hr + ei[k]; hr = nr; hi_ = ni; } }
}
__device__ __forceinline__ void s5_carry_seg(const Frame& F, int bg, const unsigned char* tb, const float* __restrict__ E, float* __restrict__ Hs) {
    const float* ab = (const float*)(tb + S5T_AB); const int n = F.lane, w = F.wave, g = bg & 15, b = bg >> 4;
    const float are = ab[2048 + g * 64 + n], aim = ab[3072 + g * 64 + n];
    float sr = are, si = aim;
#pragma unroll
    for (int k = 0; k < 5; ++k) { const float tr = sr * sr - si * si, ti = 2.0f * sr * si; sr = tr; si = ti; }
    const size_t o0 = ((size_t)(b * 256 + 32 * w) * 16 + g) * 128 + n;
    float er[32], ei[32];
#pragma unroll
    for (int k = 0; k < 32; ++k) { er[k] = E[o0 + (size_t)k * 2048]; ei[k] = E[o0 + (size_t)k * 2048 + 64]; }
    float hr = 0.f, hi_ = 0.f;
#pragma unroll
    for (int k = 0; k < 32; ++k) { const float nr = are * hr - aim * hi_ + er[k], ni = are * hi_ + aim * hr + ei[k]; hr = nr; hi_ = ni; }
    LAS float* tot = (LAS float*)F.lds;
    tot[w * 128 + n] = hr; tot[w * 128 + 64 + n] = hi_;
    LDS_WAIT(); __syncthreads();
    hr = 0.f; hi_ = 0.f;
    for (int k = 0; k < w; ++k) { const float tr = tot[k * 128 + n], ti = tot[k * 128 + 64 + n]; const float nr = sr * hr - si * hi_ + tr, ni = sr * hi_ + si * hr + ti; hr = nr; hi_ = ni; }
#pragma unroll
    for (int k = 0; k < 32; ++k) { Hs[o0 + (size_t)k * 2048] = hr; Hs[o0 + (size_t)k * 2048 + 64] = hi_;
        const float nr = are * hr - aim * hi_ + er[k], ni = are * hi_ + aim * hr + ei[k]; hr = nr; hi_ = ni; }
    __syncthreads();
}
__device__ __forceinline__ void s5_pass3(const Frame& F, int task, const bf16_t* XS, const unsigned char* tb, const float* Hs, const bf16_t* Wglu, const float* bglu, const float* gm, bf16_t* MIX, const float* SA) {
    const int lane = F.lane, wid = F.wave, r32 = lane & 31, hi = lane >> 5;
    const float* ab = (const float*)(tb + S5T_AB); const bf16_t* BBt = (const bf16_t*)(tb + S5T_BBT); const bf16_t* Cmt = (const bf16_t*)(tb + S5T_CMT); const float* dd = (const float*)(tb + S5T_D);
    const size_t t0 = (size_t)task * 64;
    LAS unsigned char* bu = F.lds + wid * S5_BU; LAS unsigned char* ggt = F.lds + S5_GG;
#if MK_S5_SCRUB
    asm volatile("v_mov_b32 v150, 0\n\tv_mov_b32 v151, 0\n\tv_mov_b32 v152, 0\n\tv_mov_b32 v153, 0\n\tv_mov_b32 v154, 0\n\tv_mov_b32 v155, 0\n\tv_mov_b32 v156, 0\n\tv_mov_b32 v157, 0\n\tv_mov_b32 v158, 0\n\tv_mov_b32 v159, 0\n\tv_mov_b32 v160, 0\n\tv_mov_b32 v161, 0\n\tv_mov_b32 v162, 0\n\tv_mov_b32 v163, 0\n\tv_mov_b32 v164, 0\n\tv_mov_b32 v165, 0\n\tv_mov_b32 v166, 0\n\tv_mov_b32 v167, 0\n\tv_mov_b32 v168, 0\n\tv_mov_b32 v169, 0\n\tv_mov_b32 v170, 0\n\tv_mov_b32 v171, 0\n\tv_mov_b32 v172, 0\n\tv_mov_b32 v173, 0\n\tv_mov_b32 v174, 0\n\tv_mov_b32 v175, 0\n\tv_mov_b32 v176, 0\n\tv_mov_b32 v177, 0\n\tv_mov_b32 v178, 0\n\tv_mov_b32 v179, 0\n\tv_mov_b32 v180, 0\n\tv_mov_b32 v181, 0\n\tv_mov_b32 v182, 0\n\tv_mov_b32 v183, 0\n\tv_mov_b32 v184, 0\n\tv_mov_b32 v185, 0\n\tv_mov_b32 v186, 0\n\tv_mov_b32 v187, 0\n\tv_mov_b32 v188, 0\n\tv_mov_b32 v189, 0\n\tv_mov_b32 v190, 0\n\tv_mov_b32 v191, 0\n\tv_mov_b32 v192, 0\n\tv_mov_b32 v193, 0\n\tv_mov_b32 v194, 0\n\tv_mov_b32 v195, 0\n\tv_mov_b32 v196, 0\n\tv_mov_b32 v197, 0\n\tv_mov_b32 v198, 0\n\tv_mov_b32 v199, 0\n\tv_mov_b32 v200, 0\n\tv_mov_b32 v201, 0\n\tv_mov_b32 v202, 0\n\tv_mov_b32 v203, 0\n\tv_mov_b32 v204, 0\n\tv_mov_b32 v205, 0\n\tv_mov_b32 v206, 0\n\tv_mov_b32 v207, 0\n\tv_mov_b32 v208, 0\n\tv_mov_b32 v209, 0\n\tv_mov_b32 v210, 0\n\tv_mov_b32 v211, 0\n\tv_mov_b32 v212, 0\n\tv_mov_b32 v213, 0\n\tv_mov_b32 v214, 0\n\tv_mov_b32 v215, 0\n\tv_mov_b32 v216, 0\n\tv_mov_b32 v217, 0\n\tv_mov_b32 v218, 0\n\tv_mov_b32 v219, 0\n\tv_mov_b32 v220, 0\n\tv_mov_b32 v221, 0\n\tv_mov_b32 v222, 0\n\tv_mov_b32 v223, 0\n\tv_mov_b32 v224, 0\n\tv_mov_b32 v225, 0\n\tv_mov_b32 v226, 0\n\tv_mov_b32 v227, 0\n\tv_mov_b32 v228, 0\n\tv_mov_b32 v229, 0\n\tv_mov_b32 v230, 0\n\tv_mov_b32 v231, 0\n\tv_mov_b32 v232, 0\n\tv_mov_b32 v233, 0\n\tv_mov_b32 v234, 0\n\tv_mov_b32 v235, 0\n\tv_mov_b32 v236, 0\n\tv_mov_b32 v237, 0\n\tv_mov_b32 v238, 0\n\tv_mov_b32 v239, 0\n\tv_mov_b32 v240, 0\n\tv_mov_b32 v241, 0\n\tv_mov_b32 v242, 0\n\tv_mov_b32 v243, 0\n\tv_mov_b32 v244, 0\n\tv_mov_b32 v245, 0\n\tv_mov_b32 v246, 0\n\tv_mov_b32 v247, 0\n\tv_mov_b32 v248, 0\n\tv_mov_b32 v249, 0" ::: "v150", "v151", "v152", "v153", "v154", "v155", "v156", "v157", "v158", "v159", "v160", "v161", "v162", "v163", "v164", "v165", "v166", "v167", "v168", "v169", "v170", "v171", "v172", "v173", "v174", "v175", "v176", "v177", "v178", "v179", "v180", "v181", "v182", "v183", "v184", "v185", "v186", "v187", "v188", "v189", "v190", "v191", "v192", "v193", "v194", "v195", "v196", "v197", "v198", "v199", "v200", "v201", "v202", "v203", "v204", "v205", "v206", "v207", "v208", "v209", "v210", "v211", "v212", "v213", "v214", "v215", "v216", "v217", "v218", "v219", "v220", "v221", "v222", "v223", "v224", "v225", "v226", "v227", "v228", "v229", "v230", "v231", "v232", "v233", "v234", "v235", "v236", "v237", "v238", "v239", "v240", "v241", "v242", "v243", "v244", "v245", "v246", "v247", "v248", "v249");
#endif
#if MK_S5_ZERO
    if (MK_S5_ZERO != 4) for (int i = F.tid; i < ((MK_S5_ZERO == 1 || MK_S5_ZERO == 5) ? S5_GG : (S5_GG + 64 * S5_GG_ROW)) / 16; i += NW * 64) if (MK_S5_ZERO != 3 || i >= S5_GG / 16) *(LAS u32x4*)(F.lds + i * 16) = (MK_S5_ZERO == 5) ? (u32x4){0x7FC07FC0u, 0x7FC07FC0u, 0x7FC07FC0u, 0x7FC07FC0u} : (u32x4){0u, 0u, 0u, 0u};
    LDS_WAIT(); __syncthreads();
#endif
    for (int gi = 0; gi < 2; ++gi) { const int g = 2 * wid + gi; const float are = ab[g * 64 + lane], aim = ab[1024 + g * 64 + lane];
        bf16x8 bfrag[4];
#pragma unroll
        for (int nb = 0; nb < 4; ++nb) bfrag[nb] = *(const bf16x8*)(BBt + ((size_t)g * 128 + 32 * nb + r32) * 16 + 8 * hi);
        bf16x8 cfrag[8];
#pragma unroll
        for (int ks = 0; ks < 8; ++ks) { u32x4 w = (u32x4){0u, 0u, 0u, 0u}; if (r32 < 16) w = *(const u32x4*)(Cmt + ((size_t)g * 16 + r32) * 128 + 16 * ks + 8 * hi); cfrag[ks] = __builtin_bit_cast(bf16x8, w); }
        const float dv = dd[g * 16 + (lane & 15)];
#if MK_S5_V2 == 6
        { unsigned hx = 0u;
#pragma unroll
          for (int ks = 0; ks < 8; ++ks) { const u32x4 w = __builtin_bit_cast(u32x4, cfrag[ks]); hx ^= w.x * (8u * ks + 1u) ^ w.y * (8u * ks + 3u) ^ w.z * (8u * ks + 5u) ^ w.w * (8u * ks + 7u); }
          ((unsigned*)(F.ws + (650ull << 20)))[((size_t)task * 16 + g) * 64 + lane] = hx; }
#endif
        float hr = Hs[((size_t)task * 16 + g) * 128 + lane], hi_ = Hs[((size_t)task * 16 + g) * 128 + 64 + lane];
#if MK_S5_V2 == 7
        asm volatile("s_waitcnt vmcnt(0)" ::: "memory");
        const unsigned hs_r = __hip_atomic_load((const unsigned*)Hs + ((size_t)task * 16 + g) * 128 + lane, __ATOMIC_RELAXED, __HIP_MEMORY_SCOPE_SYSTEM), hs_i = __hip_atomic_load((const unsigned*)Hs + ((size_t)task * 16 + g) * 128 + 64 + lane, __ATOMIC_RELAXED, __HIP_MEMORY_SCOPE_SYSTEM);
        ((unsigned*)(F.ws + (666ull << 20)))[(((size_t)task * 16 + g) * 2 + 0) * 64 + lane] = hs_r * 3u ^ hs_i * 5u;
        ((unsigned*)(F.ws + (666ull << 20)))[(((size_t)task * 16 + g) * 2 + 1) * 64 + lane] = __builtin_bit_cast(unsigned, hr) * 3u ^ __builtin_bit_cast(unsigned, hi_) * 5u;
#endif
#if MK_S5_V1
        hr = 0.f; hi_ = 0.f;
#endif
        for (int blk = 0; blk < 2; ++blk) { const bf16_t* xr0 = XS + (t0 + 32 * blk) * 256 + g * 16;
            unsigned short xraw[16];
#pragma unroll
            for (int r = 0; r < 16; ++r) xraw[r] = xr0[(size_t)att::crow(r, hi) * 256 + (r32 & 15)];
            unsigned rgx = 0u, ux = 0u;
            const float h0raw = hr;
            const unsigned h0x = __builtin_bit_cast(unsigned, hr) * 3u ^ __builtin_bit_cast(unsigned, hi_) * 5u, abx = __builtin_bit_cast(unsigned, are) * 3u ^ __builtin_bit_cast(unsigned, aim) * 5u;
            s5_block<3>(xr0, bfrag, bu, lane, are, aim, hr, hi_, rgx, ux);
#if MK_S5_V2 == 8
            if (rgx) atomicAdd((unsigned*)(F.ws + (650ull << 20)), 1u);
#endif
#if MK_S5_V2 == 7
            if (rgx) atomicAdd((unsigned*)(F.ws + (649ull << 20)), 1u);
            float are2 = are, aim2 = aim; asm volatile("" : "+v"(are2), "+v"(aim2));
            const unsigned abx2 = __builtin_bit_cast(unsigned, are2) * 3u ^ __builtin_bit_cast(unsigned, aim2) * 5u;
            float hp_r = hr, hp_i = hi_; asm volatile("" : "+v"(hp_r), "+v"(hp_i));
            const unsigned hpost = __builtin_bit_cast(unsigned, hp_r) * 3u ^ __builtin_bit_cast(unsigned, hp_i) * 5u;
#endif
#if MK_S5_V2 == 7
            { unsigned scx = 0u;
#pragma unroll 8
              for (int r = 0; r < 32; ++r) scx ^= *(const LAS unsigned*)(bu + r * 272 + lane * 4) * (2u * r + 1u);
              const size_t di = (((size_t)task * 16 + g) * 2 + blk) * 64 + lane;
              ((unsigned*)(F.ws + (650ull << 20)))[di] = abx; ((unsigned*)(F.ws + (654ull << 20)))[di] = ux; ((unsigned*)(F.ws + (658ull << 20)))[di] = h0x; ((unsigned*)(F.ws + (662ull << 20)))[di] = hpost; ((unsigned*)(F.ws + (642ull << 20)))[di] = abx2; if (scx == 0x777u) ((unsigned*)(F.ws + (650ull << 20)))[di] = 1u; }
#endif
            f32x16 y = f32x16{};
#if MK_S5_V2 == 6 || MK_S5_V2 == 7
            unsigned ax = 0u;
#pragma unroll
            for (int ks = 0; ks < 8; ++ks) { const bf16x8 a = *(const LAS bf16x8*)(bu + r32 * 272 + (16 * ks + 8 * hi) * 2); y = __builtin_amdgcn_mfma_f32_32x32x16_bf16(a, cfrag[ks], y, 0, 0, 0);
                const u32x4 w = __builtin_bit_cast(u32x4, a); ax ^= w.x * (8u * ks + 1u) ^ w.y * (8u * ks + 3u) ^ w.z * (8u * ks + 5u) ^ w.w * (8u * ks + 7u); }
            if (MK_S5_V2 != 7) ((unsigned*)(F.ws + (666ull << 20)))[(((size_t)task * 16 + g) * 2 + blk) * 64 + lane] = ax; else if (ax == 0x5151u) ((unsigned*)(F.ws + (650ull << 20)))[0] = 1u;
#else
#pragma unroll
            for (int ks = 0; ks < 8; ++ks) { const bf16x8 a = *(const LAS bf16x8*)(bu + r32 * 272 + (16 * ks + 8 * hi) * 2); y = __builtin_amdgcn_mfma_f32_32x32x16_bf16(a, cfrag[ks], y, 0, 0, 0); }
#endif
            MFMA_PAD(y);
#pragma unroll
            for (int r = 0; r < 16; ++r) { const int pr = att::crow(r, hi); const float xv = bf2f(xraw[r]);
#if MK_S5_V2 == 1
                const float gvv = bflo(*(const LAS unsigned*)(bu + pr * 272 + (r32 & 15) * 4)) + 0.f * (y[r] + dv * xv);
#elif MK_S5_V2 == 2
                const float gvv = y[r];
#elif MK_S5_V2 == 3
                const float gvv = dv * xv;
#else
                const float gvv = gelu_t(y[r] + dv * xv);
#endif
                const float gnb = shx(gvv, 1);
                if (r32 < 16 && (r32 & 1) == 0) *(LAS unsigned*)(ggt + (32 * blk + pr) * S5_GG_ROW + (g * 16 + r32) * 2) = pk2(gvv, gnb); }
            LDS_WAIT(); } }
    LDS_WAIT(); __syncthreads();
#if DBG == 100 && MK_S5_V2 < 6
    { bf16_t* GGD = (bf16_t*)(F.ws + (650ull << 20));
      for (int i = 0; i < 8; ++i) { const int row = wid * 8 + i; const u32x2 v = *(const LAS u32x2*)(ggt + row * S5_GG_ROW + lane * 8); *(u32x2*)(GGD + (t0 + row) * 256 + 4 * lane) = v; } }
#endif
    { f32x16 acc[2]; acc[0] = f32x16{}; acc[1] = f32x16{}; const bf16_t* wr = Wglu + (size_t)(32 * wid + r32) * 256 + 8 * hi;
#pragma unroll 4
      for (int ks = 0; ks < 16; ++ks) { const bf16x8 bw = *(const bf16x8*)(wr + 16 * ks);
#pragma unroll
          for (int mb = 0; mb < 2; ++mb) { const bf16x8 a = *(const LAS bf16x8*)(ggt + (32 * mb + r32) * S5_GG_ROW + (16 * ks + 8 * hi) * 2); acc[mb] = __builtin_amdgcn_mfma_f32_32x32x16_bf16(a, bw, acc[mb], 0, 0, 0); } }
      MFMA_PAD(acc[0]); MFMA_PAD(acc[1]);
      const int n = 32 * wid + r32; const float bg = bglu[n];
#pragma unroll
      for (int mb = 0; mb < 2; ++mb)
#pragma unroll
          for (int r = 0; r < 16; ++r) { const int pos = 32 * mb + att::crow(r, hi); const float gv = bf2f(*(const LAS bf16_t*)(ggt + pos * S5_GG_ROW + n * 2));
              *(LAS float*)(F.lds + (pos * S5_ST_ROW + n) * 4) = gv * sigm(acc[mb][r] + bg); } }
    LDS_WAIT(); __syncthreads();
#pragma unroll
    for (int i = 0; i < 8; ++i) { const int row = wid * 8 + i; const f32x4 v = *(const LAS f32x4*)(F.lds + (row * S5_ST_ROW + 4 * lane) * 4);
#if DBG == 100 && MK_S5_V2 < 6
        { bf16_t* SD = (bf16_t*)(F.ws + (666ull << 20)); u32x2 d; d.x = pk2(v[0], v[1]); d.y = pk2(v[2], v[3]); *(u32x2*)(SD + (t0 + row) * 256 + 4 * lane) = d; }
#endif
        const float rs = rsqrtf(wave_sum((v[0] * v[0] + v[1] * v[1]) + (v[2] * v[2] + v[3] * v[3])) * (1.0f / 256.0f) + EPS) * inv_ra(SA, t0 + row); const f32x4 gg = *(const f32x4*)(gm + 768 + 4 * lane);
        u32x2 o; o.x = pk2(v[0] * rs * gg[0], v[1] * rs * gg[1]); o.y = pk2(v[2] * rs * gg[2], v[3] * rs * gg[3]);
        *(u32x2*)(MIX + (t0 + row) * DM + 768 + 4 * lane) = o; }
    __syncthreads();
}
__device__ __forceinline__ void anorm_row(int t, int lane, bf16_t* MIX, const float* SA, const float* gm) {
    const f32x4 s0 = *(const f32x4*)(SA + (size_t)t * 8), s1 = *(const f32x4*)(SA + (size_t)t * 8 + 4);
    const float ra = rsqrtf((((s0[0] + s0[1]) + (s0[2] + s0[3])) + ((s1[0] + s1[1]) + (s1[2] + s1[3]))) * (1.0f / 512.0f) + EPS);
    u32x4* p = (u32x4*)(MIX + (size_t)t * DM + 8 * lane); const u32x4 w = *p; const f32x4 g0 = *(const f32x4*)(gm + 8 * lane), g1 = *(const f32x4*)(gm + 8 * lane + 4);
    u32x4 o; o.x = pk2(bflo(w.x) * ra * g0[0], bfhi(w.x) * ra * g0[1]); o.y = pk2(bflo(w.y) * ra * g0[2], bfhi(w.y) * ra * g0[3]);
    o.z = pk2(bflo(w.z) * ra * g1[0], bfhi(w.z) * ra * g1[1]); o.w = pk2(bflo(w.w) * ra * g1[2], bfhi(w.w) * ra * g1[3]); *p = o;
}

__device__ __forceinline__ void anorm_rows4(int t0, int dt, int lane, bf16_t* MIX, const float* SA, const float* gm) {
    u32x4 w[4]; float ra[4];
#pragma unroll
    for (int i = 0; i < 4; ++i) { const int t = t0 + i * dt; const f32x4 s0 = *(const f32x4*)(SA + (size_t)t * 8), s1 = *(const f32x4*)(SA + (size_t)t * 8 + 4);
        w[i] = *(const u32x4*)(MIX + (size_t)t * DM + 8 * lane);
        ra[i] = rsqrtf((((s0[0] + s0[1]) + (s0[2] + s0[3])) + ((s1[0] + s1[1]) + (s1[2] + s1[3]))) * (1.0f / 512.0f) + EPS); }
    const f32x4 g0 = *(const f32x4*)(gm + 8 * lane), g1 = *(const f32x4*)(gm + 8 * lane + 4);
#pragma unroll
    for (int i = 0; i < 4; ++i) { const int t = t0 + i * dt; u32x4 o; const float r = ra[i];
        o.x = pk2(bflo(w[i].x) * r * g0[0], bfhi(w[i].x) * r * g0[1]); o.y = pk2(bflo(w[i].y) * r * g0[2], bfhi(w[i].y) * r * g0[3]);
        o.z = pk2(bflo(w[i].z) * r * g1[0], bfhi(w[i].z) * r * g1[1]); o.w = pk2(bflo(w[i].w) * r * g1[2], bfhi(w[i].w) * r * g1[3]);
        *(u32x4*)(MIX + (size_t)t * DM + 8 * lane) = o; }
}

__device__ __forceinline__ void route_block(const Frame& F, int blk, const bf16_t* Hb, const float* SS2, const bf16_t* Wr, const float* brg, const float* bre,
                                            float* RS2, int* CNT, int* ER, float* WGT) {
    const int lane = F.lane, wid = F.wave, tid = F.tid; const int t0 = blk * 128 + wid * 16;
    LAS float* lg = (LAS float*)(F.lds) + wid * (16 * 49);
    LAS int* cnt = (LAS int*)(F.lds + EXTRA_OFF);
    if (tid < 32) cnt[tid] = 0;
    f32x4 acc[3]; acc[0] = acc[1] = acc[2] = (f32x4){0.f, 0.f, 0.f, 0.f};
    const bf16_t* ap = Hb + (size_t)(t0 + (lane & 15)) * DM + 8 * (lane >> 4); const bf16_t* bp = Wr + (size_t)(lane & 15) * DM + 8 * (lane >> 4);
#pragma unroll 8
    for (int ks = 0; ks < 32; ++ks) { const bf16x8 a = *(const bf16x8*)(ap + 32 * ks);
#pragma unroll
        for (int nb = 0; nb < 3; ++nb) { const bf16x8 bw = *(const bf16x8*)(bp + (size_t)nb * 16 * DM + 32 * ks); acc[nb] = __builtin_amdgcn_mfma_f32_16x16x32_bf16(a, bw, acc[nb], 0, 0, 0); } }
    MFMA_PAD(acc[0]); MFMA_PAD(acc[1]); MFMA_PAD(acc[2]);
#pragma unroll
    for (int nb = 0; nb < 3; ++nb)
#pragma unroll
        for (int r = 0; r < 4; ++r) lg[(4 * (lane >> 4) + r) * 49 + 16 * nb + (lane & 15)] = acc[nb][r];
    LDS_WAIT(); __syncthreads();
    if (lane < 16) { const int t = t0 + lane; const float rs = rsqrtf(sum16(SS2 + (size_t)t * 16) * (1.0f / 1024.0f) + EPS); RS2[t] = rs;
        const LAS float* q = lg + lane * 49;
        float gl[4]; int gs = 0;
#pragma unroll
        for (int j = 0; j < 4; ++j) gl[j] = q[j] * rs + brg[j];
        float gmx = gl[0];
#pragma unroll
        for (int j = 1; j < 4; ++j) if (gl[j] > gmx) { gmx = gl[j]; gs = j; }
        float se = 0.f;
#pragma unroll
        for (int j = 0; j < 4; ++j) se += __expf(gl[j] - gmx);
        const float gw = 1.0f / se;
        float el[8];
#pragma unroll
        for (int j = 0; j < 8; ++j) el[j] = q[4 + gs * 8 + j] * rs + bre[gs * 8 + j];
        int i0 = 0; float v0 = el[0];
#pragma unroll
        for (int j = 1; j < 8; ++j) if (el[j] > v0) { v0 = el[j]; i0 = j; }
        int i1 = 0; float v1 = -3.4e38f;
#pragma unroll
        for (int j = 0; j < 8; ++j) if (j != i0 && el[j] > v1) { v1 = el[j]; i1 = j; }
        const float e1 = __expf(v1 - v0); const float w0 = 1.0f / (1.0f + e1), w1 = e1 / (1.0f + e1);
        const int ea = gs * 8 + i0, eb = gs * 8 + i1;
        const int ra = atomicAdd((int*)&cnt[ea], 1), rb = atomicAdd((int*)&cnt[eb], 1);
        ER[t * 2] = (ea << 16) | ra; ER[t * 2 + 1] = (eb << 16) | rb; WGT[t * 2] = w0 * gw; WGT[t * 2 + 1] = w1 * gw; }
    LDS_WAIT(); __syncthreads();
    if (tid < 32) CNT[blk * 32 + tid] = cnt[tid];
    __syncthreads();
}
__device__ __forceinline__ void scatter_block(const Frame& F, int blk, unsigned hb_off, const float* RS2, const int* CNT, const int* ER, const float* WGT,
                                              int* TSTART, int* TOK, float* RW, float* RRS, unsigned* RTO) {
    const int lane = F.lane, wid = F.wave, tid = F.tid;
    LAS int* sm = (LAS int*)(F.lds);
    { const int e = tid & 31, part = tid >> 5; int pa = 0, pb = 0;
      for (int j = 0; j < 16; ++j) { const int b2 = part * 16 + j; const int c = CNT[b2 * 32 + e]; pa += c; pb += (b2 < blk) ? c : 0; }
      sm[part * 32 + e] = pa; sm[512 + part * 32 + e] = pb; }
    LDS_WAIT(); __syncthreads();
    if (tid < 32) { int ta = 0, tb2 = 0; for (int p = 0; p < 16; ++p) { ta += sm[p * 32 + tid]; tb2 += sm[512 + p * 32 + tid]; } sm[1024 + tid] = ta; sm[1088 + tid] = tb2; }
    LDS_WAIT(); __syncthreads();
    if (tid == 0) { int st = 0; for (int e = 0; e < 32; ++e) { sm[1152 + e] = st; st += (sm[1024 + e] + 255) & ~255; } sm[1152 + 32] = st; }
    LDS_WAIT(); __syncthreads();
    if (blk == 0 && tid < 33) TSTART[tid] = sm[1152 + tid] >> 8;
    if (tid < 256) { const int t = blk * 128 + (tid >> 1), k = tid & 1; const int er = ER[t * 2 + k]; const int e = er >> 16, rk = er & 0xffff;
        const int slot = sm[1152 + e] + sm[1088 + e] + rk; st_wt(TOK + slot, t * 2 + k); st_wt(RW + slot, WGT[t * 2 + k]); st_wt(RRS + slot, RS2[t]); RTO[slot] = hb_off + (unsigned)t * 2048u; }
    LDS_WAIT(); __syncthreads();
    if (blk < 32) { const int e = blk; const int p0 = sm[1152 + e] + sm[1024 + e], p1 = sm[1152 + e + 1];
        for (int r = p0 + tid; r < p1; r += NW * 64) { st_wt(TOK + r, -1); st_wt(RW + r, 0.f); st_wt(RRS + r, 0.f); RTO[r] = ZERO_OFF; } }
    __syncthreads();
}
__device__ __forceinline__ void combine_row(int t, int lane, const bf16_t* HbIn, const bf16_t* Y, bf16_t* HbOut) {
    const GAS u32x4* hi = (const GAS u32x4*)(HbIn + (size_t)t * DM) + lane; const GAS u32x4* y0 = (const GAS u32x4*)(Y + (size_t)t * DM) + lane; const GAS u32x4* y1 = (const GAS u32x4*)(Y + ((size_t)T + t) * DM) + lane;
    GAS u32x4* ho = (GAS u32x4*)(HbOut + (size_t)t * DM) + lane;
#pragma unroll
    for (int j = 0; j < 2; ++j) { const u32x4 h = hi[64 * j], a = y0[64 * j], b = y1[64 * j]; u32x4 o;
        o.x = pk2(bflo(h.x) + bflo(a.x) + bflo(b.x), bfhi(h.x) + bfhi(a.x) + bfhi(b.x)); o.y = pk2(bflo(h.y) + bflo(a.y) + bflo(b.y), bfhi(h.y) + bfhi(a.y) + bfhi(b.y));
        o.z = pk2(bflo(h.z) + bflo(a.z) + bflo(b.z), bfhi(h.z) + bfhi(a.z) + bfhi(b.z)); o.w = pk2(bflo(h.w) + bflo(a.w) + bflo(b.w), bfhi(h.w) + bfhi(a.w) + bfhi(b.w));
        ho[64 * j] = o; }
}
constexpr int NPHASE = 12;
__global__ void __launch_bounds__(NW * 64, 2) mk_fwd(Args a) {
    extern __shared__ __attribute__((aligned(16))) unsigned char lds[];
    Frame F; F.lds = (LAS unsigned char*)lds; F.ws = a.ws;
    F.tid = threadIdx.x; F.lane = F.tid & 63; F.wave = __builtin_amdgcn_readfirstlane(F.tid >> 6);
    F.G = gridDim.x; { const int bx = ((int)blockIdx.x + a.shift) % (int)gridDim.x; F.vcu = (F.G % 8 == 0) ? (bx % 8) * (F.G / 8) + bx / 8 : bx; }
    for (int u = F.tid; u < (LDS_BYTES - LDSCTL_OFF) / 4; u += NW * 64) ((LAS unsigned*)(F.lds + LDSCTL_OFF))[u] = 0u;
    __syncthreads();
    unsigned* ctl = (unsigned*)(a.ws + WS_CTL);
    const bool one_launch = (a.ph_hi - a.ph_lo > 1) || (a.l_hi - a.l_lo > 1);
    XcdBarrier bar; bar.bar = ctl + CW_BAR; bar.x = 0; bar.st = nullptr;
    if (one_launch) bar = xcd_barrier_post(ctl + CW_BAR, (volatile LAS unsigned*)(F.lds + LDSCTL_OFF) + 8);
#ifndef MK_REP
#define MK_REP 0
#endif
#define NREP(k) (((MK_REP >> (k)) & 1) ? 2 : 1)
#ifndef MK_TIMING
#define MK_TIMING 0
#endif
#if MK_TIMING
    unsigned long long* tsb = (unsigned long long*)(a.ws + 65536);
    if (blockIdx.x == 0 && threadIdx.x == 0) tsb[255] = __builtin_amdgcn_s_memrealtime();
#define STAMP(l_, ph_) do { if (blockIdx.x == 0 && threadIdx.x == 0) tsb[(l_) * 16 + (ph_)] = __builtin_amdgcn_s_memrealtime(); } while (0)
#else
#define STAMP(l_, ph_) do {} while (0)
#endif
#ifdef MK_DBLSEAM
#define SEAM() do { if (one_launch) { xcd_barrier(bar); xcd_barrier(bar); } } while (0)
#else
#define SEAM() do { if (one_launch) xcd_barrier(bar); } while (0)
#endif
#ifndef MK_PHMASK
#define MK_PHMASK 0xFFFF
#endif
#define FRESH(Fn) Frame Fn = F; { const int t_ = opaque_tid(); Fn.tid = t_; Fn.lane = t_ & 63; Fn.wave = __builtin_amdgcn_readfirstlane(t_ >> 6); }
#define INP(k) (((MK_PHMASK >> (k)) & 1) && (k) >= a.ph_lo && (k) < a.ph_hi)
    unsigned char* ws = a.ws;
    const int gw = F.vcu * NW + F.wave, NGW = F.G * NW;
    const int G = F.G; const int bx = ((int)blockIdx.x + a.shift) % G;
    float* H = a.out;
#define PHASE_PTRS unsigned char* ws = a.ws; asm volatile("" : "+s"(ws)); float* H = a.out; asm volatile("" : "+s"(H)); bf16_t* ZQ = (bf16_t*)(ws + WS_ZQ); bf16_t* ZKV = (bf16_t*)(ws + WS_ZKV); bf16_t* U = (bf16_t*)(ws + WS_U); bf16_t* VS = (bf16_t*)(ws + WS_VS); bf16_t* XS = (bf16_t*)(ws + WS_XS); bf16_t* Q = (bf16_t*)(ws + WS_Q); bf16_t* K = (bf16_t*)(ws + WS_K); bf16_t* V = (bf16_t*)(ws + WS_V); bf16_t* MIX = (bf16_t*)(ws + WS_MIX); bf16_t* XG = (bf16_t*)(ws + WS_XG); bf16_t* HBX = (bf16_t*)(ws + WS_HBX); bf16_t* Y01 = (bf16_t*)(ws + WS_Y01); bf16_t* PL = (bf16_t*)(ws + WS_PL); bf16_t* Pb = (bf16_t*)(ws + WS_PB); float* SS1 = (float*)(ws + WS_SS1); float* SS2 = (float*)(ws + WS_SS2); float* SSQ = (float*)(ws + WS_SSQ); float* SKV = (float*)(ws + WS_SKV); float* SQH = (float*)(ws + WS_SQH); float* SA = (float*)(ws + WS_SA); float* RS2 = (float*)(ws + WS_RS2); float* KR = (float*)(ws + WS_KR); float* E = (float*)(ws + WS_E); float* HS = (float*)(ws + WS_HS); const float* CS = (const float*)(ws + WS_COS); const float* SN = (const float*)(ws + WS_SIN); int* CNT = (int*)(ws + WS_ROUTE + RT_CNT); int* TSTART = (int*)(ws + WS_ROUTE + RT_TSTART); int* ER = (int*)(ws + WS_ROUTE + RT_ER); float* WGT = (float*)(ws + WS_ROUTE + RT_WGT); int* TOK = (int*)(ws + WS_ROUTE + RT_TOK); float* RW = (float*)(ws + WS_ROUTE + RT_W); float* RRS = (float*)(ws + WS_ROUTE + RT_RS);
    if (a.l_lo == 0 && INP(0)) for (int rep_ = 0; rep_ < NREP(0); ++rep_) { FRESH(Fp); p0_prologue(Fp, a); SEAM(); STAMP(0, 0); }

    for (int l = a.l_lo; l < a.l_hi; ++l) {
#define HbCur ((bf16_t*)(ws + ((l & 1) ? WS_HBB : WS_HBA)))
#define HbOth ((bf16_t*)(ws + ((l & 1) ? WS_HBA : WS_HBB)))
#define s5tb ((const unsigned char*)(ws + WS_S5T + (size_t)l * S5T_LAYER))
#define gmix (a.in[24] + (size_t)l * 1024)
        if (INP(1)) for (int rep_ = 0; rep_ < NREP(1); ++rep_) { PHASE_PTRS
            Gemm g{HbCur, (const bf16_t*)(ws + WS_WIN) + (size_t)l * 1536 * 1024, T, 1536, 1024}; pg8::StaticOrder So; So.init(T, 1536, G, bx);
            EpiIn Ei{SS1, ZQ, KR, ZKV, U, VS, XS, SSQ, SKV, a.in[10] + l * 256, a.in[11] + l * 256};
            PHASE_SYNC(); pg8::gemm_phase<EpiIn, pg8::StaticOrder, true, true>(F.lds, g, So, Ei);
            SEAM();
            STAMP(l, 1);
        }
        if (INP(2)) for (int rep_ = 0; rep_ < NREP(2); ++rep_) { PHASE_PTRS
#ifndef MK_SUB
#define MK_SUB 0xF
#endif
            if (MK_SUB & 1) { Gemm g{ZQ, (const bf16_t*)(ws + WS_WUQ) + (size_t)l * 1024 * 384, T, 1024, 384}; pg8::StaticOrder So; So.init(T, 1024, G, bx);
              EpiQ Eq{SSQ, Q, SQH}; PHASE_SYNC(); pg8::gemm_phase<EpiQ, pg8::StaticOrder, true, true>(F.lds, g, So, Eq); }
            if (MK_SUB & 2) { Gemm g{ZKV, (const bf16_t*)(ws + WS_WUKV) + (size_t)l * 1024 * 256, T, 1024, 256}; pg8::StaticOrder So; So.init(T, 1024, G, bx);
              EpiKV Ek{SKV, KR, a.in[9] + l * 96, CS, SN, K, V}; PHASE_SYNC(); pg8::gemm_phase<EpiKV, pg8::StaticOrder, true, true>(F.lds, g, So, Ek); }
            if (MK_SUB & 4) for (int task = bx; task < T / 64; task += G) { PHASE_SYNC(); FRESH(Fp); s5_pass1(Fp, task, XS, s5tb, E); }
            SEAM();
            STAMP(l, 2);
        }
        if (INP(3)) for (int rep_ = 0; rep_ < NREP(3); ++rep_) { PHASE_PTRS
            if (bx < 32) { PHASE_SYNC(); FRESH(Fp); s5_carry_seg(Fp, bx, s5tb, E, HS); }
            __syncthreads();
            bool generic;
            { const int ln = opaque_tid() & 63; const float* gq = a.in[8] + l * 96; const float* gk = a.in[9] + l * 96;
              float mq = fmaxf(fabsf(gq[ln]), ln < 32 ? fabsf(gq[64 + ln]) : 0.f), mk = fmaxf(fabsf(gk[ln]), ln < 32 ? fabsf(gk[64 + ln]) : 0.f);
#pragma unroll
              for (int o_ = 1; o_ < 64; o_ <<= 1) { mq = fmaxf(mq, shx(mq, o_)); mk = fmaxf(mk, shx(mk, o_)); }
              const float bound = 96.0f * mq * mk * att::C2; generic = __builtin_amdgcn_readfirstlane((int)(!(bound < 64.0f))) != 0; }
            for (int v = F.vcu; v < 256; v += G) { const int bh = v >> 4, s = v & 15;
#pragma unroll 1
                for (int i = 0; i < 4; ++i) { const int qb = (i == 0) ? 63 - s : (i == 1) ? 32 + s : (i == 2) ? 31 - s : s;
                    PHASE_SYNC(); if (generic) att::attn_unit(bh >> 3, bh & 7, qb, Q, SQH, a.in[8] + l * 96, CS, SN, K, V, MIX, SA, (char*)lds);
                    else att::attn_unit3(bh >> 3, bh & 7, qb, Q, SQH, a.in[8] + l * 96, CS, SN, K, V, MIX, SA, (char*)lds); } }
            SEAM();
            STAMP(l, 3);
        }
        if (INP(4)) { PHASE_PTRS
            for (int rep_ = 0; rep_ < NREP(4); ++rep_) {
            if (MK_SUB & 1) for (int task = bx; task < T / 64; task += G) { PHASE_SYNC(); FRESH(Fp); s5_pass3(Fp, task, XS, s5tb, HS, (const bf16_t*)(ws + WS_WGLU) + (size_t)l * 65536, a.in[23] + l * 256, gmix, MIX, SA); }
            if (MK_SUB & 2) for (int ci = bx; ci < T / 128; ci += G) { PHASE_SYNC(); FRESH(Fp); gmlp_unit(Fp, ci, U, VS, (const bf16_t*)(ws + WS_WSG) + (size_t)l * 65536, a.in[13] + l * 512, gmix, MIX, SA); }
            if (rep_ + 1 < NREP(4)) SEAM(); }
            SEAM();
            STAMP(l, 4);
        }
        if (INP(5)) { PHASE_PTRS
            Gemm g{MIX, (const bf16_t*)(ws + WS_WOUT) + (size_t)l * 1024 * 1024, T, 1024, 1024}; pg8::StaticOrder So; So.init(T, 1024, G, bx);
            EpiOut Eo{HbCur, HbOth, SS2, SA}; PHASE_SYNC(); pg8::gemm_phase<EpiOut, pg8::StaticOrder, true, true>(F.lds, g, So, Eo);
            SEAM();
            STAMP(l, 5);
        }
        if (INP(6)) for (int rep_ = 0; rep_ < NREP(6); ++rep_) { PHASE_PTRS
            for (int blk = bx; blk < 256; blk += G) { PHASE_SYNC(); FRESH(Fp); route_block(Fp, blk, HbOth, SS2, (const bf16_t*)(ws + WS_WR) + (size_t)l * 48 * 1024, a.in[28] + l * 4, a.in[30] + l * 32, RS2, CNT, ER, WGT); }
            SEAM();
            STAMP(l, 6);
        }
        if (INP(7)) for (int rep_ = 0; rep_ < NREP(7); ++rep_) { PHASE_PTRS
            for (int blk = bx; blk < 256; blk += G) { PHASE_SYNC(); FRESH(Fp); scatter_block(Fp, blk, (unsigned)((l & 1) ? WS_HBA : WS_HBB), RS2, CNT, ER, WGT, TSTART, TOK, RW, RRS, (unsigned*)(ws + WS_ROUTE + RT_RTO)); }
            SEAM();
            STAMP(l, 7);
        }
        if (INP(8)) for (int rep_ = 0; rep_ < NREP(8); ++rep_) { PHASE_PTRS
            const bool ovl = a.pad != 0; const int par = ovl ? (l & 1) : 0;
            Gemm g{(const bf16_t*)ws, (const bf16_t*)(ws + (par ? WS_W13B : WS_W13)), NPMAX, 32 * 512, 1024}; MoeOrder<2> Mo; Mo.init(TSTART, G, F.vcu);
            EpiM1 Em{RRS, HBX}; PHASE_SYNC(); pg8::gemm_phase_g<EpiM1, MoeOrder<2>, true, true>(F.lds, g, Mo, Em, (const unsigned*)(ws + WS_ROUTE + RT_RTO));
            if (ovl && l + 1 < NL) { const int nt = Mo.total, r = nt % G; const int L = r ? G - r : G, j = r ? F.vcu - r : F.vcu;
                if (j >= 0) { FRESH(Fp); conv_moe_layer(Fp, j * NW + Fp.wave, L * NW, a, l + 1, (l + 1) & 1); } }
            SEAM();
            STAMP(l, 8);
        }
        if (INP(9)) for (int rep_ = 0; rep_ < NREP(9); ++rep_) { PHASE_PTRS
            const bool ovl = a.pad != 0; const int par = ovl ? (l & 1) : 0;
            Gemm g{HBX, (const bf16_t*)(ws + (par ? WS_W2TB : WS_W2T)), NPMAX, 32 * 1024, 256}; MoeOrder<4> Mo; Mo.init(TSTART, G, F.vcu);
            EpiM2 Em{TOK, RW, Y01}; PHASE_SYNC(); pg8::gemm_phase<EpiM2, MoeOrder<4>, true, true>(F.lds, g, Mo, Em);
            if (ovl) { const int nt = Mo.total, r = nt % G; const int L = r ? G - r : G, j = r ? F.vcu - r : F.vcu;
                if (j >= 0) { FRESH(Fp); conv_p_layer(Fp, j * NW + Fp.wave, L * NW, a, l); } }
            SEAM();
            STAMP(l, 9);
        }
        if (INP(10)) { PHASE_PTRS
            FRESH(Fp); const int gwp = Fp.vcu * NW + Fp.wave;
            for (int t = gwp; t < T; t += NGW) combine_row(t, Fp.lane, HbOth, Y01, HbCur);
            if (a.pad == 0) { conv_p_layer(Fp, gwp, NGW, a, l);
                if (l + 1 < NL) conv_moe_layer(Fp, gwp, NGW, a, l + 1); }
            SEAM();
            STAMP(l, 10);
        }
        if (INP(11)) { PHASE_PTRS
            if (MK_SUB & 1) { Gemm g{Pb, (const bf16_t*)(ws + WS_WPLE) + (size_t)l * 1024 * 256, T, 1024, 256}; pg8::StaticOrder So; So.init(T, 1024, G, bx);
              EpiPl Ep{PL}; PHASE_SYNC(); pg8::gemm_phase<EpiPl, pg8::StaticOrder, true, true>(F.lds, g, So, Ep); }
            if (MK_SUB & 2) { Gemm g{HbCur, (const bf16_t*)(ws + WS_WPG) + (size_t)l * 1024 * 1024, T, 1024, 1024}; pg8::StaticOrder So; So.init(T, 1024, G, bx);
              EpiGate Eg{HbCur, PL, a.in[35] + l * 1024, HbOth, SS1, (l + 1 == NL) ? H : nullptr}; PHASE_SYNC(); pg8::gemm_phase<EpiGate, pg8::StaticOrder, true, true>(F.lds, g, So, Eg); }
            if (l + 1 < a.l_hi) SEAM();
            STAMP(l, 11);
        }
    }
#undef SEAM
#undef INP
}
}
#if DBG && DBG != 100
namespace dbg {
constexpr int NT = 1024;
constexpr size_t WS_ORACLE = 640ull << 20;
__global__ void k_cmp(const void* f, int isbf, size_t f_rs, size_t f_off, const float* r, size_t r_rs, size_t r_off, int rows, int cols, int* res) {
    const int row = blockIdx.x * (blockDim.x >> 6) + (threadIdx.x >> 6), lane = threadIdx.x & 63;
    if (row >= rows) return;
    float sd = 0.f, sr = 0.f;
    for (int c = lane; c < cols; c += 64) {
        const float rv = r[(size_t)row * r_rs + r_off + c];
        float fv;
        if (isbf) { const unsigned short b = ((const unsigned short*)f)[(size_t)row * f_rs + f_off + c]; fv = __builtin_bit_cast(float, (unsigned)b << 16); }
        else fv = ((const float*)f)[(size_t)row * f_rs + f_off + c];
        const float d = fv - rv; sd += d * d; sr += rv * rv;
    }
    sd = nv::wsum(sd); sr = nv::wsum(sr);
    if (lane == 0) { const float rel = sqrtf(sd / fmaxf(sr, 1e-30f)); const int bad = (rel <= 0.05f) ? 0 : 1; atomicAdd(res, bad); atomicAdd(res + 1, 1); }
}
__global__ void k_cmpw(const unsigned short* Wt, const float* w_in, const float* ln1, int* res) {
    const int n = blockIdx.x * (blockDim.x >> 6) + (threadIdx.x >> 6), lane = threadIdx.x & 63;
    if (n >= 64) return;
    float sd = 0.f, sr = 0.f;
    for (int k = lane; k < 1024; k += 64) { const float rv = w_in[(size_t)k * 1440 + n] * ln1[k]; const float fv = __builtin_bit_cast(float, (unsigned)Wt[(size_t)n * 1024 + k] << 16); const float d = fv - rv; sd += d * d; sr += rv * rv; }
    sd = nv::wsum(sd); sr = nv::wsum(sr);
    if (lane == 0) { const float rel = sqrtf(sd / fmaxf(sr, 1e-30f)); atomicAdd(res, (rel <= 0.05f) ? 0 : 1); atomicAdd(res + 1, 1); }
}
__global__ void k_encode(const int* res, int ncodes, const float* x, float* out, size_t n) {
    int code = 0;
    for (int c = 1; c < ncodes; ++c) { const int bad = res[2 * c], tot = res[2 * c + 1]; if (tot > 0 && bad * 20 > tot) { code = c; break; } }
    if (code == 0) return;
    int mask = 0;
    for (int j = 0; j < 6 && code + j < ncodes; ++j) { const int bad = res[2 * (code + j)], tot = res[2 * (code + j) + 1]; if (tot > 0 && bad * 20 > tot) mask |= 1 << j; }
    const float sc = 1.0f + 10.0f * (float)code;
    for (size_t i = (size_t)blockIdx.x * blockDim.x + threadIdx.x; i < n; i += (size_t)gridDim.x * blockDim.x) out[i] = (i == 0) ? 1000.0f * (float)mask : x[i] * sc;
}
static void cmp(hipStream_t st, int* res, int code, const void* f, int isbf, size_t f_rs, size_t f_off, const float* r, size_t r_rs, size_t r_off, int cols) {
    hipLaunchKernelGGL(k_cmp, dim3((NT + 3) / 4), dim3(256), 0, st, f, isbf, f_rs, f_off, r, r_rs, r_off, NT, cols, res + 2 * code);
}
}
#endif


#if DBG == 100
namespace dh {
constexpr int NREP = 12, NBUF = 32;
__global__ void k_hash(const unsigned* p, size_t rows, size_t rs, size_t c0, size_t c1, unsigned long long* out) {
    unsigned long long acc = 0ull; const size_t w = c1 - c0, n = rows * w;
    for (size_t i = (size_t)blockIdx.x * blockDim.x + threadIdx.x; i < n; i += (size_t)gridDim.x * blockDim.x) { const size_t r = i / w, c = c0 + i % w; acc += (unsigned long long)p[r * rs + c] * (2ull * i + 1ull); }
    for (int o = 32; o >= 1; o >>= 1) acc += __shfl_xor(acc, o);
    if ((threadIdx.x & 63) == 0) atomicAdd(out, acc);
}
__global__ void __launch_bounds__(512) k_scrub(unsigned pat, unsigned* sink) {
    extern __shared__ unsigned sl[];
    for (int i = threadIdx.x; i < 163840 / 4 - 64; i += 512) sl[i] = pat + (unsigned)i * 0u;
    __syncthreads();
    if (sl[threadIdx.x] == 0x12345u) sink[0] = 1u;
}
__global__ void k_nancnt(const unsigned short* p, size_t rows, size_t rs, size_t c0, size_t c1, unsigned* out) {
    unsigned c = 0; const size_t w = c1 - c0, n = rows * w;
    for (size_t i = (size_t)blockIdx.x * blockDim.x + threadIdx.x; i < n; i += (size_t)gridDim.x * blockDim.x) { const unsigned short v = p[(i / w) * rs + c0 + i % w]; c += ((v & 0x7F80u) == 0x7F80u && (v & 0x7Fu)) ? 1u : 0u; }
    if (c) atomicAdd(out, c);
}
__global__ void k_nanenc(const unsigned* cnt, const float* x, float* out, size_t n) {
    const int code = cnt[0] ? 1 : (cnt[1] ? 2 : (cnt[2] ? 3 : 0));
    const float sc = 1.0f + (float)code;
    for (size_t i = (size_t)blockIdx.x * blockDim.x + threadIdx.x; i < n; i += (size_t)gridDim.x * blockDim.x) out[i] = x[i] * sc;
}
__global__ void k_encode(const unsigned long long* tab, int nbuf, const float* x, float* out, size_t n) {
    int code = 0, mask = 0;
    for (int b = 1; b <= nbuf; ++b) { bool diff = false; for (int r = 1; r < NREP; ++r) diff |= tab[b * 16 + r] != tab[b * 16];
        if (diff && code == 0) code = b; }
    int code2 = 0;
    for (int b = 1; b <= nbuf; ++b) { bool diff = false; for (int r = 0; r < NREP; ++r) { const int base = (r & 1) ? 1 : ((r & 2) ? 2 : 0); diff |= tab[b * 16 + r] != tab[b * 16 + base]; }
        if (diff && code2 == 0) code2 = b; }
    const float sc = 1.0f + (float)code, sc2 = 1.0f + (float)code2;
    for (size_t i = (size_t)blockIdx.x * blockDim.x + threadIdx.x; i < n; i += (size_t)gridDim.x * blockDim.x) out[i] = x[i] * ((i < n / 2) ? sc : sc2);
}
__global__ void k_diff(const unsigned* D, size_t stride, size_t n, int nrep, unsigned* res) {
    for (size_t i = (size_t)blockIdx.x * blockDim.x + threadIdx.x; i < n; i += (size_t)gridDim.x * blockDim.x) { const unsigned ref = D[(size_t)(nrep - 1) * stride + i];
        for (int r = 0; r < nrep - 1; ++r) { const bool d = D[(size_t)r * stride + i] != ref; if (d) { atomicAdd(&res[0], 1u); atomicAdd(&res[1 + r], 1u); } } }
}
__global__ void k_diffenc(const unsigned* res, const unsigned long long* tab, int nbuf, const float* x, float* out, size_t n) {
    const unsigned cd = res[0]; int code = 0;
    for (int b = 1; b <= nbuf; ++b) { bool diff = false; for (int r = 1; r < NREP; ++r) diff |= tab[b * 16 + r] != tab[b * 16]; if (diff && code == 0) code = b; }
    int nd = 0; for (int r = 0; r < NREP - 1; ++r) nd += res[1 + r] ? 1 : 0;
#ifndef MK_ENC_ND
#define MK_ENC_ND 0
#endif
    const float sc = 1.0f + (float)code + 0.04f * (MK_ENC_ND ? (float)nd : (cd ? (float)(32 - __clz(cd)) : 0.0f));
    for (size_t i = (size_t)blockIdx.x * blockDim.x + threadIdx.x; i < n; i += (size_t)gridDim.x * blockDim.x) out[i] = x[i] * sc;
}
__global__ void k_cntenc(const unsigned* cnt, const float* x, float* out, size_t n) {
    const unsigned c = cnt[0]; const float sc = 1.0f + (c ? (float)(32 - __clz(c)) : 0.0f);
    for (size_t i = (size_t)blockIdx.x * blockDim.x + threadIdx.x; i < n; i += (size_t)gridDim.x * blockDim.x) out[i] = x[i] * sc;
}
}
#endif

#if MK_TIMING
__global__ void k_tsenc(const unsigned long long* tsb, unsigned maskA, unsigned maskB, const float* x, float* out, size_t n) {
    float dA = 0.f, dB = 0.f;
    for (int l = 0; l < 4; ++l) for (int ph = (l == 0 ? 0 : 1); ph < 12; ++ph) {
        unsigned long long prev = (ph == 0) ? tsb[255] : ((ph == 1 && l > 0) ? tsb[(l - 1) * 16 + 11] : tsb[l * 16 + ph - 1]);
        const float d = (float)(tsb[l * 16 + ph] - prev) * 0.01f;
        if ((maskA >> ph) & 1) dA += d; if ((maskB >> ph) & 1) dB += d; }
    const float sA = 1.0f + rintf(logf(fmaxf(dA, 1.0f)) * (1.0f / 0.0392207f)), sB = 1.0f + rintf(logf(fmaxf(dB, 1.0f)) * (1.0f / 0.0392207f));
    for (size_t i = (size_t)blockIdx.x * blockDim.x + threadIdx.x; i < n; i += (size_t)gridDim.x * blockDim.x) out[i] = x[i] * ((i < n / 2) ? sA : sB);
}
#endif
extern "C" void kernel_launch(void* const* d_in, const int* in_sizes, int n_in, void* d_out, int out_size, void* d_ws, size_t ws_size, hipStream_t stream) {
    using namespace mk;
    static int grid = 0;
    if (grid == 0) {
        size_t need = WS_END;
#if DBG && DBG != 100
        need = dbg::WS_ORACLE + (size_t)dbg::NT * 4096 + nv::bufs_bytes_noalias(dbg::NT);
#endif
        if (n_in != 37 || out_size != T * DM || ws_size < need) { fprintf(stderr, "kernel_launch: n_in %d out %d ws %zu (need %zu): nothing launched\n", n_in, out_size, ws_size, need); grid = -1; return; }
        int dev = 0, cus = 0, per_cu = 0;
        if (hipGetDevice(&dev) != hipSuccess || hipDeviceGetAttribute(&cus, hipDeviceAttributeMultiprocessorCount, dev) != hipSuccess) { grid = -1; return; }
        if (hipFuncSetAttribute((const void*)mk_fwd, hipFuncAttributeMaxDynamicSharedMemorySize, LDS_BYTES) != hipSuccess) { fprintf(stderr, "kernel_launch: hipFuncSetAttribute failed\n"); grid = -1; return; }
        if (hipOccupancyMaxActiveBlocksPerMultiprocessor(&per_cu, (const void*)mk_fwd, NW * 64, LDS_BYTES) != hipSuccess || per_cu < 1) fprintf(stderr, "kernel_launch: occupancy query says %d\n", per_cu);
        (void)hipGetLastError();
        grid = cus;
    }
    if (grid < 0) return;
    (void)hipMemsetAsync((char*)d_ws + WS_CTL, 0, CTL_ZERO_BYTES, stream);
    Args a{};
    for (int i = 0; i < 37; ++i) a.in[i] = (const float*)d_in[i];
    a.out = (float*)d_out; a.ws = (unsigned char*)d_ws;
#if DBG == 100
    {
        unsigned char* ws = (unsigned char*)d_ws;
        unsigned long long* tab = (unsigned long long*)(ws + (640ull << 20));
        (void)hipMemsetAsync(tab, 0, 64 * 16 * 8, stream);
        struct HB { size_t off; size_t rows, rs, c0, c1; bool out; };
        const size_t TT = T;
        const HB list[] = { {0, 0, 0, 0, 0, false},
            {WS_XS, TT, 128, 0, 128, false}, {WS_HS, 512 * 16, 128, 0, 128, false},
#if MK_S5_V2 == 7
            {(666ull << 20), 512 * 16, 128, 0, 64, false}, {(666ull << 20), 512 * 16, 128, 64, 128, false}, {(650ull << 20), 512 * 32, 64, 0, 64, false},
            {(654ull << 20), 512 * 16, 128, 0, 64, false}, {(658ull << 20), 512 * 16, 128, 0, 64, false}, {(642ull << 20), 512 * 16, 128, 0, 64, false}, {(662ull << 20), 512 * 16, 128, 0, 64, false},
            {(654ull << 20), 512 * 16, 128, 64, 128, false}, {(658ull << 20), 512 * 16, 128, 64, 128, false}, {(642ull << 20), 512 * 16, 128, 64, 128, false}, {(662ull << 20), 512 * 16, 128, 64, 128, false}, {WS_MIX, TT, 512, 384, 512, false} };
#elif MK_S5_V2 == 6
            {(650ull << 20), 512 * 16, 64, 0, 64, false}, {(666ull << 20), 512 * 32, 64, 0, 64, false}, {WS_MIX, TT, 512, 384, 512, false} };
#else
            {(650ull << 20), TT, 128, 0, 128, false}, {(666ull << 20), TT, 128, 0, 128, false}, {WS_MIX, TT, 512, 384, 512, false} };
#endif
        const int nbuf = (int)(sizeof(list) / sizeof(list[0])) - 1;
        const size_t M = 1ull << 20;
        (void)hipMemsetAsync(ws + (650ull << 20), 0, 256, stream); (void)hipMemsetAsync(ws + (649ull << 20), 0, 256, stream);
        for (int rep = 0; rep < dh::NREP; ++rep) {
            (void)hipMemsetAsync(ws + WS_CTL, 0, CTL_ZERO_BYTES, stream);
#if MK_S5_V2 == 7
            (void)hipMemsetAsync(ws + M, 0xAA, 537 * M, stream);
#else
            (void)hipMemsetAsync(ws + M, 0xAA, 633 * M, stream);
#endif
            (void)hipMemsetAsync(d_out, 0xAA, (size_t)T * DM * 4, stream);
            a.l_lo = 0; a.l_hi = 1; a.ph_lo = 0; a.ph_hi = 6; a.shift = (rep & 1) ? 37 : ((rep & 2) ? 101 : 0);
#ifdef MK_SPLIT
            for (int ph = 0; ph < 6; ++ph) { a.ph_lo = ph; a.ph_hi = ph + 1; hipLaunchKernelGGL(mk_fwd, dim3(grid), dim3(NW * 64), LDS_BYTES, stream, a); }
#else
            hipLaunchKernelGGL(mk_fwd, dim3(grid), dim3(NW * 64), LDS_BYTES, stream, a);
#endif
            for (int b = 1; b <= nbuf; ++b) { const HB& h = list[b];
                const unsigned* p = h.out ? (const unsigned*)d_out : (const unsigned*)(ws + h.off);
                hipLaunchKernelGGL(dh::k_hash, dim3(1024), dim3(256), 0, stream, p, h.rows, h.rs, h.c0, h.c1, tab + b * 16 + rep); }
#if MK_S5_V2 == 7
            (void)hipMemcpyAsync(ws + (538ull << 20) + (size_t)rep * 4 * M, ws + (658ull << 20), 4 * M, hipMemcpyDeviceToDevice, stream);
#endif
        }
#if MK_S5_V2 == 7
        (void)hipMemsetAsync(ws + (650ull << 20), 0, 256, stream);
        hipLaunchKernelGGL(dh::k_diff, dim3(1024), dim3(256), 0, stream, (const unsigned*)(ws + (538ull << 20)), (size_t)(4 * M / 4), (size_t)(4 * M / 4), dh::NREP, (unsigned*)(ws + (650ull << 20)));
        hipLaunchKernelGGL(dh::k_diffenc, dim3(1024), dim3(256), 0, stream, (const unsigned*)(ws + (650ull << 20)), tab, nbuf, (const float*)d_in[0], (float*)d_out, (size_t)T * DM);
#elif MK_S5_V2 == 8
        hipLaunchKernelGGL(dh::k_cntenc, dim3(1024), dim3(256), 0, stream, (const unsigned*)(ws + (650ull << 20)), (const float*)d_in[0], (float*)d_out, (size_t)T * DM);
#else
        hipLaunchKernelGGL(dh::k_encode, dim3(1024), dim3(256), 0, stream, tab, nbuf, (const float*)d_in[0], (float*)d_out, (size_t)T * DM);
#endif
        return;
    }
#endif
#if !DBG
#ifdef MK_PROBE_WS
    if (ws_size < WS_END2) return;
#endif
    a.l_lo = 0; a.l_hi = NL; a.ph_lo = 0; a.ph_hi = NPHASE; a.pad = (ws_size >= WS_END2) ? 1 : 0;
#ifdef MK_PROBE_NOOVL
    a.pad = 0;
#endif
    hipLaunchKernelGGL(mk_fwd, dim3(grid), dim3(NW * 64), LDS_BYTES, stream, a);
#if MK_TIMING
    hipLaunchKernelGGL(k_tsenc, dim3(1024), dim3(256), 0, stream, (const unsigned long long*)((unsigned char*)d_ws + 65536), (unsigned)MK_TS_A, (unsigned)MK_TS_B, (const float*)d_in[0], (float*)d_out, (size_t)T * DM);
#endif
#elif DBG != 100
    using dbg::NT;
    unsigned char* ws = (unsigned char*)d_ws;
    int* res = (int*)(ws + 32768);
    float* Hn = (float*)(ws + dbg::WS_ORACLE);
    nv::Bufs Bn = nv::carve_noalias(Hn, (char*)ws + dbg::WS_ORACLE + (size_t)NT * 4096, NT);
    (void)hipMemcpyAsync(Hn, d_in[0], (size_t)NT * 4096, hipMemcpyDeviceToDevice, stream);
    a.l_lo = 0; a.l_hi = 1; a.ph_lo = 0; a.ph_hi = 1;
    hipLaunchKernelGGL(mk_fwd, dim3(grid), dim3(NW * 64), LDS_BYTES, stream, a);
    dbg::cmp(stream, res, 1, d_out, 0, 1024, 0, (const float*)d_in[0], 1024, 0, 1024);
    dbg::cmp(stream, res, 2, ws + WS_HBA, 1, 1024, 0, (const float*)d_in[0], 1024, 0, 1024);
    hipLaunchKernelGGL(dbg::k_cmpw, dim3(16), dim3(256), 0, stream, (const unsigned short*)(ws + WS_WIN), (const float*)d_in[3], (const float*)d_in[2], res + 2 * 3);
    const int DBG_LAYERS = DBG;
    for (int l = 0; l < NL; ++l) {
        if (l < DBG_LAYERS) nv::layer(stream, d_in, l, Bn, 1, NT);
        for (int ph = 1; ph < NPHASE; ++ph) {
            a.l_lo = l; a.l_hi = l + 1; a.ph_lo = ph; a.ph_hi = ph + 1;
            hipLaunchKernelGGL(mk_fwd, dim3(grid), dim3(NW * 64), LDS_BYTES, stream, a);
            if (l >= DBG_LAYERS) continue;
            const int cb = l * 20 + 3;
            if (ph == 1) {
                dbg::cmp(stream, res, cb + 1, ws + WS_ZQ, 1, 384, 0, Bn.Z, 1440, 0, 384);
                dbg::cmp(stream, res, cb + 2, ws + WS_ZKV, 1, 256, 0, Bn.Z, 1440, 384, 256);
                dbg::cmp(stream, res, cb + 3, ws + WS_KR, 0, 32, 0, Bn.Z, 1440, 640, 32);
                dbg::cmp(stream, res, cb + 4, ws + WS_U, 1, 256, 0, Bn.U, 256, 0, 256);
                dbg::cmp(stream, res, cb + 5, ws + WS_VS, 1, 256, 0, Bn.VS, 256, 0, 256);
                dbg::cmp(stream, res, cb + 6, ws + WS_XS, 1, 256, 0, Bn.Z, 1440, 1184, 256);
            } else if (ph == 2) {
                for (int h = 0; h < 8; ++h) { dbg::cmp(stream, res, cb + 7, ws + WS_K, 1, 96, (size_t)h * S * 96, Bn.K, 768, h * 96, 96);
                    dbg::cmp(stream, res, cb + 8, ws + WS_V, 1, 64, (size_t)h * S * 64, Bn.KV, 1024, h * 128 + 64, 64); }
            } else if (ph == 3) {
                dbg::cmp(stream, res, cb + 9, ws + WS_MIX, 1, 1024, 0, Bn.A, 512, 0, 512);
            } else if (ph == 4) {
                dbg::cmp(stream, res, cb + 10, ws + WS_MIX, 1, 1024, 0, Bn.SNAP_MIX, 1024, 0, 512);
                dbg::cmp(stream, res, cb + 11, ws + WS_MIX, 1, 1024, 512, Bn.SNAP_MIX, 1024, 512, 256);
                dbg::cmp(stream, res, cb + 12, ws + WS_MIX, 1, 1024, 768, Bn.SNAP_MIX, 1024, 768, 256);
            } else if (ph == 5) {
                dbg::cmp(stream, res, cb + 13, d_out, 0, 1024, 0, Bn.SNAP_HMID, 1024, 0, 1024);
            } else if (ph == 10) {
                dbg::cmp(stream, res, cb + 14, d_out, 0, 1024, 0, Bn.SNAP_HMOE, 1024, 0, 1024);
            } else if (ph == 11) {
                dbg::cmp(stream, res, cb + 15, d_out, 0, 1024, 0, Hn, 1024, 0, 1024);
            }
        }
    }
    hipLaunchKernelGGL(dbg::k_encode, dim3(1024), dim3(256), 0, stream, res, 64, (const float*)d_in[0], (float*)d_out, (size_t)T * DM);
#endif
}
```
